# Optimizing an MI355X kernel written in HIP

```python
import jax, jax.numpy as jnp
from jax import lax
import numpy as np

D_MODEL = 1024
BATCH = 8
SEQ = 4096
DEPTH = 2

N_A_LAYERS = DEPTH // 2
N_B_LAYERS = DEPTH - N_A_LAYERS
PLE_DIM = 256
EPS = 1e-6

ML_HEADS = 8
ML_DV = D_MODEL // ML_HEADS
ML_DQK = ML_DV // 2
ML_CHUNK = 64
GATE_CAP = 15.0
ML_SPLITS = (ML_HEADS * ML_DQK, ML_HEADS * ML_DQK, ML_HEADS * ML_DV, ML_HEADS * ML_DV, ML_HEADS, ML_HEADS)
ML_IN = sum(ML_SPLITS)

MB_HEADS = 16
MB_KV_HEADS = 4
MB_HD = D_MODEL // MB_HEADS
MB_GROUP = MB_HEADS // MB_KV_HEADS
MB_BLOCK = 256
MB_TOPK = 3
MB_QCHUNK = 16
ROPE_THETA = 500000.0
ROPE_DIM = MB_HD // 4

FFN_HIDDEN = -(-8 * D_MODEL // (3 * 256)) * 256

kernel_name = "yoco_mlstm_moba_hybrid"


def rmsnorm(x, g):
    xf = x.astype(jnp.float32)
    y = xf * lax.rsqrt(jnp.mean(xf * xf, axis=-1, keepdims=True) + EPS)
    return (y * g.astype(jnp.float32)).astype(x.dtype)


def rope_partial(x):
    s_len = x.shape[2]
    half = ROPE_DIM // 2
    inv = ROPE_THETA ** (-jnp.arange(0, ROPE_DIM, 2, dtype=jnp.float32) / ROPE_DIM)
    ang = jnp.arange(s_len, dtype=jnp.float32)[:, None] * inv[None, :]
    cos, sin = jnp.cos(ang), jnp.sin(ang)
    xf = x.astype(jnp.float32)
    x1, x2 = xf[..., :half], xf[..., half:ROPE_DIM]
    out = jnp.concatenate([x1 * cos - x2 * sin, x2 * cos + x1 * sin, xf[..., ROPE_DIM:]], axis=-1)
    return out.astype(x.dtype)


def swiglu(h, w_gate_up, w_down):
    g, u = jnp.split(h @ w_gate_up, 2, axis=-1)
    return (jax.nn.silu(g) * u) @ w_down


def mlstm_chunkwise(q, k, v, logi, logf):
    b, nh, s_len, dqk = q.shape
    dv = v.shape[-1]
    L = ML_CHUNK
    nc = s_len // L
    qc = q.reshape(b, nh, nc, L, dqk) * (dqk ** -0.5)
    kc = k.reshape(b, nh, nc, L, dqk)
    vc = v.reshape(b, nh, nc, L, dv)
    li = logi.reshape(b, nh, nc, L)
    g = jnp.cumsum(logf.reshape(b, nh, nc, L), axis=-1)
    g_last = g[..., -1]
    causal = jnp.tril(jnp.ones((L, L), dtype=bool))
    dmat = jnp.where(causal, g[..., :, None] - g[..., None, :] + li[..., None, :], -jnp.inf)
    m_intra = jnp.max(dmat, axis=-1)
    a = g_last[..., None] - g + li
    m_loc = jnp.max(a, axis=-1)
    wloc = jnp.exp(a - m_loc[..., None])
    c_loc = jnp.einsum('bhcsv,bhcsk->bhcvk', vc * wloc[..., None], kc)
    n_loc = jnp.einsum('bhcs,bhcsk->bhck', wloc, kc)

    def step(carry, inp):
        c_st, n_st, m_st = carry
        cl, nl, ml, gl = inp
        m_new = jnp.maximum(gl + m_st, ml)
        sp = jnp.exp(gl + m_st - m_new)
        sl = jnp.exp(ml - m_new)
        c_new = sp[..., None, None] * c_st + sl[..., None, None] * cl
        n_new = sp[..., None] * n_st + sl[..., None] * nl
        return (c_new, n_new, m_new), (c_st, n_st, m_st)

    init = (jnp.zeros((b, nh, dv, dqk), jnp.float32), jnp.zeros((b, nh, dqk), jnp.float32),
            jnp.zeros((b, nh), jnp.float32))
    xs = (jnp.moveaxis(c_loc, 2, 0), jnp.moveaxis(n_loc, 2, 0), jnp.moveaxis(m_loc, 2, 0), jnp.moveaxis(g_last, 2, 0))
    _, (c_prev, n_prev, m_prev) = lax.scan(step, init, xs)
    c_prev = jnp.moveaxis(c_prev, 0, 2)
    n_prev = jnp.moveaxis(n_prev, 0, 2)
    m_prev = jnp.moveaxis(m_prev, 0, 2)

    m_inter = g + m_prev[..., None]
    m_comb = jnp.maximum(m_inter, m_intra)
    w_inter = jnp.exp(m_inter - m_comb)
    s = jnp.einsum('bhcjk,bhcsk->bhcjs', qc, kc) * jnp.exp(dmat - m_comb[..., None])
    num = w_inter[..., None] * jnp.einsum('bhcjk,bhcvk->bhcjv', qc, c_prev) + jnp.einsum('bhcjs,bhcsv->bhcjv', s, vc)
    den = w_inter * jnp.einsum('bhcjk,bhck->bhcj', qc, n_prev) + jnp.sum(s, axis=-1)
    hcell = num / jnp.maximum(jnp.abs(den), jnp.exp(-m_comb))[..., None]
    return hcell.reshape(b, nh, s_len, dv)


def mlstm_mixer(hn, w_in, b_gate, mh_gain, w_out):
    b, s_len, _ = hn.shape
    idx = np.cumsum(ML_SPLITS)[:-1].tolist()
    q, k, v, o, gi, gf = jnp.split(hn @ w_in, idx, axis=-1)
    heads = lambda t, d: t.reshape(b, s_len, ML_HEADS, d).transpose(0, 2, 1, 3).astype(jnp.float32)
    q, k, v = heads(q, ML_DQK), heads(k, ML_DQK), heads(v, ML_DV)
    cap = lambda t: GATE_CAP * jnp.tanh(t / GATE_CAP)
    b_i, b_f = b_gate[:ML_HEADS], b_gate[ML_HEADS:]
    logi = cap(gi.astype(jnp.float32) + b_i).transpose(0, 2, 1)
    logf = jax.nn.log_sigmoid(cap(gf.astype(jnp.float32) + b_f)).transpose(0, 2, 1)
    hcell = mlstm_chunkwise(q, k, v, logi, logf)
    hcell = rmsnorm(hcell.transpose(0, 2, 1, 3), mh_gain).reshape(b, s_len, ML_HEADS * ML_DV)
    return ((jax.nn.sigmoid(o.astype(jnp.float32)) * hcell).astype(hn.dtype)) @ w_out


def shared_kv(h, kv_norm, w_kv, k_norm):
    b, s_len, _ = h.shape
    k, v = jnp.split(rmsnorm(h, kv_norm) @ w_kv, 2, axis=-1)
    k = k.reshape(b, s_len, MB_KV_HEADS, MB_HD).transpose(0, 2, 1, 3)
    v = v.reshape(b, s_len, MB_KV_HEADS, MB_HD).transpose(0, 2, 1, 3)
    k = rope_partial(rmsnorm(k, k_norm))
    nb = -(-s_len // MB_BLOCK)
    pad = ((0, 0), (0, 0), (0, nb * MB_BLOCK - s_len), (0, 0))
    k_blocks = jnp.pad(k, pad).reshape(b, MB_KV_HEADS, nb, MB_BLOCK, MB_HD)
    v_blocks = jnp.pad(v, pad).reshape(b, MB_KV_HEADS, nb, MB_BLOCK, MB_HD)
    k_mean = jnp.mean(k_blocks.astype(jnp.float32), axis=3)
    return k_blocks, v_blocks, k_mean


def moba_mixer(hn, w_q, q_norm, w_o, k_blocks, v_blocks, k_mean):
    b, s_len, _ = hn.shape
    nb = k_blocks.shape[2]
    scale = MB_HD ** -0.5
    q = (hn @ w_q).reshape(b, s_len, MB_HEADS, MB_HD).transpose(0, 2, 1, 3)
    q = rope_partial(rmsnorm(q, q_norm))
    gate = jnp.einsum('bkgsd,bknd->bkgsn', q.reshape(b, MB_KV_HEADS, MB_GROUP, s_len, MB_HD).astype(jnp.float32),
                      k_mean).reshape(b, MB_HEADS, s_len, nb)
    qblk = jnp.arange(s_len) // MB_BLOCK
    past = jnp.arange(nb)[None, :] < qblk[:, None]
    gate = jnp.where(past, gate, -jnp.inf)
    if nb < MB_TOPK:
        gate = jnp.concatenate([gate, jnp.full((b, MB_HEADS, s_len, MB_TOPK - nb), -jnp.inf, gate.dtype)], axis=-1)
    sel = jnp.minimum(lax.top_k(gate, MB_TOPK)[1], nb - 1)
    bi = jnp.arange(b)[:, None, None, None]
    gi = (jnp.arange(MB_HEADS) // MB_GROUP)[None, :, None, None]

    def chunk(c):
        t0 = c * MB_QCHUNK
        qc = lax.dynamic_slice_in_dim(q, t0, MB_QCHUNK, axis=2)
        selc = lax.dynamic_slice_in_dim(sel, t0, MB_QCHUNK, axis=2)
        tpos = t0 + jnp.arange(MB_QCHUNK)
        ob = t0 // MB_BLOCK
        k_sel = k_blocks[bi, gi, selc]
        v_sel = v_blocks[bi, gi, selc]
        s_sel = jnp.einsum('bhqd,bhqjud->bhqju', qc, k_sel).astype(jnp.float32) * scale
        valid = jnp.arange(MB_TOPK)[None, :] < (tpos // MB_BLOCK)[:, None]
        s_sel = jnp.where(valid[None, None, :, :, None], s_sel, -jnp.inf).reshape(b, MB_HEADS, MB_QCHUNK, MB_TOPK * MB_BLOCK)
        k_own = lax.dynamic_index_in_dim(k_blocks, ob, axis=2, keepdims=False)
        v_own = lax.dynamic_index_in_dim(v_blocks, ob, axis=2, keepdims=False)
        qg = qc.reshape(b, MB_KV_HEADS, MB_GROUP, MB_QCHUNK, MB_HD)
        s_own = jnp.einsum('bkgqd,bkud->bkgqu', qg, k_own).astype(jnp.float32).reshape(b, MB_HEADS, MB_QCHUNK, MB_BLOCK) * scale
        kpos = ob * MB_BLOCK + jnp.arange(MB_BLOCK)
        s_own = jnp.where(kpos[None, :] <= tpos[:, None], s_own, -jnp.inf)
        prob = jax.nn.softmax(jnp.concatenate([s_sel, s_own], axis=-1), axis=-1)
        p_sel = prob[..., :MB_TOPK * MB_BLOCK].reshape(b, MB_HEADS, MB_QCHUNK, MB_TOPK, MB_BLOCK).astype(v_sel.dtype)
        p_own = prob[..., MB_TOPK * MB_BLOCK:].reshape(b, MB_KV_HEADS, MB_GROUP, MB_QCHUNK, MB_BLOCK).astype(v_own.dtype)
        o_sel = jnp.einsum('bhqju,bhqjud->bhqd', p_sel, v_sel)
        o_own = jnp.einsum('bkgqu,bkud->bkgqd', p_own, v_own).reshape(b, MB_HEADS, MB_QCHUNK, MB_HD)
        return o_sel + o_own

    out = lax.map(chunk, jnp.arange(s_len // MB_QCHUNK))
    out = jnp.transpose(out, (1, 0, 3, 2, 4)).reshape(b, s_len, MB_HEADS * MB_HD)
    return out @ w_o


def setup_inputs(seed: int = 0) -> dict:
    key = jax.random.key(seed)
    ks = jax.random.split(key, 24)
    f32 = jnp.float32
    nrm = lambda k, shape, fan: jax.random.normal(k, shape, f32) * (fan ** -0.5)
    gain = lambda k, shape: 1.0 + 0.05 * jax.random.normal(k, shape, f32)
    b_gate = jnp.concatenate([
        0.1 * jax.random.normal(ks[4], (N_A_LAYERS, ML_HEADS), f32),
        jnp.linspace(3.0, 6.0, ML_HEADS, dtype=f32)[None, :] + 0.1 * jax.random.normal(ks[5], (N_A_LAYERS, ML_HEADS), f32)], axis=-1)
    return {
        "x": jax.random.normal(ks[0], (BATCH, SEQ, D_MODEL), f32),
        "p": jax.random.normal(ks[1], (DEPTH, BATCH, SEQ, PLE_DIM), f32),
        "norm_mix": gain(ks[2], (DEPTH, D_MODEL)),
        "a_w_in": nrm(ks[3], (N_A_LAYERS, D_MODEL, ML_IN), D_MODEL),
        "a_b_gate": b_gate,
        "a_mh_gain": gain(ks[6], (N_A_LAYERS, ML_DV)),
        "a_w_out": nrm(ks[7], (N_A_LAYERS, ML_HEADS * ML_DV, D_MODEL), ML_HEADS * ML_DV),
        "kv_norm": gain(ks[8], (D_MODEL,)),
        "w_kv": nrm(ks[9], (D_MODEL, 2 * MB_KV_HEADS * MB_HD), D_MODEL),
        "k_norm": gain(ks[10], (MB_HD,)),
        "b_w_q": nrm(ks[11], (N_B_LAYERS, D_MODEL, MB_HEADS * MB_HD), D_MODEL),
        "b_q_norm": gain(ks[12], (N_B_LAYERS, MB_HD)),
        "b_w_o": nrm(ks[13], (N_B_LAYERS, MB_HEADS * MB_HD, D_MODEL), MB_HEADS * MB_HD),
        "norm_ffn": gain(ks[14], (DEPTH, D_MODEL)),
        "w_gate_up": nrm(ks[15], (DEPTH, D_MODEL, 2 * FFN_HIDDEN), D_MODEL),
        "w_down": nrm(ks[16], (DEPTH, FFN_HIDDEN, D_MODEL), FFN_HIDDEN),
        "norm_ple": gain(ks[17], (DEPTH, D_MODEL)),
        "w_ple_gate": nrm(ks[18], (DEPTH, D_MODEL, D_MODEL), D_MODEL),
        "w_ple_up": nrm(ks[19], (DEPTH, PLE_DIM, D_MODEL), PLE_DIM),
    }


def reference(x, p, norm_mix, a_w_in, a_b_gate, a_mh_gain, a_w_out, kv_norm, w_kv, k_norm,
              b_w_q, b_q_norm, b_w_o, norm_ffn, w_gate_up, w_down, norm_ple, w_ple_gate, w_ple_up):
    h = x
    shared = None
    for i in range(DEPTH):
        hn = rmsnorm(h, norm_mix[i])
        if i < N_A_LAYERS:
            h = h + mlstm_mixer(hn, a_w_in[i], a_b_gate[i], a_mh_gain[i], a_w_out[i])
        else:
            if shared is None:
                shared = shared_kv(h, kv_norm, w_kv, k_norm)
            j = i - N_A_LAYERS
            h = h + moba_mixer(hn, b_w_q[j], b_q_norm[j], b_w_o[j], *shared)
        h = h + swiglu(rmsnorm(h, norm_ffn[i]), w_gate_up[i], w_down[i])
        gate = jax.nn.sigmoid(rmsnorm(h, norm_ple[i]) @ w_ple_gate[i])
        h = h + (p[i].astype(h.dtype) @ w_ple_up[i]) * gate
    return h
```

```cpp
#include <hip/hip_runtime.h>
#include <cstdio>
#include <cstdint>

#ifndef MK_N_LAUNCHES
#define MK_N_LAUNCHES 0
#endif

#define LAS __attribute__((address_space(3)))
#define GAS __attribute__((address_space(1)))

namespace pg8 {
#define PG8_LAS __attribute__((address_space(3)))
typedef unsigned short bf16_t;
typedef short bf16x8 __attribute__((ext_vector_type(8)));
typedef float f32x4 __attribute__((ext_vector_type(4)));
typedef unsigned u32x4 __attribute__((ext_vector_type(4)));
typedef unsigned u32x2 __attribute__((ext_vector_type(2)));
constexpr int BM = 256, BK = 64, HALF = 128, HTB = HALF * BK * 2, STAGE_BYTES = 8 * HTB, NXCD = 8, WGM = 8;

__host__ __device__ __forceinline__ int lds_byte(int r, int c) { const int st = (r >> 4) * 2 + (c >> 5), rr = r & 15, cc = c & 31, ob = rr * 64 + cc * 2; return st * 1024 + (ob ^ (((ob >> 9) & 1) << 5)); }
__host__ __device__ __forceinline__ void stage_rc(int b, int& R, int& C) { const int st = b / 1024, sb = b % 1024, swz = sb ^ (((sb >> 9) & 1) << 5); R = (st >> 1) * 16 + swz / 64; C = (st & 1) * 32 + (swz % 64) / 2; }
__host__ __device__ __forceinline__ int perm32(int rho) { const int n = rho >> 4, i = rho & 15; return 8 * (i >> 2) + 4 * n + (i & 3); }

struct Unit { int pm, pn; };
struct Gemm { const bf16_t* A; const bf16_t* Bt; int M, N, K; };

struct StaticOrder {
    int nM, nN, nwg, G, c;
    __host__ __device__ void init(int M, int N, int G_, int c_) { nM = M / BM; nN = N / BM; nwg = nM * nN; G = G_; c = c_; }
    __host__ __device__ bool next(int i, Unit& u) const {
        const long L = (long)i * G + c; if (L >= nwg) return false;
        int wgid = (int)L; { const int q = nwg / NXCD, r = nwg % NXCD, xcd = wgid % NXCD, off = wgid / NXCD; wgid = (xcd < r ? xcd * (q + 1) : r * (q + 1) + (xcd - r) * q) + off; }
        const int nig = WGM * nN, gid = wgid / nig, fm = gid * WGM, gsz = (nM - fm) < WGM ? (nM - fm) : WGM;
        u.pm = fm + ((wgid % nig) % gsz); u.pn = (wgid % nig) / gsz; return true;
    }
    __device__ __forceinline__ void a_ready(const Unit&) const {}
    __device__ __forceinline__ void done(const Unit&) const {}
};

__device__ __forceinline__ unsigned cvt_pk_bf16(float lo, float hi) { unsigned r; asm volatile("v_cvt_pk_bf16_f32 %0, %1, %2" : "=v"(r) : "v"(lo), "v"(hi)); return r; }

template <class Epi, class Sched, bool ALIGN_EPI = false, bool SP2 = false>
__device__ __forceinline__ void gemm_phase(PG8_LAS unsigned char* lds, const Gemm g, const Sched& S, const Epi& E, const int tid) {
    const int wid = __builtin_amdgcn_readfirstlane(tid >> 6), lane = tid & 63, wr = wid >> 2, wc = wid & 3, fr = lane & 15, fq = lane >> 4;
    int K_ = g.K; asm volatile("" : "+s"(K_));
    const int K = K_, nt = K / BK;
    unsigned voffA[2], voffB[2];
#pragma unroll
    for (int i = 0; i < 2; ++i) { int R, C; stage_rc(tid * 16 + i * 8192, R, C); const int Rb = Epi::PERM ? ((R & ~31) + perm32(R & 31)) : R;
        voffA[i] = (unsigned)(R * K + C) * 2u; voffB[i] = (unsigned)(Rb * K + C) * 2u; }
    const size_t kstep = (size_t)(BK * 2);
    const size_t hstep = (size_t)HALF * K * 2;
    const size_t tstep = 2 * hstep;
    const unsigned ldsw = (unsigned)wid * 1024u;
    const int aoff = lds_byte(wr * 64 + fr, fq * 8), boff = lds_byte(wc * 32 + fr, fq * 8);
#define PG8_SA(b, h) (((b) * 2 + (h)) * HTB)
#define PG8_SB(b, h) ((4 + (b) * 2 + (h)) * HTB)
#define PG8_STAGE(bufoff, gbase, voff) do { _Pragma("unroll") for (int _i = 0; _i < 2; ++_i) \
        __builtin_amdgcn_global_load_lds((const unsigned*)((const char*)(gbase) + (voff)[_i]), (PG8_LAS unsigned*)(lds + (bufoff) + ldsw + _i * 8192), 16, 0, 0); } while (0)
#define PG8_LDA(dst, b, h) do { _Pragma("unroll") for (int m = 0; m < 4; ++m) _Pragma("unroll") for (int k = 0; k < 2; ++k) dst[m][k] = *(const PG8_LAS bf16x8*)(lds + PG8_SA(b, h) + aoff + m * 2048 + k * 1024); } while (0)
#define PG8_LDB(dst, b, h) do { _Pragma("unroll") for (int n = 0; n < 2; ++n) _Pragma("unroll") for (int k = 0; k < 2; ++k) dst[n][k] = *(const PG8_LAS bf16x8*)(lds + PG8_SB(b, h) + boff + n * 2048 + k * 1024); } while (0)
#define PG8_MMA(ai, bj, At, Bt) do { __builtin_amdgcn_s_setprio(1); _Pragma("unroll") for (int m = 0; m < 4; ++m) _Pragma("unroll") for (int n = 0; n < 2; ++n) _Pragma("unroll") for (int k = 0; k < 2; ++k) \
        acc[ai][bj][m][n] = __builtin_amdgcn_mfma_f32_16x16x32_bf16(Bt[n][k], At[m][k], acc[ai][bj][m][n], 0, 0, 0); __builtin_amdgcn_s_setprio(0); } while (0)
#define PG8_WAIT_V(n) asm volatile("s_waitcnt vmcnt(" #n ")" ::: "memory")
#define PG8_WAIT_L(n) asm volatile("s_waitcnt lgkmcnt(" #n ")" ::: "memory")
#define PG8_BAR __builtin_amdgcn_s_barrier()
#define PG8_SCHED __builtin_amdgcn_sched_barrier(0)
    Unit cur, nxt; int ui = 0;
    if (!S.next(0, cur)) return;
    f32x4 acc[2][2][4][2];
#pragma unroll
    for (int a = 0; a < 2; ++a)
#pragma unroll
        for (int b = 0; b < 2; ++b)
#pragma unroll
            for (int m = 0; m < 4; ++m)
#pragma unroll
                for (int n = 0; n < 2; ++n) acc[a][b][m][n] = (f32x4){0.f, 0.f, 0.f, 0.f};
    bf16x8 At[4][2], B0[2][2], B1[2][2];
    const char* cA = (const char*)g.A + (size_t)cur.pm * tstep; const char* cB = (const char*)g.Bt + (size_t)cur.pn * tstep;
    S.a_ready(cur);
    if constexpr (SP2) {
        PG8_STAGE(PG8_SB(0, 0), cB, voffB); PG8_STAGE(PG8_SB(0, 1), cB + hstep, voffB); PG8_STAGE(PG8_SA(0, 0), cA, voffA); PG8_STAGE(PG8_SA(0, 1), cA + hstep, voffA);
        if (wr == 1) PG8_BAR;
        PG8_WAIT_V(2); PG8_BAR;
        PG8_STAGE(PG8_SB(1, 0), cB + kstep, voffB); PG8_STAGE(PG8_SA(1, 0), cA + kstep, voffA); PG8_STAGE(PG8_SB(1, 1), cB + hstep + kstep, voffB);
        PG8_WAIT_V(6); PG8_BAR;
    } else {
        PG8_STAGE(PG8_SB(0, 0), cB, voffB); PG8_STAGE(PG8_SA(0, 0), cA, voffA); PG8_STAGE(PG8_SB(0, 1), cB + hstep, voffB); PG8_STAGE(PG8_SA(0, 1), cA + hstep, voffA);
        if (wr == 1) PG8_BAR;
        PG8_WAIT_V(4); PG8_BAR;
        PG8_STAGE(PG8_SB(1, 0), cB + kstep, voffB); PG8_STAGE(PG8_SA(1, 0), cA + kstep, voffA); PG8_STAGE(PG8_SB(1, 1), cB + hstep + kstep, voffB);
        PG8_WAIT_V(6); PG8_BAR;
    }
    for (;;) {
        const bool has_next = S.next(ui + 1, nxt);
        const char* nA = has_next ? (const char*)g.A + (size_t)nxt.pm * tstep : cA; const char* nB = has_next ? (const char*)g.Bt + (size_t)nxt.pn * tstep : cB;
        for (int t = 0; t < nt; t += 2) {
            const bool last = (t == nt - 2);
            const char* a1 = cA + (size_t)(t + 1) * kstep;
            const char* a2 = last ? nA : cA + (size_t)(t + 2) * kstep; const char* b2 = last ? nB : cB + (size_t)(t + 2) * kstep;
            const char* a3 = a2 + kstep; const char* b3 = b2 + kstep;
            if (last && has_next) S.a_ready(nxt);
            if constexpr (SP2) {
            PG8_LDB(B0, 0, 0); PG8_LDB(B1, 0, 1); PG8_SCHED; PG8_LDA(At, 0, 0); PG8_STAGE(PG8_SA(1, 1), a1 + hstep, voffA);
            PG8_WAIT_V(8); PG8_WAIT_L(0); PG8_BAR; PG8_MMA(0, 0, At, B0); PG8_MMA(0, 1, At, B1); PG8_BAR; PG8_SCHED;
            PG8_LDA(At, 0, 1); PG8_STAGE(PG8_SB(0, 0), b2, voffB); PG8_STAGE(PG8_SB(0, 1), b2 + hstep, voffB); PG8_STAGE(PG8_SA(0, 0), a2, voffA);
            PG8_WAIT_V(8); PG8_WAIT_L(0); PG8_BAR; PG8_MMA(1, 0, At, B0); PG8_MMA(1, 1, At, B1); PG8_BAR; PG8_SCHED;
            PG8_LDB(B0, 1, 0); PG8_LDB(B1, 1, 1); PG8_SCHED; PG8_LDA(At, 1, 0); PG8_STAGE(PG8_SA(0, 1), a2 + hstep, voffA);
            PG8_WAIT_V(8); PG8_WAIT_L(0); PG8_BAR; PG8_MMA(0, 0, At, B0); PG8_MMA(0, 1, At, B1); PG8_BAR; PG8_SCHED;
            PG8_LDA(At, 1, 1); PG8_STAGE(PG8_SB(1, 0), b3, voffB); PG8_STAGE(PG8_SB(1, 1), b3 + hstep, voffB); PG8_STAGE(PG8_SA(1, 0), a3, voffA);
            PG8_WAIT_V(8); PG8_WAIT_L(0); PG8_BAR; PG8_MMA(1, 0, At, B0); PG8_MMA(1, 1, At, B1); PG8_BAR; PG8_SCHED;
            } else {
            PG8_LDB(B0, 0, 0); PG8_SCHED; PG8_LDA(At, 0, 0); PG8_STAGE(PG8_SA(1, 1), a1 + hstep, voffA);
            PG8_WAIT_L(8); PG8_BAR; PG8_WAIT_L(0); PG8_MMA(0, 0, At, B0); PG8_BAR; PG8_SCHED;
            PG8_LDB(B1, 0, 1); PG8_STAGE(PG8_SB(0, 0), b2, voffB);
            PG8_BAR; PG8_WAIT_L(0); PG8_MMA(0, 1, At, B1); PG8_BAR;
            PG8_LDA(At, 0, 1); PG8_STAGE(PG8_SA(0, 0), a2, voffA);
            PG8_BAR; PG8_WAIT_L(0); PG8_MMA(1, 0, At, B0); PG8_BAR; PG8_SCHED;
            PG8_STAGE(PG8_SB(0, 1), b2 + hstep, voffB);
            PG8_WAIT_V(6); PG8_BAR; PG8_MMA(1, 1, At, B1); PG8_BAR;
            PG8_LDB(B0, 1, 0); PG8_SCHED; PG8_LDA(At, 1, 0); PG8_STAGE(PG8_SA(0, 1), a2 + hstep, voffA);
            PG8_WAIT_L(8); PG8_BAR; PG8_WAIT_L(0); PG8_MMA(0, 0, At, B0); PG8_BAR; PG8_SCHED;
            PG8_LDB(B1, 1, 1); PG8_STAGE(PG8_SB(1, 0), b3, voffB);
            PG8_BAR; PG8_WAIT_L(0); PG8_MMA(0, 1, At, B1); PG8_BAR;
            PG8_LDA(At, 1, 1); PG8_STAGE(PG8_SA(1, 0), a3, voffA);
            PG8_BAR; PG8_WAIT_L(0); PG8_MMA(1, 0, At, B0); PG8_BAR; PG8_SCHED;
            PG8_STAGE(PG8_SB(1, 1), b3 + hstep, voffB);
            PG8_WAIT_V(6); PG8_BAR; PG8_MMA(1, 1, At, B1); PG8_BAR;
            }
        }
        if constexpr (ALIGN_EPI) { if (wr == 0) PG8_BAR; }
        E(acc, cur, wr, wc, fr, fq); S.done(cur);
        if (!has_next) break;
#pragma unroll
        for (int a = 0; a < 2; ++a)
#pragma unroll
            for (int b = 0; b < 2; ++b)
#pragma unroll
                for (int m = 0; m < 4; ++m)
#pragma unroll
                    for (int n = 0; n < 2; ++n) acc[a][b][m][n] = (f32x4){0.f, 0.f, 0.f, 0.f};
        cur = nxt; cA = nA; cB = nB; ++ui;
        if constexpr (ALIGN_EPI) { if (wr == 1) PG8_BAR; }
    }
    PG8_WAIT_V(0);
    if constexpr (!ALIGN_EPI) { if (wr == 0) PG8_BAR; }
    PG8_BAR;
#undef PG8_SA
#undef PG8_SB
#undef PG8_STAGE
#undef PG8_LDA
#undef PG8_LDB
#undef PG8_MMA
#undef PG8_WAIT_V
#undef PG8_WAIT_L
#undef PG8_BAR
#undef PG8_SCHED
}
}

typedef unsigned short bf16;
typedef float f32x4 __attribute__((ext_vector_type(4)));
typedef unsigned v4u __attribute__((ext_vector_type(4)));
typedef unsigned v2u __attribute__((ext_vector_type(2)));
constexpr int NB_ = 8, SEQ = 4096, D = 1024, M = NB_ * SEQ;
constexpr int ML_H = 8, ML_DV = 128, ML_DQK = 64, ML_L = 64, ML_NC = SEQ / ML_L, ML_IN = 3088, ML_INP = 3328;
constexpr int MB_H = 16, MB_KVH = 4, MB_HD = 64, MB_BLK = 256, MB_NB = SEQ / MB_BLK;
constexpr int FF = 2816, PLE = 256;
constexpr float EPS = 1e-6f, GATE_CAP = 15.0f;
constexpr int NWAVES = 8, NTHREADS = 512;

constexpr size_t MiB = 1u << 20;
constexpr size_t WS_CTL = 0, CTL_ZERO_BYTES = 1 * MiB;
constexpr size_t WS_ROPE = 1 * MiB;
constexpr size_t WS_KMP = 1 * MiB + 512 * 1024;
constexpr size_t WS_SSQ = 2 * MiB;
constexpr size_t WS_GATES = 6 * MiB;
constexpr size_t WS_MLOC = 8 * MiB, WS_GLAST = WS_MLOC + 16384, WS_MPREV = WS_GLAST + 16384;
constexpr size_t WS_NLOC = 9 * MiB;
constexpr size_t WS_WIN = 10 * MiB, WS_WOUT = 17 * MiB, WS_WQKV1 = 19 * MiB, WS_WO1 = 22 * MiB, WS_WGU = 24 * MiB  , WS_WDN = 46 * MiB  , WS_WPG = 58 * MiB  , WS_WPU = 62 * MiB  ;
constexpr size_t WS_HB = 64 * MiB, WS_HB2 = 448 * MiB;
constexpr size_t WS_PB = 128 * MiB;
constexpr size_t WS_UP = 160 * MiB;
constexpr size_t WS_OG = 160 * MiB;
constexpr size_t WS_Q0 = 224 * MiB, WS_K0 = 256 * MiB, WS_V0 = 288 * MiB  , WS_CLOC = 384 * MiB  ;
constexpr size_t WS_ACT = 224 * MiB;
constexpr size_t WS_Q1 = 224 * MiB, WS_K1 = 288 * MiB, WS_V1 = 304 * MiB, WS_AO = 320 * MiB;
constexpr size_t WS_END = 512 * MiB;

constexpr int LDS_BYTES = 147456;
constexpr int RING_BYTES = 131072;
constexpr int LDSCTL_OFF = RING_BYTES;

__device__ __forceinline__ unsigned f2bf(float f) { unsigned u = __builtin_bit_cast(unsigned, f); return (u + 0x7fffu + ((u >> 16) & 1u)) >> 16; }
__device__ __forceinline__ unsigned pk2(float lo, float hi) { return pg8::cvt_pk_bf16(lo, hi); }
__device__ __forceinline__ float bf_lo(unsigned u) { return __builtin_bit_cast(float, u << 16); }
__device__ __forceinline__ float bf_hi(unsigned u) { return __builtin_bit_cast(float, u & 0xffff0000u); }
__device__ __forceinline__ float rstd_of(const float* ssq, int row) {
    const f32x4* p = (const f32x4*)(ssq + (size_t)row * 16);
    const f32x4 a = p[0], b = p[1], c = p[2], d = p[3];
    const float s = (((a[0] + a[1]) + (a[2] + a[3])) + ((b[0] + b[1]) + (b[2] + b[3]))) + (((c[0] + c[1]) + (c[2] + c[3])) + ((d[0] + d[1]) + (d[2] + d[3])));
    return __builtin_amdgcn_rsqf(s * (1.0f / D) + EPS);
}
__device__ __forceinline__ float sigmoidf_(float x) { return __builtin_amdgcn_rcpf(1.0f + __builtin_amdgcn_exp2f(-1.4426950408889634f * x)); }
__device__ __forceinline__ float shx(float v, int mask, int lane) { return __builtin_bit_cast(float, __builtin_amdgcn_ds_bpermute((lane ^ mask) << 2, __builtin_bit_cast(int, v))); }
__device__ __forceinline__ int shxi(int v, int mask, int lane) { return __builtin_amdgcn_ds_bpermute((lane ^ mask) << 2, v); }
__device__ __forceinline__ float shup(float v, int o, int lane) { return __builtin_bit_cast(float, __builtin_amdgcn_ds_bpermute((lane >= o ? lane - o : lane) << 2, __builtin_bit_cast(int, v))); }
__device__ __forceinline__ float shidx(float v, int src) { return __builtin_bit_cast(float, __builtin_amdgcn_ds_bpermute(src << 2, __builtin_bit_cast(int, v))); }
__device__ __forceinline__ float wave_sum(float v, int lane) {
#pragma unroll
    for (int o = 1; o < 64; o <<= 1) v += shx(v, o, lane);
    return v;
}
__device__ __forceinline__ float wave_max(float v, int lane) {
#pragma unroll
    for (int o = 1; o < 64; o <<= 1) v = fmaxf(v, shx(v, o, lane));
    return v;
}

using pg8::Unit; using pg8::HALF; using pg8::BM;
#define ROWS8 _Pragma("unroll") for (int ai = 0; ai < 2; ++ai) _Pragma("unroll") for (int m = 0; m < 4; ++m)

struct EpiMl {
    static constexpr bool PERM = true, AFTER_DRAIN = false;
    unsigned char* ws; float* gates; const float* ssq; const float* bgate;
    __device__ __forceinline__ void operator()(const f32x4 (&acc)[2][2][4][2], const Unit& u, int wr, int wc, int fr, int fq) const {
        const int row0 = u.pm * BM + wr * 64 + fr;
        float rs[2][4];
        ROWS8 { rs[ai][m] = rstd_of(ssq, row0 + ai * HALF + m * 16); }
        if (u.pn < 12) {
            const int t = u.pn < 2 ? 0 : (u.pn < 4 ? 1 : (u.pn < 8 ? 2 : 3));
            const size_t boff = t == 0 ? WS_Q0 : (t == 1 ? WS_K0 : (t == 2 ? WS_V0 : WS_OG));
            const int ld = t < 2 ? 512 : 1024, colt = (u.pn - (t == 0 ? 0 : (t == 1 ? 2 : (t == 2 ? 4 : 8)))) * 256; const float sc = t == 0 ? 0.125f : 1.f;
            bf16* base = (bf16*)(ws + boff);
            const int col0 = colt + wc * 32 + 8 * fq;
            ROWS8 { bf16* rowp = base + (size_t)(row0 + ai * HALF + m * 16) * ld + col0; const float r = rs[ai][m] * sc;
#pragma unroll
                for (int bj = 0; bj < 2; ++bj) { const f32x4 v0 = acc[ai][bj][m][0] * r, v1 = acc[ai][bj][m][1] * r; v4u w; w.x = pk2(v0[0], v0[1]); w.y = pk2(v0[2], v0[3]); w.z = pk2(v1[0], v1[1]); w.w = pk2(v1[2], v1[3]);
                    *(v4u*)(rowp + bj * HALF) = w; } }
        } else if (wc == 0 && fq < 2) {
            float bg[8];
#pragma unroll
            for (int j = 0; j < 8; ++j) bg[j] = bgate[8 * fq + j];
            ROWS8 { const int row = row0 + ai * HALF + m * 16; const float r = rs[ai][m]; float o[8];
#pragma unroll
                for (int j = 0; j < 8; ++j) { const float pre = acc[ai][0][m][j >> 2][j & 3] * r + bg[j]; const float c = GATE_CAP * tanhf(pre * (1.0f / GATE_CAP));
                    o[j] = (fq == 0) ? c : -log1pf(expf(-c)); }
                float* gp = gates + (size_t)row * 16 + 8 * fq; *(f32x4*)gp = (f32x4){o[0], o[1], o[2], o[3]}; *(f32x4*)(gp + 4) = (f32x4){o[4], o[5], o[6], o[7]}; }
        }
    }
};
struct EpiQkv1 {
    static constexpr bool PERM = true, AFTER_DRAIN = false;
    unsigned char* ws; const float* ssq;
    __device__ __forceinline__ void operator()(const f32x4 (&acc)[2][2][4][2], const Unit& u, int wr, int wc, int fr, int fq) const {
        const int row0 = u.pm * BM + wr * 64 + fr;
        const size_t boff = u.pn < 4 ? WS_Q1 : (u.pn == 4 ? WS_K1 : WS_V1); const int ld = u.pn < 4 ? 1024 : 256, colt = u.pn < 4 ? u.pn * 256 : 0;
        bf16* base = (bf16*)(ws + boff);
        const int col0 = colt + wc * 32 + 8 * fq;
        ROWS8 { const float r = rstd_of(ssq, row0 + ai * HALF + m * 16); bf16* rowp = base + (size_t)(row0 + ai * HALF + m * 16) * ld + col0;
#pragma unroll
            for (int bj = 0; bj < 2; ++bj) { const f32x4 v0 = acc[ai][bj][m][0] * r, v1 = acc[ai][bj][m][1] * r; v4u w; w.x = pk2(v0[0], v0[1]); w.y = pk2(v0[2], v0[3]); w.z = pk2(v1[0], v1[1]); w.w = pk2(v1[2], v1[3]);
                *(v4u*)(rowp + bj * HALF) = w; }
            if (m == 3) asm volatile("" ::: "memory"); }
    }
};
struct EpiPlain {
    static constexpr bool PERM = true, AFTER_DRAIN = false;
    bf16* O; int ld;
    __device__ __forceinline__ void operator()(const f32x4 (&acc)[2][2][4][2], const Unit& u, int wr, int wc, int fr, int fq) const {
        const int row0 = u.pm * BM + wr * 64 + fr, col0 = u.pn * BM + wc * 32 + 8 * fq;
        ROWS8 { bf16* rowp = O + (size_t)(row0 + ai * HALF + m * 16) * ld + col0;
#pragma unroll
            for (int bj = 0; bj < 2; ++bj) { const f32x4 v0 = acc[ai][bj][m][0], v1 = acc[ai][bj][m][1]; v4u w; w.x = pk2(v0[0], v0[1]); w.y = pk2(v0[2], v0[3]); w.z = pk2(v1[0], v1[1]); w.w = pk2(v1[2], v1[3]);
                *(v4u*)(rowp + bj * HALF) = w; } }
    }
};
struct EpiSwiglu {
    static constexpr bool PERM = true, AFTER_DRAIN = false;
    bf16* act; const float* ssq;
    __device__ __forceinline__ void operator()(const f32x4 (&acc)[2][2][4][2], const Unit& u, int wr, int wc, int fr, int fq) const {
        const int row0 = u.pm * BM + wr * 64 + fr, col0 = u.pn * HALF + wc * 32 + 8 * fq;
        ROWS8 { const float r = rstd_of(ssq, row0 + ai * HALF + m * 16); bf16* rowp = act + (size_t)(row0 + ai * HALF + m * 16) * FF + col0; float o[8];
#pragma unroll
            for (int n = 0; n < 2; ++n)
#pragma unroll
                for (int e = 0; e < 4; ++e) { const float gv = acc[ai][0][m][n][e] * r, uv = acc[ai][1][m][n][e] * r; o[4 * n + e] = gv * sigmoidf_(gv) * uv; }
            v4u w; w.x = pk2(o[0], o[1]); w.y = pk2(o[2], o[3]); w.z = pk2(o[4], o[5]); w.w = pk2(o[6], o[7]); *(v4u*)rowp = w;
            if (m == 3) asm volatile("" ::: "memory"); }
    }
};
struct EpiRes {
    static constexpr bool PERM = false, AFTER_DRAIN = false;
    const float* base; float* out; bf16* hb; float* ssq;
    __device__ __forceinline__ void operator()(const f32x4 (&acc)[2][2][4][2], const Unit& u, int wr, int wc, int fr, int fq) const {
        const int row0 = u.pm * BM + wr * 64 + fr, col0 = u.pn * BM + wc * 32 + 4 * fq;
        ROWS8 { const int row = row0 + ai * HALF + m * 16; const size_t off = (size_t)row * D + col0; float part = 0.f;
#pragma unroll
            for (int bj = 0; bj < 2; ++bj)
#pragma unroll
                for (int n = 0; n < 2; ++n) { const size_t o2 = off + bj * HALF + n * 16; const f32x4 o = *(const f32x4*)(base + o2) + acc[ai][bj][m][n];
                    *(f32x4*)(out + o2) = o; v2u w; w.x = pk2(o[0], o[1]); w.y = pk2(o[2], o[3]); *(v2u*)(hb + o2) = w; part += (o[0] * o[0] + o[1] * o[1]) + (o[2] * o[2] + o[3] * o[3]); }
            part += shx(part, 16, fr + 16 * fq); part += shx(part, 32, fr + 16 * fq);
            if (fq == 0) ssq[(size_t)row * 16 + 4 * u.pn + wc] = part;
            if (m & 1) asm volatile("" ::: "memory"); }
    }
};
struct EpiPle {
    static constexpr bool PERM = false, AFTER_DRAIN = false;
    const float* base; float* out; bf16* hb; float* ssq_out; const float* ssq_in; const bf16* up;
    __device__ __forceinline__ void operator()(const f32x4 (&acc)[2][2][4][2], const Unit& u, int wr, int wc, int fr, int fq) const {
        const int row0 = u.pm * BM + wr * 64 + fr, col0 = u.pn * BM + wc * 32 + 4 * fq;
        ROWS8 { const int row = row0 + ai * HALF + m * 16; const size_t off = (size_t)row * D + col0; const float r = rstd_of(ssq_in, row); float part = 0.f;
#pragma unroll
            for (int bj = 0; bj < 2; ++bj)
#pragma unroll
                for (int n = 0; n < 2; ++n) { const size_t o2 = off + bj * HALF + n * 16; const v2u uw = *(const v2u*)(up + o2); const f32x4 a = acc[ai][bj][m][n] * r;
                    f32x4 o = *(const f32x4*)(base + o2);
                    o[0] += bf_lo(uw.x) * sigmoidf_(a[0]); o[1] += bf_hi(uw.x) * sigmoidf_(a[1]); o[2] += bf_lo(uw.y) * sigmoidf_(a[2]); o[3] += bf_hi(uw.y) * sigmoidf_(a[3]);
                    *(f32x4*)(out + o2) = o; v2u w; w.x = pk2(o[0], o[1]); w.y = pk2(o[2], o[3]); *(v2u*)(hb + o2) = w; part += (o[0] * o[0] + o[1] * o[1]) + (o[2] * o[2] + o[3] * o[3]); }
            part += shx(part, 16, fr + 16 * fq); part += shx(part, 32, fr + 16 * fq);
            if (fq == 0) ssq_out[(size_t)row * 16 + 4 * u.pn + wc] = part;
            asm volatile("" ::: "memory"); }
    }
};

typedef GAS unsigned gu32;
#define RLX_AGENT __ATOMIC_RELAXED, __HIP_MEMORY_SCOPE_AGENT
#define XB_TMO      128
#define XB_XCNT(j)  (256  + 64 * (j))
#define XB_XSUB(j)  (1280 + 64 * (j))
#define XB_XGEN(j)  (2304 + 64 * (j))
#define XB_TOP      3328
#define XB_TOPGEN   3392
#define XCD_BAR_WORDS 3456
#define XB_SPIN_CAP (1u << 22)
__device__ __forceinline__ unsigned xb_ld(unsigned* p)              { return __hip_atomic_load(p, __ATOMIC_RELAXED, __HIP_MEMORY_SCOPE_AGENT); }
__device__ __forceinline__ unsigned xb_add(unsigned* p, unsigned v) { return __hip_atomic_fetch_add(p, v, __ATOMIC_RELAXED, __HIP_MEMORY_SCOPE_AGENT); }
__device__ __forceinline__ unsigned xb_xcc_id() { return (unsigned)__builtin_amdgcn_s_getreg((3 << 11) | 20) & 0xFu; }
#define XB_SPIN(cond, bar) do { unsigned _sp = 0; while (cond) { __builtin_amdgcn_s_sleep(1); \
    if ((++_sp & 255u) == 0u) { if (xb_ld(&(bar)[XB_TMO])) break; if (_sp > XB_SPIN_CAP) { atomicAdd(&(bar)[XB_TMO], 1u); break; } } } } while (0)
struct XcdBarrier { unsigned* bar; unsigned x; volatile LAS unsigned* st; };
__device__ __forceinline__ XcdBarrier xcd_barrier_post(unsigned* bar, volatile LAS unsigned* st) {
    XcdBarrier b; b.bar = bar; b.x = xb_xcc_id(); b.st = st;
    if (threadIdx.x == 0) (void)xb_add(&bar[XB_XCNT(b.x)], 1u);
    return b;
}
__device__ __forceinline__ void xcd_barrier_complete(unsigned* bar, unsigned x, unsigned& nloc, unsigned& nx) {
    const unsigned G = gridDim.x * gridDim.y * gridDim.z;
    unsigned sum, cnt, mine, sp = 0u;
    for (;;) {
        sum = 0u; cnt = 0u; mine = 0u;
#pragma unroll
        for (unsigned j = 0; j < 16; ++j) { const unsigned c = xb_ld(&bar[XB_XCNT(j)]); sum += c; cnt += (c > 0u) ? 1u : 0u; mine = (j == x) ? c : mine; }
        if (sum == G) break;
        __builtin_amdgcn_s_sleep(1);
        if ((++sp & 255u) == 0u) { if (xb_ld(&bar[XB_TMO])) break; if (sp > XB_SPIN_CAP) { atomicAdd(&bar[XB_TMO], 1u); break; } }
    }
    nloc = mine > 0u ? mine : 1u; nx = cnt > 0u ? cnt : 1u;
}
__device__ __forceinline__ void xcd_barrier(const XcdBarrier& b) {
    asm volatile("s_waitcnt vmcnt(0)" ::: "memory");
    __syncthreads();
    if (threadIdx.x == 0) {
        unsigned* bar = b.bar;
        __builtin_amdgcn_s_waitcnt(0);
        unsigned nloc = b.st[0], nx = b.st[1];
        if (nloc == 0u) { xcd_barrier_complete(bar, b.x, nloc, nx); b.st[0] = nloc; b.st[1] = nx; }
        const unsigned old = xb_add(&bar[XB_XSUB(b.x)], 1u);
        const unsigned gen = old / nloc;
        if (old + 1u == (gen + 1u) * nloc) {
            __builtin_amdgcn_fence(__ATOMIC_RELEASE, "agent");
            asm volatile("s_waitcnt vmcnt(0)" ::: "memory");
            const unsigned og = xb_add(&bar[XB_TOP], 1u);
            const unsigned tg = og / nx;
            if (og + 1u == (tg + 1u) * nx) xb_add(&bar[XB_TOPGEN], 1u);
            else XB_SPIN(xb_ld(&bar[XB_TOPGEN]) == tg, bar);
            __builtin_amdgcn_fence(__ATOMIC_ACQUIRE, "agent");
            xb_add(&bar[XB_XGEN(b.x)], 1u);
            asm volatile("s_waitcnt vmcnt(0)" ::: "memory");
        } else {
            XB_SPIN(xb_ld(&bar[XB_XGEN(b.x)]) == gen, bar);
            __builtin_amdgcn_fence(__ATOMIC_ACQUIRE, "agent");
            asm volatile("s_waitcnt vmcnt(0)" ::: "memory");
        }
    }
    __syncthreads();
}

template <int MODE>
__device__ __forceinline__ void p0_transpose_item(const float* W, int K, int N, const float* gain, bf16* WT, int row_off, LAS float* scr, int item, int lane) {
    const int nblk = (N + 31) / 32, kb = item / nblk, nb = item % nblk, k0 = 64 * kb, n0 = 32 * nb;
    const int ncol = n0 + (lane & 31); const bool nok = ncol < N;
#pragma unroll 8
    for (int i = 0; i < 32; ++i) { const int kk = 2 * i + (lane >> 5); float v = nok ? W[(size_t)(k0 + kk) * N + ncol] : 0.f; if (gain) v *= gain[k0 + kk]; scr[kk * 33 + (lane & 31)] = v; }
    asm volatile("s_waitcnt lgkmcnt(0)" ::: "memory");
    const int c = lane & 7;
    int drow0;
    if (MODE == 0) drow0 = row_off + n0; else { const int isu = n0 >= FF ? 1 : 0, j0 = n0 - isu * FF; drow0 = 256 * (j0 / 128) + 128 * isu + (j0 % 128); }
#pragma unroll
    for (int j = 0; j < 4; ++j) { const int n = (lane >> 3) + 8 * j; const LAS float* s = scr + (8 * c) * 33 + n;
        v4u o; o.x = pk2(s[0 * 33], s[1 * 33]); o.y = pk2(s[2 * 33], s[3 * 33]); o.z = pk2(s[4 * 33], s[5 * 33]); o.w = pk2(s[6 * 33], s[7 * 33]);
        if (n0 + n < N) *(v4u*)(WT + (size_t)(drow0 + n) * K + k0 + 8 * c) = o; }
    asm volatile("s_waitcnt lgkmcnt(0)" ::: "memory");
}

struct Args { const float* in[19]; float* out; unsigned char* ws; int ph_lo, ph_hi; };
typedef const Args __attribute__((address_space(4))) CArgs;

__device__ __forceinline__ void p0_prologue(CArgs* A, LAS unsigned char* lds, int G, int vcu, int wave, int lane) {
    unsigned char* ws = A->ws;
    LAS float* scr = (LAS float*)(lds + wave * 16384);
    const int gw = vcu * NWAVES + wave, NGW = G * NWAVES;
    struct WI { int items; };
    constexpr int I_IN = 16 * 97, I_SQ = 16 * 32, I_KV = 16 * 16, I_GU = 16 * 176, I_DN = 44 * 32, I_PU = 4 * 32;
    constexpr int NITEMS = I_IN + I_SQ   + I_SQ   + I_KV + I_SQ   + 2 * I_GU + 2 * I_DN + 2 * I_SQ + 2 * I_PU;
    for (int it = gw; it < NITEMS; it += NGW) {
        int r = it;
        if (r < I_IN) { p0_transpose_item<0>(A->in[3], D, ML_IN, A->in[2], (bf16*)(ws + WS_WIN), 0, scr, r, lane); continue; } r -= I_IN;
        if (r < I_SQ) { p0_transpose_item<0>(A->in[6], D, D, nullptr, (bf16*)(ws + WS_WOUT), 0, scr, r, lane); continue; } r -= I_SQ;
        if (r < I_SQ) { p0_transpose_item<0>(A->in[10], D, D, A->in[2] + D, (bf16*)(ws + WS_WQKV1), 0, scr, r, lane); continue; } r -= I_SQ;
        if (r < I_KV) { p0_transpose_item<0>(A->in[8], D, 512, A->in[7], (bf16*)(ws + WS_WQKV1), D, scr, r, lane); continue; } r -= I_KV;
        if (r < I_SQ) { p0_transpose_item<0>(A->in[12], D, D, nullptr, (bf16*)(ws + WS_WO1), 0, scr, r, lane); continue; } r -= I_SQ;
        if (r < 2 * I_GU) { const int l = r / I_GU; p0_transpose_item<1>(A->in[14] + (size_t)l * D * 2 * FF, D, 2 * FF, A->in[13] + l * D, (bf16*)(ws + WS_WGU + l * 11 * MiB), 0, scr, r % I_GU, lane); continue; } r -= 2 * I_GU;
        if (r < 2 * I_DN) { const int l = r / I_DN; p0_transpose_item<0>(A->in[15] + (size_t)l * FF * D, FF, D, nullptr, (bf16*)(ws + WS_WDN + l * 6 * MiB), 0, scr, r % I_DN, lane); continue; } r -= 2 * I_DN;
        if (r < 2 * I_SQ) { const int l = r / I_SQ; p0_transpose_item<0>(A->in[17] + (size_t)l * D * D, D, D, A->in[16] + l * D, (bf16*)(ws + WS_WPG + l * 2 * MiB), 0, scr, r % I_SQ, lane); continue; } r -= 2 * I_SQ;
        { const int l = r / I_PU; p0_transpose_item<0>(A->in[18] + (size_t)l * PLE * D, PLE, D, nullptr, (bf16*)(ws + WS_WPU + l * (MiB / 2)), 0, scr, r % I_PU, lane); }
    }
    {
        const float* x = A->in[0]; bf16* hb = (bf16*)(ws + WS_HB); float* ssq = (float*)(ws + WS_SSQ);
        for (int m = gw; m < M; m += NGW) {
            const f32x4* xr = (const f32x4*)(x + (size_t)m * D) + lane; f32x4 v[4]; float s = 0.f;
#pragma unroll
            for (int j = 0; j < 4; ++j) { v[j] = xr[64 * j]; s += (v[j][0] * v[j][0] + v[j][1] * v[j][1]) + (v[j][2] * v[j][2] + v[j][3] * v[j][3]); }
            s = wave_sum(s, lane);
            unsigned long long* o8 = (unsigned long long*)(hb + (size_t)m * D) + lane;
#pragma unroll
            for (int j = 0; j < 4; ++j) o8[64 * j] = (unsigned long long)pk2(v[j][0], v[j][1]) | ((unsigned long long)pk2(v[j][2], v[j][3]) << 32);
            if (lane < 16) ssq[(size_t)m * 16 + lane] = (lane == 0) ? s : 0.f;
        }
    }
    {
        const float* p = A->in[1]; bf16* pb = (bf16*)(ws + WS_PB);
        const size_t n8 = (size_t)2 * M * PLE / 8, gt = (size_t)gw * 64 + lane, ngt = (size_t)NGW * 64;
        for (size_t i = gt; i < n8; i += ngt) { const f32x4 a = *(const f32x4*)(p + i * 8), b = *(const f32x4*)(p + i * 8 + 4);
            v4u w; w.x = pk2(a[0], a[1]); w.y = pk2(a[2], a[3]); w.z = pk2(b[0], b[1]); w.w = pk2(b[2], b[3]); *(v4u*)(pb + i * 8) = w; }
    }
    {
        float* rc = (float*)(ws + WS_ROPE); float* rsn = rc + SEQ * 8;
        const int gt = gw * 64 + lane;
        if (gt < SEQ * 8) { const int pos = gt >> 3, i = gt & 7;
            const float inv = (i == 0 ? 1.000000000e+00f : i == 1 ? 1.939227432e-01f : i == 2 ? 3.760603070e-02f : i == 3 ? 7.292664610e-03f : i == 4 ? 1.414213562e-03f : i == 5 ? 2.742481884e-04f : i == 6 ? 5.318295734e-05f : 1.031338525e-05f);
            const float angf = (float)pos * inv;
            const double rev = (double)angf * 0.15915494309189535; const double fr = rev - rint(rev);
            rc[gt] = __builtin_amdgcn_cosf((float)fr); rsn[gt] = __builtin_amdgcn_sinf((float)fr); }
    }
}

__device__ __forceinline__ float wave_incl_scan(float v, int lane) {
#pragma unroll
    for (int o = 1; o < 64; o <<= 1) { const float t = shup(v, o, lane); if (lane >= o) v += t; }
    return v;
}
__device__ __forceinline__ float wave_incl_max(float v, int lane) {
#pragma unroll
    for (int o = 1; o < 64; o <<= 1) { const float t = shup(v, o, lane); if (lane >= o) v = fmaxf(v, t); }
    return v;
}
__device__ __forceinline__ void mlstm_a(CArgs* A, LAS unsigned char* lds, int G, const int bx, const int tid) {
    unsigned char* ws = A->ws; const int lane = tid & 63;
    LAS float* kf = (LAS float*)lds;
    LAS float* vw = kf + 4096;
    LAS float* wl = vw + 8192;
    const float* gates = (const float*)(ws + WS_GATES); const bf16* K0 = (const bf16*)(ws + WS_K0); const bf16* V0 = (const bf16*)(ws + WS_V0);
    float* cloc = (float*)(ws + WS_CLOC); float* nloc = (float*)(ws + WS_NLOC); float* mloc = (float*)(ws + WS_MLOC); float* glast = (float*)(ws + WS_GLAST);
    for (int unit = bx; unit < NB_ * ML_H * ML_NC; unit += G) {
        const int bh = unit >> 6, c = unit & 63, b = bh >> 3, h = bh & 7, row0 = b * SEQ + c * ML_L;
        if (tid < 64) {
            const float li = gates[(size_t)(row0 + tid) * 16 + h], lf = gates[(size_t)(row0 + tid) * 16 + 8 + h];
            const float g = wave_incl_scan(lf, lane); const float gl = shidx(g, 63);
            const float a = gl - g + li; const float ml = wave_max(a, lane);
            wl[tid] = expf(a - ml);
            if (tid == 0) { mloc[unit] = ml; glast[unit] = gl; }
        }
        __syncthreads();
        { const int s = tid >> 3, kc = (tid & 7) * 8; const v4u kk = *(const v4u*)(K0 + (size_t)(row0 + s) * 512 + h * 64 + kc); LAS float* d = kf + s * 64 + kc;
          d[0] = bf_lo(kk.x); d[1] = bf_hi(kk.x); d[2] = bf_lo(kk.y); d[3] = bf_hi(kk.y); d[4] = bf_lo(kk.z); d[5] = bf_hi(kk.z); d[6] = bf_lo(kk.w); d[7] = bf_hi(kk.w);
          const int vc = (tid & 7) * 16; const float w = wl[s]; const v4u v0 = *(const v4u*)(V0 + (size_t)(row0 + s) * 1024 + h * 128 + vc), v1 = *(const v4u*)(V0 + (size_t)(row0 + s) * 1024 + h * 128 + vc + 8);
          LAS float* e = vw + s * 128 + vc;
          e[0] = w * bf_lo(v0.x); e[1] = w * bf_hi(v0.x); e[2] = w * bf_lo(v0.y); e[3] = w * bf_hi(v0.y); e[4] = w * bf_lo(v0.z); e[5] = w * bf_hi(v0.z); e[6] = w * bf_lo(v0.w); e[7] = w * bf_hi(v0.w);
          e[8] = w * bf_lo(v1.x); e[9] = w * bf_hi(v1.x); e[10] = w * bf_lo(v1.y); e[11] = w * bf_hi(v1.y); e[12] = w * bf_lo(v1.z); e[13] = w * bf_hi(v1.z); e[14] = w * bf_lo(v1.w); e[15] = w * bf_hi(v1.w); }
        __syncthreads();
        { const int v = tid >> 2, kg = (tid & 3) * 16; float acc[16];
#pragma unroll
          for (int i = 0; i < 16; ++i) acc[i] = 0.f;
          for (int s = 0; s < 64; ++s) { const float a = vw[s * 128 + v];
#pragma unroll
              for (int i = 0; i < 16; ++i) acc[i] += a * kf[s * 64 + kg + i]; }
          float* o = cloc + (size_t)unit * 8192 + v * 64 + kg;
#pragma unroll
          for (int i = 0; i < 4; ++i) *(f32x4*)(o + 4 * i) = (f32x4){acc[4 * i], acc[4 * i + 1], acc[4 * i + 2], acc[4 * i + 3]};
          if (tid < 64) { float n = 0.f; for (int s = 0; s < 64; ++s) n += wl[s] * kf[s * 64 + tid]; nloc[(size_t)unit * 64 + tid] = n; } }
        __syncthreads();
    }
}
__device__ __forceinline__ void mlstm_scan(CArgs* A, int G, const int bx, const int tid) {
    unsigned char* ws = A->ws;
    float* cloc = (float*)(ws + WS_CLOC); float* nloc = (float*)(ws + WS_NLOC); const float* mloc = (const float*)(ws + WS_MLOC); const float* glast = (const float*)(ws + WS_GLAST); float* mprev = (float*)(ws + WS_MPREV);
    for (int su = bx; su < 64 * 4; su += G) {
        const int bh = su >> 2, qt = su & 3;
        float* cp = cloc + (size_t)bh * 64 * 8192 + qt * 2048 + tid * 4;
        f32x4 C = (f32x4){0.f, 0.f, 0.f, 0.f}; float n = 0.f, m = 0.f;
        for (int c = 0; c < 64; ++c) {
            const float ml = mloc[bh * 64 + c], gl = glast[bh * 64 + c];
            const float mn = fmaxf(gl + m, ml), sp = expf(gl + m - mn), sl = expf(ml - mn);
            const f32x4 cl = *(const f32x4*)(cp + (size_t)c * 8192);
            *(f32x4*)(cp + (size_t)c * 8192) = C;
            C = C * sp + cl * sl;
            if (qt == 0 && tid < 64) { float* np = nloc + (size_t)(bh * 64 + c) * 64 + tid; const float nl = *np; *np = n; n = sp * n + sl * nl; }
            if (qt == 0 && tid == 0) mprev[bh * 64 + c] = m;
            m = mn;
        }
    }
}
__device__ __forceinline__ void mlstm_c(CArgs* A, LAS unsigned char* lds, int G, const int bx, const int tid) {
    unsigned char* ws = A->ws; const int lane = tid & 63;
    LAS float* qf = (LAS float*)lds;
    LAS float* kf = qf + 4096;
    LAS float* vf = kf + 4096;
    LAS float* cp = vf + 8192;
    LAS float* Sm = cp + 128 * 65;
    LAS float* sc = Sm + 64 * 65;
    const float* gates = (const float*)(ws + WS_GATES); const bf16* Q0 = (const bf16*)(ws + WS_Q0); const bf16* K0 = (const bf16*)(ws + WS_K0); const bf16* V0 = (const bf16*)(ws + WS_V0);
    const bf16* OG = (const bf16*)(ws + WS_OG); bf16* HC = (bf16*)(ws + WS_V0);
    const float* cprev = (const float*)(ws + WS_CLOC); const float* nprev = (const float*)(ws + WS_NLOC); const float* mprev = (const float*)(ws + WS_MPREV);
    const float* mh_gain = A->in[5];
    for (int unit = bx; unit < NB_ * ML_H * ML_NC; unit += G) {
        const int bh = unit >> 6, c = unit & 63, b = bh >> 3, h = bh & 7, row0 = b * SEQ + c * ML_L;
        if (tid < 64) {
            const float li = gates[(size_t)(row0 + tid) * 16 + h], lf = gates[(size_t)(row0 + tid) * 16 + 8 + h];
            const float g = wave_incl_scan(lf, lane);
            const float pm = wave_incl_max(li - g, lane);
            const float mintra = g + pm, minter = g + mprev[unit], mc = fmaxf(minter, mintra);
            sc[tid] = g; sc[64 + tid] = li; sc[128 + tid] = mc; sc[192 + tid] = expf(minter - mc); sc[320 + tid] = nprev[(size_t)unit * 64 + tid];
        }
        { const int s = tid >> 3, kc = (tid & 7) * 8;
          const v4u qq = *(const v4u*)(Q0 + (size_t)(row0 + s) * 512 + h * 64 + kc); LAS float* dq = qf + s * 64 + kc;
          dq[0] = bf_lo(qq.x); dq[1] = bf_hi(qq.x); dq[2] = bf_lo(qq.y); dq[3] = bf_hi(qq.y); dq[4] = bf_lo(qq.z); dq[5] = bf_hi(qq.z); dq[6] = bf_lo(qq.w); dq[7] = bf_hi(qq.w);
          const v4u kk = *(const v4u*)(K0 + (size_t)(row0 + s) * 512 + h * 64 + kc); LAS float* d = kf + s * 64 + kc;
          d[0] = bf_lo(kk.x); d[1] = bf_hi(kk.x); d[2] = bf_lo(kk.y); d[3] = bf_hi(kk.y); d[4] = bf_lo(kk.z); d[5] = bf_hi(kk.z); d[6] = bf_lo(kk.w); d[7] = bf_hi(kk.w);
          const int vc = (tid & 7) * 16; const v4u v0 = *(const v4u*)(V0 + (size_t)(row0 + s) * 1024 + h * 128 + vc), v1 = *(const v4u*)(V0 + (size_t)(row0 + s) * 1024 + h * 128 + vc + 8);
          LAS float* e = vf + s * 128 + vc;
          e[0] = bf_lo(v0.x); e[1] = bf_hi(v0.x); e[2] = bf_lo(v0.y); e[3] = bf_hi(v0.y); e[4] = bf_lo(v0.z); e[5] = bf_hi(v0.z); e[6] = bf_lo(v0.w); e[7] = bf_hi(v0.w);
          e[8] = bf_lo(v1.x); e[9] = bf_hi(v1.x); e[10] = bf_lo(v1.y); e[11] = bf_hi(v1.y); e[12] = bf_lo(v1.z); e[13] = bf_hi(v1.z); e[14] = bf_lo(v1.w); e[15] = bf_hi(v1.w);
          const float* cs = cprev + (size_t)unit * 8192;
#pragma unroll
          for (int i = 0; i < 4; ++i) { const int e4 = tid * 4 + i * 2048; const f32x4 cv = *(const f32x4*)(cs + e4); const int v = e4 >> 6, k = e4 & 63; LAS float* dd = cp + v * 65 + k; dd[0] = cv[0]; dd[1] = cv[1]; dd[2] = cv[2]; dd[3] = cv[3]; } }
        __syncthreads();
        { const int j = tid >> 3, sg = (tid & 7) * 8; const float gj = sc[j], mcj = sc[128 + j];
#pragma unroll
          for (int i = 0; i < 8; ++i) { const int s = sg + i; float d = 0.f;
              for (int k = 0; k < 64; ++k) d += qf[j * 64 + k] * kf[s * 64 + k];
              Sm[j * 65 + s] = (s <= j) ? d * expf(gj - sc[s] + sc[64 + s] - mcj) : 0.f; } }
        __syncthreads();
        if (tid < 64) { const int j = tid; float qn = 0.f, rsum = 0.f;
            for (int k = 0; k < 64; ++k) qn += qf[j * 64 + k] * sc[320 + k];
            for (int s = 0; s < 64; ++s) rsum += Sm[j * 65 + s];
            const float dn = sc[192 + j] * qn + rsum; sc[256 + j] = fmaxf(fabsf(dn), expf(-sc[128 + j])); }
        const int j = tid >> 3, vg = (tid & 7) * 16; float acc[16];
        { const float wi = sc[192 + j];
#pragma unroll
          for (int i = 0; i < 16; ++i) acc[i] = 0.f;
          for (int k = 0; k < 64; ++k) { const float q = qf[j * 64 + k];
#pragma unroll
              for (int i = 0; i < 16; ++i) acc[i] += q * cp[(vg + i) * 65 + k]; }
#pragma unroll
          for (int i = 0; i < 16; ++i) acc[i] *= wi;
          for (int s = 0; s < 64; ++s) { const float p = Sm[j * 65 + s];
#pragma unroll
              for (int i = 0; i < 16; ++i) acc[i] += p * vf[s * 128 + vg + i]; } }
        __syncthreads();
        { const float inv = 1.0f / sc[256 + j]; float ss = 0.f;
#pragma unroll
          for (int i = 0; i < 16; ++i) { acc[i] *= inv; ss += acc[i] * acc[i]; }
          ss += shx(ss, 1, lane); ss += shx(ss, 2, lane); ss += shx(ss, 4, lane);
          const float rn = __builtin_amdgcn_rsqf(ss * (1.0f / ML_DV) + EPS);
          const size_t off = (size_t)(row0 + j) * 1024 + h * 128 + vg;
          const v4u o0 = *(const v4u*)(OG + off), o1 = *(const v4u*)(OG + off + 8);
          float og[16] = {bf_lo(o0.x), bf_hi(o0.x), bf_lo(o0.y), bf_hi(o0.y), bf_lo(o0.z), bf_hi(o0.z), bf_lo(o0.w), bf_hi(o0.w), bf_lo(o1.x), bf_hi(o1.x), bf_lo(o1.y), bf_hi(o1.y), bf_lo(o1.z), bf_hi(o1.z), bf_lo(o1.w), bf_hi(o1.w)};
          float r[16];
#pragma unroll
          for (int i = 0; i < 16; ++i) r[i] = acc[i] * rn * mh_gain[vg + i] * sigmoidf_(og[i]);
          v4u w0, w1; w0.x = pk2(r[0], r[1]); w0.y = pk2(r[2], r[3]); w0.z = pk2(r[4], r[5]); w0.w = pk2(r[6], r[7]); w1.x = pk2(r[8], r[9]); w1.y = pk2(r[10], r[11]); w1.z = pk2(r[12], r[13]); w1.w = pk2(r[14], r[15]);
          *(v4u*)(HC + off) = w0; *(v4u*)(HC + off + 8) = w1; }
        __syncthreads();
    }
}

__device__ __forceinline__ void moba_fixup(CArgs* A, LAS unsigned char* lds, int G, const int bx, const int tid) {
    unsigned char* ws = A->ws;
    bf16* Q1 = (bf16*)(ws + WS_Q1); bf16* K1 = (bf16*)(ws + WS_K1); float* kmp = (float*)(ws + WS_KMP);
    const float* rc = (const float*)(ws + WS_ROPE); const float* rsn = rc + SEQ * 8;
    const float* qg = A->in[11]; const float* kg = A->in[9];
    LAS float* ks = (LAS float*)lds;
    for (int unit = bx; unit < M / 128; unit += G) {
        const int r0 = unit * 128;
        for (int it = tid; it < 128 * 20; it += NTHREADS) {
            const int rl = it / 20, hh = it % 20, row = r0 + rl, pos = row & (SEQ - 1);
            bf16* p = (hh < 16) ? Q1 + (size_t)row * 1024 + hh * 64 : K1 + (size_t)row * 256 + (hh - 16) * 64;
            const float* gn = (hh < 16) ? qg : kg;
            float v[64]; float ss = 0.f;
#pragma unroll
            for (int i = 0; i < 8; ++i) { const v4u w = *(const v4u*)(p + 8 * i); v[8 * i] = bf_lo(w.x); v[8 * i + 1] = bf_hi(w.x); v[8 * i + 2] = bf_lo(w.y); v[8 * i + 3] = bf_hi(w.y); v[8 * i + 4] = bf_lo(w.z); v[8 * i + 5] = bf_hi(w.z); v[8 * i + 6] = bf_lo(w.w); v[8 * i + 7] = bf_hi(w.w); }
#pragma unroll
            for (int i = 0; i < 64; ++i) ss += v[i] * v[i];
            const float rn = __builtin_amdgcn_rsqf(ss * (1.0f / 64.0f) + EPS);
#pragma unroll
            for (int i = 0; i < 64; ++i) v[i] = v[i] * rn * gn[i];
#pragma unroll
            for (int i = 0; i < 8; ++i) { const float cs = rc[pos * 8 + i], sn = rsn[pos * 8 + i]; const float x1 = v[i], x2 = v[8 + i]; v[i] = x1 * cs - x2 * sn; v[8 + i] = x2 * cs + x1 * sn; }
#pragma unroll
            for (int i = 0; i < 8; ++i) { v4u w; w.x = pk2(v[8 * i], v[8 * i + 1]); w.y = pk2(v[8 * i + 2], v[8 * i + 3]); w.z = pk2(v[8 * i + 4], v[8 * i + 5]); w.w = pk2(v[8 * i + 6], v[8 * i + 7]); *(v4u*)(p + 8 * i) = w; }
            if (hh >= 16) { LAS float* kd = ks + (rl * 4 + (hh - 16)) * 64;
#pragma unroll
                for (int i = 0; i < 64; ++i) kd[i] = v[i]; }
        }
        __syncthreads();
        if (tid < 256) { float s = 0.f; for (int r = 0; r < 128; ++r) s += ks[r * 256 + tid]; kmp[(size_t)unit * 256 + tid] = s; }
        __syncthreads();
    }
}
__device__ __forceinline__ void moba_attn(CArgs* A, LAS unsigned char* lds, int G, const int bx, const int tid) {
    unsigned char* ws = A->ws; const int lane = tid & 63, wave = tid >> 6;
    const bf16* Q1 = (const bf16*)(ws + WS_Q1); const bf16* K1 = (const bf16*)(ws + WS_K1); const bf16* V1 = (const bf16*)(ws + WS_V1); const float* kmp = (const float*)(ws + WS_KMP);
    bf16* AO = (bf16*)(ws + WS_AO);
    LAS float* qs = (LAS float*)lds + wave * 1088; LAS float* ps = qs + 64;
    const int nitems = M * MB_H / NWAVES;
    for (int it = bx; it < nitems; it += G) {
        const int item = it * NWAVES + wave, row = item >> 4, h = item & 15, kvh = h >> 2, b = row >> 12, t = row & (SEQ - 1), qb = t >> 8;
        { const bf16 qv = Q1[(size_t)row * 1024 + h * 64 + lane]; qs[lane] = __builtin_bit_cast(float, (unsigned)qv << 16); }
        asm volatile("s_waitcnt lgkmcnt(0)" ::: "memory");
        float q[64];
#pragma unroll
        for (int i = 0; i < 16; ++i) { const f32x4 t4 = *(const LAS f32x4*)(qs + 4 * i); q[4 * i] = t4[0]; q[4 * i + 1] = t4[1]; q[4 * i + 2] = t4[2]; q[4 * i + 3] = t4[3]; }
        float gv = -INFINITY;
        if (lane < qb) { const float* k0 = kmp + (size_t)((b * 32 + 2 * lane) * 4 + kvh) * 64; const float* k1 = k0 + 256; float s = 0.f;
#pragma unroll
            for (int i = 0; i < 16; ++i) { const f32x4 a = *(const f32x4*)(k0 + 4 * i) + *(const f32x4*)(k1 + 4 * i); s += (q[4 * i] * a[0] + q[4 * i + 1] * a[1]) + (q[4 * i + 2] * a[2] + q[4 * i + 3] * a[3]); }
            gv = s; }
        int sel0 = 0, sel1 = 0, sel2 = 0;
#pragma unroll
        for (int r = 0; r < 3; ++r) { float mv = gv; int mi = lane;
#pragma unroll
            for (int o = 32; o >= 1; o >>= 1) { const float ov = shx(mv, o, lane); const int oi = shxi(mi, o, lane); if (ov > mv || (ov == mv && oi < mi)) { mv = ov; mi = oi; } }
            const int sr = __builtin_amdgcn_readfirstlane(mi); if (lane == sr) gv = -INFINITY;
            if (r == 0) sel0 = sr; else if (r == 1) sel1 = sr; else sel2 = sr; }
        const int nvalid = qb < 3 ? qb : 3;
        float mx = -INFINITY;
#pragma unroll 1
        for (int jj = 0; jj < 16; ++jj) {
            const int j = jj >> 2, i = jj & 3; const bool active = (j == 3) || (j < nvalid); const int nblk = j == 0 ? sel0 : (j == 1 ? sel1 : (j == 2 ? sel2 : qb));
            float sv = -INFINITY;
            if (active) { const int pos = nblk * 256 + i * 64 + lane; const bf16* kp = K1 + (size_t)(b * SEQ + pos) * 256 + kvh * 64; float d = 0.f;
#pragma unroll
                for (int e = 0; e < 8; ++e) { const v4u w = *(const v4u*)(kp + 8 * e);
                    d += q[8 * e] * bf_lo(w.x) + q[8 * e + 1] * bf_hi(w.x) + q[8 * e + 2] * bf_lo(w.y) + q[8 * e + 3] * bf_hi(w.y) + q[8 * e + 4] * bf_lo(w.z) + q[8 * e + 5] * bf_hi(w.z) + q[8 * e + 6] * bf_lo(w.w) + q[8 * e + 7] * bf_hi(w.w); }
                sv = d * 0.125f; if (j == 3 && pos > t) sv = -INFINITY; }
            ps[jj * 64 + lane] = sv; mx = fmaxf(mx, sv);
        }
        mx = wave_max(mx, lane);
        float l = 0.f;
        float o[64];
#pragma unroll
        for (int i = 0; i < 64; ++i) o[i] = 0.f;
#pragma unroll 1
        for (int jj = 0; jj < 16; ++jj) {
            const int j = jj >> 2, i = jj & 3; const bool active = (j == 3) || (j < nvalid); const int nblk = j == 0 ? sel0 : (j == 1 ? sel1 : (j == 2 ? sel2 : qb));
            if (active) { const int pos = nblk * 256 + i * 64 + lane; const bf16* vp = V1 + (size_t)(b * SEQ + pos) * 256 + kvh * 64; const float p = __expf(ps[jj * 64 + lane] - mx); l += p;
#pragma unroll
                for (int e = 0; e < 8; ++e) { const v4u w = *(const v4u*)(vp + 8 * e);
                    o[8 * e] += p * bf_lo(w.x); o[8 * e + 1] += p * bf_hi(w.x); o[8 * e + 2] += p * bf_lo(w.y); o[8 * e + 3] += p * bf_hi(w.y); o[8 * e + 4] += p * bf_lo(w.z); o[8 * e + 5] += p * bf_hi(w.z); o[8 * e + 6] += p * bf_lo(w.w); o[8 * e + 7] += p * bf_hi(w.w); } }
        }
        l = wave_sum(l, lane);
#define RED_STEP(OFF, N) _Pragma("unroll") for (int i = 0; i < (N) / 2; ++i) { const bool up = (lane & (OFF)) != 0; const float send = up ? o[i] : o[i + (N) / 2]; const float keep = up ? o[i + (N) / 2] : o[i]; o[i] = keep + shx(send, OFF, lane); }
        RED_STEP(32, 64) RED_STEP(16, 32) RED_STEP(8, 16) RED_STEP(4, 8) RED_STEP(2, 4) RED_STEP(1, 2)
#undef RED_STEP
        AO[(size_t)row * 1024 + h * 64 + lane] = (bf16)f2bf(o[0] / l);
        asm volatile("s_waitcnt lgkmcnt(0)" ::: "memory");
    }
}

constexpr int N_PHASES = 18;
#define PHASE_TID() unsigned ones_ = ones; asm volatile("" : "+s"(ones_)); const int tid = (wave_s << 6) | (int)__builtin_amdgcn_mbcnt_hi(ones_, __builtin_amdgcn_mbcnt_lo(ones_, 0u));
__device__ __forceinline__ void run_phase(const int ph, CArgs* ap, LAS unsigned char* lds, const int G, const int bx, const int wave_s, const unsigned ones) {
    const int vcu = (G % 8 == 0) ? (bx % 8) * (G / 8) + bx / 8 : bx;
    CArgs* A = ap;
    unsigned char* ws = A->ws;
    const int l = ph >= 10 ? 1 : 0;
    bf16* HB0 = (bf16*)(ws + WS_HB); bf16* HB1 = (bf16*)(ws + WS_HB2); float* SSQ0 = (float*)(ws + WS_SSQ); float* SSQ1 = SSQ0 + (size_t)M * 16;
    bf16* HBl = l ? HB1 : HB0; bf16* HBo = l ? HB0 : HB1; float* SSQl = l ? SSQ1 : SSQ0; float* SSQo = l ? SSQ0 : SSQ1;
    float* OUT = A->out;
    switch (ph) {
    case 0: { PHASE_TID() p0_prologue(A, lds, G, vcu, wave_s, tid & 63); } break;
    case 1: { PHASE_TID() pg8::Gemm g{HB0, (const bf16*)(ws + WS_WIN), M, ML_INP, D}; pg8::StaticOrder S; S.init(M, ML_INP, G, bx);
        EpiMl E{ws, (float*)(ws + WS_GATES), SSQ0, A->in[4]};
        pg8::gemm_phase<EpiMl, pg8::StaticOrder, true, true>(lds, g, S, E, tid); } break;
    case 2: { PHASE_TID() mlstm_a(A, lds, G, bx, tid); } break;
    case 3: { PHASE_TID() mlstm_scan(A, G, bx, tid); } break;
    case 4: { PHASE_TID() mlstm_c(A, lds, G, bx, tid); } break;
    case 5: { PHASE_TID() pg8::Gemm g{(const bf16*)(ws + WS_V0), (const bf16*)(ws + WS_WOUT), M, D, D}; pg8::StaticOrder S; S.init(M, D, G, bx);
        EpiRes E{A->in[0], OUT, HB0, SSQ0};
        pg8::gemm_phase<EpiRes, pg8::StaticOrder, true, true>(lds, g, S, E, tid); } break;
    case 10: { PHASE_TID() pg8::Gemm g{HB1, (const bf16*)(ws + WS_WQKV1), M, 1536, D}; pg8::StaticOrder S; S.init(M, 1536, G, bx);
        EpiQkv1 E{ws, SSQ1};
        pg8::gemm_phase<EpiQkv1, pg8::StaticOrder, true, true>(lds, g, S, E, tid); } break;
    case 11: { PHASE_TID() moba_fixup(A, lds, G, bx, tid); } break;
    case 12: { PHASE_TID() moba_attn(A, lds, G, bx, tid); } break;
    case 13: case 7: case 15: {
        PHASE_TID() const bool dn = ph != 13;
        pg8::Gemm g{(const bf16*)(ws + (dn ? WS_ACT : WS_AO)), (const bf16*)(ws + (dn ? WS_WDN + l * 6 * MiB : WS_WO1)), M, D, dn ? FF : D}; pg8::StaticOrder S; S.init(M, D, G, bx);
        EpiRes E{OUT, OUT, HBl, SSQl};
        pg8::gemm_phase<EpiRes, pg8::StaticOrder, true, true>(lds, g, S, E, tid); } break;
    case 6: case 14: { PHASE_TID() pg8::Gemm g{HBl, (const bf16*)(ws + WS_WGU + l * 11 * MiB), M, 2 * FF, D}; pg8::StaticOrder S; S.init(M, 2 * FF, G, bx);
        EpiSwiglu E{(bf16*)(ws + WS_ACT), SSQl};
        pg8::gemm_phase<EpiSwiglu, pg8::StaticOrder, true, true>(lds, g, S, E, tid); } break;
    case 8: case 16: { PHASE_TID() pg8::Gemm g{(const bf16*)(ws + WS_PB) + (size_t)l * M * PLE, (const bf16*)(ws + WS_WPU + l * (MiB / 2)), M, D, PLE}; pg8::StaticOrder S; S.init(M, D, G, bx);
        EpiPlain E{(bf16*)(ws + WS_UP), D};
        pg8::gemm_phase<EpiPlain, pg8::StaticOrder, true, true>(lds, g, S, E, tid); } break;
    case 9: case 17: { PHASE_TID() pg8::Gemm g{HBl, (const bf16*)(ws + WS_WPG + l * 2 * MiB), M, D, D}; pg8::StaticOrder S; S.init(M, D, G, bx);
        EpiPle E{OUT, OUT, HBo, SSQo, SSQl, (const bf16*)(ws + WS_UP)};
        pg8::gemm_phase<EpiPle, pg8::StaticOrder, true, true>(lds, g, S, E, tid); } break;
    default: break;
    }
}
#ifndef PHASE_MASK
#define PHASE_MASK 0xFFFFFFFFu
#endif
__global__ void __launch_bounds__(NTHREADS, 2) yoco_fwd(Args args) {
    extern __shared__ __attribute__((aligned(16))) unsigned char lds_raw[];
    LAS unsigned char* lds = (LAS unsigned char*)lds_raw;
    volatile LAS unsigned* MISC = (volatile LAS unsigned*)(lds + LDSCTL_OFF);
    for (int u = threadIdx.x; u < (LDS_BYTES - LDSCTL_OFF) / 4; u += NTHREADS) ((LAS unsigned*)(lds + LDSCTL_OFF))[u] = 0u;
    __syncthreads();
    XcdBarrier bar; bar.bar = (unsigned*)(args.ws + WS_CTL) + 4096; bar.x = 0; bar.st = nullptr;
    if (MK_N_LAUNCHES == 1) bar = xcd_barrier_post((unsigned*)(args.ws + WS_CTL) + 4096, MISC + 8);
    const int lo = args.ph_lo, hi = args.ph_hi;
    const int wave_s = __builtin_amdgcn_readfirstlane(threadIdx.x >> 6);
#pragma unroll 1
    for (int ph = lo; ph < hi; ++ph) {
        CArgs* ap = (CArgs*)__builtin_amdgcn_kernarg_segment_ptr(); unsigned ones = ~0u; int G = gridDim.x, bx = blockIdx.x;
        asm volatile("" : "+s"(ap), "+s"(ones), "+s"(G), "+s"(bx));
        if ((PHASE_MASK >> ph) & 1u) run_phase(ph, ap, lds, G, bx, wave_s, ones);
        if (ph + 1 < hi) { XcdBarrier b2 = bar; asm volatile("" : "+s"(b2.bar)); xcd_barrier(b2); }
    }
}

extern "C" void kernel_launch(void* const* d_in, const int* in_sizes, int n_in, void* d_out, int out_size, void* d_ws, size_t ws_size, hipStream_t stream) {
    static int grid = 0;
    if (grid == 0) {
        if (n_in != 19 || in_sizes[0] != M * D || out_size != M * D || ws_size < WS_END) { fprintf(stderr, "kernel_launch: unexpected shapes (n_in %d, in0 %d, out %d, ws %zu); nothing launched\n", n_in, n_in > 0 ? in_sizes[0] : -1, out_size, ws_size); grid = -1; return; }
        int dev = 0, cus = 0, per_cu = 0;
        if (hipGetDevice(&dev) != hipSuccess || hipDeviceGetAttribute(&cus, hipDeviceAttributeMultiprocessorCount, dev) != hipSuccess) { grid = -1; return; }
        if (hipFuncSetAttribute((const void*)yoco_fwd, hipFuncAttributeMaxDynamicSharedMemorySize, LDS_BYTES) != hipSuccess) { fprintf(stderr, "kernel_launch: hipFuncSetAttribute failed\n"); grid = -1; return; }
        if (hipOccupancyMaxActiveBlocksPerMultiprocessor(&per_cu, (const void*)yoco_fwd, NTHREADS, LDS_BYTES) != hipSuccess || per_cu < 1) { fprintf(stderr, "kernel_launch: occupancy query says %d blocks per CU\n", per_cu); per_cu = 1; }
        (void)hipGetLastError();
        grid = cus;
    }
    if (grid < 0) return;
    (void)hipMemsetAsync((char*)d_ws + WS_CTL, 0, CTL_ZERO_BYTES, stream);
    Args a{};
    for (int i = 0; i < 19; ++i) a.in[i] = (const float*)d_in[i];
    a.out = (float*)d_out; a.ws = (unsigned char*)d_ws;
    if (MK_N_LAUNCHES == 1) {
        a.ph_lo = 0; a.ph_hi = N_PHASES;
        hipLaunchKernelGGL(yoco_fwd, dim3(grid), dim3(NTHREADS), LDS_BYTES, stream, a);
    } else {
        for (int p = 0; p < N_PHASES; ++p) { a.ph_lo = p; a.ph_hi = p + 1; hipLaunchKernelGGL(yoco_fwd, dim3(grid), dim3(NTHREADS), LDS_BYTES, stream, a); }
    }
}
```

```cpp
#include <hip/hip_runtime.h>
#include <cstdio>
#include <cstdint>

#ifndef MK_N_LAUNCHES
#define MK_N_LAUNCHES 1
#endif

#define LAS __attribute__((address_space(3)))
#define GAS __attribute__((address_space(1)))

namespace pg8 {
#define PG8_LAS __attribute__((address_space(3)))
typedef unsigned short bf16_t;
typedef short bf16x8 __attribute__((ext_vector_type(8)));
typedef float f32x4 __attribute__((ext_vector_type(4)));
typedef unsigned u32x4 __attribute__((ext_vector_type(4)));
typedef unsigned u32x2 __attribute__((ext_vector_type(2)));
constexpr int BM = 256, BK = 64, HALF = 128, HTB = HALF * BK * 2, STAGE_BYTES = 8 * HTB, NXCD = 8, WGM = 8;

__host__ __device__ __forceinline__ int lds_byte(int r, int c) { const int st = (r >> 4) * 2 + (c >> 5), rr = r & 15, cc = c & 31, ob = rr * 64 + cc * 2; return st * 1024 + (ob ^ (((ob >> 9) & 1) << 5)); }
__host__ __device__ __forceinline__ void stage_rc(int b, int& R, int& C) { const int st = b / 1024, sb = b % 1024, swz = sb ^ (((sb >> 9) & 1) << 5); R = (st >> 1) * 16 + swz / 64; C = (st & 1) * 32 + (swz % 64) / 2; }
__host__ __device__ __forceinline__ int perm32(int rho) { const int n = rho >> 4, i = rho & 15; return 8 * (i >> 2) + 4 * n + (i & 3); }

struct Unit { int pm, pn; };
struct Gemm { const bf16_t* A; const bf16_t* Bt; int M, N, K; };

struct StaticOrder {
    int nM, nN, nwg, G, c;
    __host__ __device__ void init(int M, int N, int G_, int c_) { nM = M / BM; nN = N / BM; nwg = nM * nN; G = G_; c = c_; }
    __host__ __device__ bool next(int i, Unit& u) const {
        const long L = (long)i * G + c; if (L >= nwg) return false;
        int wgid = (int)L; { const int q = nwg / NXCD, r = nwg % NXCD, xcd = wgid % NXCD, off = wgid / NXCD; wgid = (xcd < r ? xcd * (q + 1) : r * (q + 1) + (xcd - r) * q) + off; }
        const int nig = WGM * nN, gid = wgid / nig, fm = gid * WGM, gsz = (nM - fm) < WGM ? (nM - fm) : WGM;
        u.pm = fm + ((wgid % nig) % gsz); u.pn = (wgid % nig) / gsz; return true;
    }
    __device__ __forceinline__ void a_ready(const Unit&) const {}
    __device__ __forceinline__ void done(const Unit&) const {}
};

__device__ __forceinline__ unsigned cvt_pk_bf16(float lo, float hi) { unsigned r; asm volatile("v_cvt_pk_bf16_f32 %0, %1, %2" : "=v"(r) : "v"(lo), "v"(hi)); return r; }

template <class Epi, class Sched, bool ALIGN_EPI = false, bool SP2 = false>
__device__ __forceinline__ void gemm_phase(PG8_LAS unsigned char* lds, const Gemm g, const Sched& S, const Epi& E, const int tid) {
    const int wid = __builtin_amdgcn_readfirstlane(tid >> 6), lane = tid & 63, wr = wid >> 2, wc = wid & 3, fr = lane & 15, fq = lane >> 4;
    int K_ = g.K; asm volatile("" : "+s"(K_));
    const int K = K_, nt = K / BK;
    unsigned voffA[2], voffB[2];
#pragma unroll
    for (int i = 0; i < 2; ++i) { int R, C; stage_rc(tid * 16 + i * 8192, R, C); const int Rb = Epi::PERM ? ((R & ~31) + perm32(R & 31)) : R;
        voffA[i] = (unsigned)(R * K + C) * 2u; voffB[i] = (unsigned)(Rb * K + C) * 2u; }
    const size_t kstep = (size_t)(BK * 2);
    const size_t hstep = (size_t)HALF * K * 2;
    const size_t tstep = 2 * hstep;
    const unsigned ldsw = (unsigned)wid * 1024u;
    const int aoff = lds_byte(wr * 64 + fr, fq * 8), boff = lds_byte(wc * 32 + fr, fq * 8);
#define PG8_SA(b, h) (((b) * 2 + (h)) * HTB)
#define PG8_SB(b, h) ((4 + (b) * 2 + (h)) * HTB)
#define PG8_STAGE(bufoff, gbase, voff) do { _Pragma("unroll") for (int _i = 0; _i < 2; ++_i) \
        __builtin_amdgcn_global_load_lds((const unsigned*)((const char*)(gbase) + (voff)[_i]), (PG8_LAS unsigned*)(lds + (bufoff) + ldsw + _i * 8192), 16, 0, 0); } while (0)
#define PG8_LDA(dst, b, h) do { _Pragma("unroll") for (int m = 0; m < 4; ++m) _Pragma("unroll") for (int k = 0; k < 2; ++k) dst[m][k] = *(const PG8_LAS bf16x8*)(lds + PG8_SA(b, h) + aoff + m * 2048 + k * 1024); } while (0)
#define PG8_LDB(dst, b, h) do { _Pragma("unroll") for (int n = 0; n < 2; ++n) _Pragma("unroll") for (int k = 0; k < 2; ++k) dst[n][k] = *(const PG8_LAS bf16x8*)(lds + PG8_SB(b, h) + boff + n * 2048 + k * 1024); } while (0)
#define PG8_MMA(ai, bj, At, Bt) do { __builtin_amdgcn_s_setprio(1); _Pragma("unroll") for (int m = 0; m < 4; ++m) _Pragma("unroll") for (int n = 0; n < 2; ++n) _Pragma("unroll") for (int k = 0; k < 2; ++k) \
        acc[ai][bj][m][n] = __builtin_amdgcn_mfma_f32_16x16x32_bf16(Bt[n][k], At[m][k], acc[ai][bj][m][n], 0, 0, 0); __builtin_amdgcn_s_setprio(0); } while (0)
#define PG8_WAIT_V(n) asm volatile("s_waitcnt vmcnt(" #n ")" ::: "memory")
#define PG8_WAIT_L(n) asm volatile("s_waitcnt lgkmcnt(" #n ")" ::: "memory")
#define PG8_BAR __builtin_amdgcn_s_barrier()
#define PG8_SCHED __builtin_amdgcn_sched_barrier(0)
    Unit cur, nxt; int ui = 0;
    if (!S.next(0, cur)) return;
    f32x4 acc[2][2][4][2];
#pragma unroll
    for (int a = 0; a < 2; ++a)
#pragma unroll
        for (int b = 0; b < 2; ++b)
#pragma unroll
            for (int m = 0; m < 4; ++m)
#pragma unroll
                for (int n = 0; n < 2; ++n) acc[a][b][m][n] = (f32x4){0.f, 0.f, 0.f, 0.f};
    bf16x8 At[4][2], B0[2][2], B1[2][2];
    const char* cA = (const char*)g.A + (size_t)cur.pm * tstep; const char* cB = (const char*)g.Bt + (size_t)cur.pn * tstep;
    S.a_ready(cur);
    if constexpr (SP2) {
        PG8_STAGE(PG8_SB(0, 0), cB, voffB); PG8_STAGE(PG8_SB(0, 1), cB + hstep, voffB); PG8_STAGE(PG8_SA(0, 0), cA, voffA); PG8_STAGE(PG8_SA(0, 1), cA + hstep, voffA);
        if (wr == 1) PG8_BAR;
        PG8_WAIT_V(2); PG8_BAR;
        PG8_STAGE(PG8_SB(1, 0), cB + kstep, voffB); PG8_STAGE(PG8_SA(1, 0), cA + kstep, voffA); PG8_STAGE(PG8_SB(1, 1), cB + hstep + kstep, voffB);
        PG8_WAIT_V(6); PG8_BAR;
    } else {
        PG8_STAGE(PG8_SB(0, 0), cB, voffB); PG8_STAGE(PG8_SA(0, 0), cA, voffA); PG8_STAGE(PG8_SB(0, 1), cB + hstep, voffB); PG8_STAGE(PG8_SA(0, 1), cA + hstep, voffA);
        if (wr == 1) PG8_BAR;
        PG8_WAIT_V(4); PG8_BAR;
        PG8_STAGE(PG8_SB(1, 0), cB + kstep, voffB); PG8_STAGE(PG8_SA(1, 0), cA + kstep, voffA); PG8_STAGE(PG8_SB(1, 1), cB + hstep + kstep, voffB);
        PG8_WAIT_V(6); PG8_BAR;
    }
    for (;;) {
        const bool has_next = S.next(ui + 1, nxt);
        const char* nA = has_next ? (const char*)g.A + (size_t)nxt.pm * tstep : cA; const char* nB = has_next ? (const char*)g.Bt + (size_t)nxt.pn * tstep : cB;
        for (int t = 0; t < nt; t += 2) {
            const bool last = (t == nt - 2);
            const char* a1 = cA + (size_t)(t + 1) * kstep;
            const char* a2 = last ? nA : cA + (size_t)(t + 2) * kstep; const char* b2 = last ? nB : cB + (size_t)(t + 2) * kstep;
            const char* a3 = a2 + kstep; const char* b3 = b2 + kstep;
            if (last && has_next) S.a_ready(nxt);
            if constexpr (SP2) {
            PG8_LDB(B0, 0, 0); PG8_LDB(B1, 0, 1); PG8_SCHED; PG8_LDA(At, 0, 0); PG8_STAGE(PG8_SA(1, 1), a1 + hstep, voffA);
            PG8_WAIT_V(8); PG8_WAIT_L(0); PG8_BAR; PG8_MMA(0, 0, At, B0); PG8_MMA(0, 1, At, B1); PG8_BAR; PG8_SCHED;
            PG8_LDA(At, 0, 1); PG8_STAGE(PG8_SB(0, 0), b2, voffB); PG8_STAGE(PG8_SB(0, 1), b2 + hstep, voffB); PG8_STAGE(PG8_SA(0, 0), a2, voffA);
            PG8_WAIT_V(8); PG8_WAIT_L(0); PG8_BAR; PG8_MMA(1, 0, At, B0); PG8_MMA(1, 1, At, B1); PG8_BAR; PG8_SCHED;
            PG8_LDB(B0, 1, 0); PG8_LDB(B1, 1, 1); PG8_SCHED; PG8_LDA(At, 1, 0); PG8_STAGE(PG8_SA(0, 1), a2 + hstep, voffA);
            PG8_WAIT_V(8); PG8_WAIT_L(0); PG8_BAR; PG8_MMA(0, 0, At, B0); PG8_MMA(0, 1, At, B1); PG8_BAR; PG8_SCHED;
            PG8_LDA(At, 1, 1); PG8_STAGE(PG8_SB(1, 0), b3, voffB); PG8_STAGE(PG8_SB(1, 1), b3 + hstep, voffB); PG8_STAGE(PG8_SA(1, 0), a3, voffA);
            PG8_WAIT_V(8); PG8_WAIT_L(0); PG8_BAR; PG8_MMA(1, 0, At, B0); PG8_MMA(1, 1, At, B1); PG8_BAR; PG8_SCHED;
            } else {
            PG8_LDB(B0, 0, 0); PG8_SCHED; PG8_LDA(At, 0, 0); PG8_STAGE(PG8_SA(1, 1), a1 + hstep, voffA);
            PG8_WAIT_L(8); PG8_BAR; PG8_WAIT_L(0); PG8_MMA(0, 0, At, B0); PG8_BAR; PG8_SCHED;
            PG8_LDB(B1, 0, 1); PG8_STAGE(PG8_SB(0, 0), b2, voffB);
            PG8_BAR; PG8_WAIT_L(0); PG8_MMA(0, 1, At, B1); PG8_BAR;
            PG8_LDA(At, 0, 1); PG8_STAGE(PG8_SA(0, 0), a2, voffA);
            PG8_BAR; PG8_WAIT_L(0); PG8_MMA(1, 0, At, B0); PG8_BAR; PG8_SCHED;
            PG8_STAGE(PG8_SB(0, 1), b2 + hstep, voffB);
            PG8_WAIT_V(6); PG8_BAR; PG8_MMA(1, 1, At, B1); PG8_BAR;
            PG8_LDB(B0, 1, 0); PG8_SCHED; PG8_LDA(At, 1, 0); PG8_STAGE(PG8_SA(0, 1), a2 + hstep, voffA);
            PG8_WAIT_L(8); PG8_BAR; PG8_WAIT_L(0); PG8_MMA(0, 0, At, B0); PG8_BAR; PG8_SCHED;
            PG8_LDB(B1, 1, 1); PG8_STAGE(PG8_SB(1, 0), b3, voffB);
            PG8_BAR; PG8_WAIT_L(0); PG8_MMA(0, 1, At, B1); PG8_BAR;
            PG8_LDA(At, 1, 1); PG8_STAGE(PG8_SA(1, 0), a3, voffA);
            PG8_BAR; PG8_WAIT_L(0); PG8_MMA(1, 0, At, B0); PG8_BAR; PG8_SCHED;
            PG8_STAGE(PG8_SB(1, 1), b3 + hstep, voffB);
            PG8_WAIT_V(6); PG8_BAR; PG8_MMA(1, 1, At, B1); PG8_BAR;
            }
        }
        if constexpr (ALIGN_EPI) { if (wr == 0) PG8_BAR; }
        E(acc, cur, wr, wc, fr, fq); S.done(cur);
        if (!has_next) break;
#pragma unroll
        for (int a = 0; a < 2; ++a)
#pragma unroll
            for (int b = 0; b < 2; ++b)
#pragma unroll
                for (int m = 0; m < 4; ++m)
#pragma unroll
                    for (int n = 0; n < 2; ++n) acc[a][b][m][n] = (f32x4){0.f, 0.f, 0.f, 0.f};
        cur = nxt; cA = nA; cB = nB; ++ui;
        if constexpr (ALIGN_EPI) { if (wr == 1) PG8_BAR; }
    }
    PG8_WAIT_V(0);
    if constexpr (!ALIGN_EPI) { if (wr == 0) PG8_BAR; }
    PG8_BAR;
#undef PG8_SA
#undef PG8_SB
#undef PG8_STAGE
#undef PG8_LDA
#undef PG8_LDB
#undef PG8_MMA
#undef PG8_WAIT_V
#undef PG8_WAIT_L
#undef PG8_BAR
#undef PG8_SCHED
}
}

typedef unsigned short bf16;
typedef float f32x4 __attribute__((ext_vector_type(4)));
typedef unsigned v4u __attribute__((ext_vector_type(4)));
typedef unsigned v2u __attribute__((ext_vector_type(2)));
constexpr int NB_ = 8, SEQ = 4096, D = 1024, M = NB_ * SEQ;
constexpr int ML_H = 8, ML_DV = 128, ML_DQK = 64, ML_L = 64, ML_NC = SEQ / ML_L, ML_IN = 3088, ML_INP = 3328;
constexpr int MB_H = 16, MB_KVH = 4, MB_HD = 64, MB_BLK = 256, MB_NB = SEQ / MB_BLK;
constexpr int FF = 2816, PLE = 256;
constexpr float EPS = 1e-6f, GATE_CAP = 15.0f;
constexpr int NWAVES = 8, NTHREADS = 512;

constexpr size_t MiB = 1u << 20;
constexpr size_t WS_CTL = 0, CTL_ZERO_BYTES = 1 * MiB;
constexpr size_t WS_ROPE = 1 * MiB;
constexpr size_t WS_KMP = 1 * MiB + 512 * 1024;
constexpr size_t WS_SSQ = 2 * MiB;
constexpr size_t WS_GATES = 6 * MiB;
constexpr size_t WS_MLOC = 8 * MiB, WS_GLAST = WS_MLOC + 16384, WS_MPREV = WS_GLAST + 16384;
constexpr size_t WS_NLOC = 9 * MiB;
constexpr size_t WS_WIN = 10 * MiB, WS_WOUT = 17 * MiB, WS_WQKV1 = 19 * MiB, WS_WO1 = 22 * MiB, WS_WGU = 24 * MiB  , WS_WDN = 46 * MiB  , WS_WPG = 58 * MiB  , WS_WPU = 62 * MiB  ;
constexpr size_t WS_HB = 64 * MiB, WS_HB2 = 448 * MiB;
constexpr size_t WS_PB = 128 * MiB;
constexpr size_t WS_UP = 160 * MiB;
constexpr size_t WS_OG = 160 * MiB;
constexpr size_t WS_Q0 = 224 * MiB, WS_K0 = 256 * MiB, WS_V0 = 288 * MiB  , WS_CLOC = 384 * MiB  ;
constexpr size_t WS_ACT = 224 * MiB;
constexpr size_t WS_Q1 = 224 * MiB, WS_K1 = 288 * MiB, WS_V1 = 304 * MiB, WS_AO = 320 * MiB;
constexpr size_t WS_END = 512 * MiB;

constexpr int LDS_BYTES = 147456;
constexpr int RING_BYTES = 131072;
constexpr int LDSCTL_OFF = RING_BYTES;

__device__ __forceinline__ unsigned f2bf(float f) { unsigned u = __builtin_bit_cast(unsigned, f); return (u + 0x7fffu + ((u >> 16) & 1u)) >> 16; }
__device__ __forceinline__ unsigned pk2(float lo, float hi) { return pg8::cvt_pk_bf16(lo, hi); }
__device__ __forceinline__ float bf_lo(unsigned u) { return __builtin_bit_cast(float, u << 16); }
__device__ __forceinline__ float bf_hi(unsigned u) { return __builtin_bit_cast(float, u & 0xffff0000u); }
__device__ __forceinline__ float rstd_of(const float* ssq, int row) {
    const f32x4* p = (const f32x4*)(ssq + (size_t)row * 16);
    const f32x4 a = p[0], b = p[1], c = p[2], d = p[3];
    const float s = (((a[0] + a[1]) + (a[2] + a[3])) + ((b[0] + b[1]) + (b[2] + b[3]))) + (((c[0] + c[1]) + (c[2] + c[3])) + ((d[0] + d[1]) + (d[2] + d[3])));
    return __builtin_amdgcn_rsqf(s * (1.0f / D) + EPS);
}
__device__ __forceinline__ float sigmoidf_(float x) { return __builtin_amdgcn_rcpf(1.0f + __builtin_amdgcn_exp2f(-1.4426950408889634f * x)); }
__device__ __forceinline__ float shx(float v, int mask, int lane) { return __builtin_bit_cast(float, __builtin_amdgcn_ds_bpermute((lane ^ mask) << 2, __builtin_bit_cast(int, v))); }
__device__ __forceinline__ int shxi(int v, int mask, int lane) { return __builtin_amdgcn_ds_bpermute((lane ^ mask) << 2, v); }
__device__ __forceinline__ float shup(float v, int o, int lane) { return __builtin_bit_cast(float, __builtin_amdgcn_ds_bpermute((lane >= o ? lane - o : lane) << 2, __builtin_bit_cast(int, v))); }
__device__ __forceinline__ float shidx(float v, int src) { return __builtin_bit_cast(float, __builtin_amdgcn_ds_bpermute(src << 2, __builtin_bit_cast(int, v))); }
__device__ __forceinline__ float wave_sum(float v, int lane) {
#pragma unroll
    for (int o = 1; o < 64; o <<= 1) v += shx(v, o, lane);
    return v;
}
__device__ __forceinline__ float wave_max(float v, int lane) {
#pragma unroll
    for (int o = 1; o < 64; o <<= 1) v = fmaxf(v, shx(v, o, lane));
    return v;
}

using pg8::Unit; using pg8::HALF; using pg8::BM;
#define ROWS8 _Pragma("unroll") for (int ai = 0; ai < 2; ++ai) _Pragma("unroll") for (int m = 0; m < 4; ++m)

struct EpiMl {
    static constexpr bool PERM = true, AFTER_DRAIN = false;
    unsigned char* ws; float* gates; const float* ssq; const float* bgate;
    __device__ __forceinline__ void operator()(const f32x4 (&acc)[2][2][4][2], const Unit& u, int wr, int wc, int fr, int fq) const {
        const int row0 = u.pm * BM + wr * 64 + fr;
        float rs[2][4];
        ROWS8 { rs[ai][m] = rstd_of(ssq, row0 + ai * HALF + m * 16); }
        if (u.pn < 12) {
            const int t = u.pn < 2 ? 0 : (u.pn < 4 ? 1 : (u.pn < 8 ? 2 : 3));
            const size_t boff = t == 0 ? WS_Q0 : (t == 1 ? WS_K0 : (t == 2 ? WS_V0 : WS_OG));
            const int ld = t < 2 ? 512 : 1024, colt = (u.pn - (t == 0 ? 0 : (t == 1 ? 2 : (t == 2 ? 4 : 8)))) * 256; const float sc = t == 0 ? 0.125f : 1.f;
            bf16* base = (bf16*)(ws + boff);
            const int col0 = colt + wc * 32 + 8 * fq;
            ROWS8 { bf16* rowp = base + (size_t)(row0 + ai * HALF + m * 16) * ld + col0; const float r = rs[ai][m] * sc;
#pragma unroll
                for (int bj = 0; bj < 2; ++bj) { const f32x4 v0 = acc[ai][bj][m][0] * r, v1 = acc[ai][bj][m][1] * r; v4u w; w.x = pk2(v0[0], v0[1]); w.y = pk2(v0[2], v0[3]); w.z = pk2(v1[0], v1[1]); w.w = pk2(v1[2], v1[3]);
                    *(v4u*)(rowp + bj * HALF) = w; } }
        } else if (wc == 0 && fq < 2) {
            float bg[8];
#pragma unroll
            for (int j = 0; j < 8; ++j) bg[j] = bgate[8 * fq + j];
            ROWS8 { const int row = row0 + ai * HALF + m * 16; const float r = rs[ai][m]; float o[8];
#pragma unroll
                for (int j = 0; j < 8; ++j) { const float pre = acc[ai][0][m][j >> 2][j & 3] * r + bg[j]; const float c = GATE_CAP * tanhf(pre * (1.0f / GATE_CAP));
                    o[j] = (fq == 0) ? c : -log1pf(expf(-c)); }
                float* gp = gates + (size_t)row * 16 + 8 * fq; *(f32x4*)gp = (f32x4){o[0], o[1], o[2], o[3]}; *(f32x4*)(gp + 4) = (f32x4){o[4], o[5], o[6], o[7]}; }
        }
    }
};
struct EpiQkv1 {
    static constexpr bool PERM = true, AFTER_DRAIN = false;
    unsigned char* ws; const float* ssq;
    __device__ __forceinline__ void operator()(const f32x4 (&acc)[2][2][4][2], const Unit& u, int wr, int wc, int fr, int fq) const {
        const int row0 = u.pm * BM + wr * 64 + fr;
        const size_t boff = u.pn < 4 ? WS_Q1 : (u.pn == 4 ? WS_K1 : WS_V1); const int ld = u.pn < 4 ? 1024 : 256, colt = u.pn < 4 ? u.pn * 256 : 0;
        bf16* base = (bf16*)(ws + boff);
        const int col0 = colt + wc * 32 + 8 * fq;
        ROWS8 { const float r = rstd_of(ssq, row0 + ai * HALF + m * 16); bf16* rowp = base + (size_t)(row0 + ai * HALF + m * 16) * ld + col0;
#pragma unroll
            for (int bj = 0; bj < 2; ++bj) { const f32x4 v0 = acc[ai][bj][m][0] * r, v1 = acc[ai][bj][m][1] * r; v4u w; w.x = pk2(v0[0], v0[1]); w.y = pk2(v0[2], v0[3]); w.z = pk2(v1[0], v1[1]); w.w = pk2(v1[2], v1[3]);
                *(v4u*)(rowp + bj * HALF) = w; }
            if (m == 3) asm volatile("" ::: "memory"); }
    }
};
struct EpiPlain {
    static constexpr bool PERM = true, AFTER_DRAIN = false;
    bf16* O; int ld;
    __device__ __forceinline__ void operator()(const f32x4 (&acc)[2][2][4][2], const Unit& u, int wr, int wc, int fr, int fq) const {
        const int row0 = u.pm * BM + wr * 64 + fr, col0 = u.pn * BM + wc * 32 + 8 * fq;
        ROWS8 { bf16* rowp = O + (size_t)(row0 + ai * HALF + m * 16) * ld + col0;
#pragma unroll
            for (int bj = 0; bj < 2; ++bj) { const f32x4 v0 = acc[ai][bj][m][0], v1 = acc[ai][bj][m][1]; v4u w; w.x = pk2(v0[0], v0[1]); w.y = pk2(v0[2], v0[3]); w.z = pk2(v1[0], v1[1]); w.w = pk2(v1[2], v1[3]);
                *(v4u*)(rowp + bj * HALF) = w; } }
    }
};
struct EpiSwiglu {
    static constexpr bool PERM = true, AFTER_DRAIN = false;
    bf16* act; const float* ssq;
    __device__ __forceinline__ void operator()(const f32x4 (&acc)[2][2][4][2], const Unit& u, int wr, int wc, int fr, int fq) const {
        const int row0 = u.pm * BM + wr * 64 + fr, col0 = u.pn * HALF + wc * 32 + 8 * fq;
        ROWS8 { const float r = rstd_of(ssq, row0 + ai * HALF + m * 16); bf16* rowp = act + (size_t)(row0 + ai * HALF + m * 16) * FF + col0; float o[8];
#pragma unroll
            for (int n = 0; n < 2; ++n)
#pragma unroll
                for (int e = 0; e < 4; ++e) { const float gv = acc[ai][0][m][n][e] * r, uv = acc[ai][1][m][n][e] * r; o[4 * n + e] = gv * sigmoidf_(gv) * uv; }
            v4u w; w.x = pk2(o[0], o[1]); w.y = pk2(o[2], o[3]); w.z = pk2(o[4], o[5]); w.w = pk2(o[6], o[7]); *(v4u*)rowp = w;
            if (m == 3) asm volatile("" ::: "memory"); }
    }
};
struct EpiRes {
    static constexpr bool PERM = false, AFTER_DRAIN = false;
    const float* base; float* out; bf16* hb; float* ssq;
    __device__ __forceinline__ void operator()(const f32x4 (&acc)[2][2][4][2], const Unit& u, int wr, int wc, int fr, int fq) const {
        const int row0 = u.pm * BM + wr * 64 + fr, col0 = u.pn * BM + wc * 32 + 4 * fq;
        ROWS8 { const int row = row0 + ai * HALF + m * 16; const size_t off = (size_t)row * D + col0; float part = 0.f;
#pragma unroll
            for (int bj = 0; bj < 2; ++bj)
#pragma unroll
                for (int n = 0; n < 2; ++n) { const size_t o2 = off + bj * HALF + n * 16; const f32x4 o = *(const f32x4*)(base + o2) + acc[ai][bj][m][n];
                    *(f32x4*)(out + o2) = o; v2u w; w.x = pk2(o[0], o[1]); w.y = pk2(o[2], o[3]); *(v2u*)(hb + o2) = w; part += (o[0] * o[0] + o[1] * o[1]) + (o[2] * o[2] + o[3] * o[3]); }
            part += shx(part, 16, fr + 16 * fq); part += shx(part, 32, fr + 16 * fq);
            if (fq == 0) ssq[(size_t)row * 16 + 4 * u.pn + wc] = part;
            if (m & 1) asm volatile("" ::: "memory"); }
    }
};
struct EpiPle {
    static constexpr bool PERM = false, AFTER_DRAIN = false;
    const float* base; float* out; bf16* hb; float* ssq_out; const float* ssq_in; const bf16* up;
    __device__ __forceinline__ void operator()(const f32x4 (&acc)[2][2][4][2], const Unit& u, int wr, int wc, int fr, int fq) const {
        const int row0 = u.pm * BM + wr * 64 + fr, col0 = u.pn * BM + wc * 32 + 4 * fq;
        ROWS8 { const int row = row0 + ai * HALF + m * 16; const size_t off = (size_t)row * D + col0; const float r = rstd_of(ssq_in, row); float part = 0.f;
#pragma unroll
            for (int bj = 0; bj < 2; ++bj)
#pragma unroll
                for (int n = 0; n < 2; ++n) { const size_t o2 = off + bj * HALF + n * 16; const v2u uw = *(const v2u*)(up + o2); const f32x4 a = acc[ai][bj][m][n] * r;
                    f32x4 o = *(const f32x4*)(base + o2);
                    o[0] += bf_lo(uw.x) * sigmoidf_(a[0]); o[1] += bf_hi(uw.x) * sigmoidf_(a[1]); o[2] += bf_lo(uw.y) * sigmoidf_(a[2]); o[3] += bf_hi(uw.y) * sigmoidf_(a[3]);
                    *(f32x4*)(out + o2) = o; v2u w; w.x = pk2(o[0], o[1]); w.y = pk2(o[2], o[3]); *(v2u*)(hb + o2) = w; part += (o[0] * o[0] + o[1] * o[1]) + (o[2] * o[2] + o[3] * o[3]); }
            part += shx(part, 16, fr + 16 * fq); part += shx(part, 32, fr + 16 * fq);
            if (fq == 0) ssq_out[(size_t)row * 16 + 4 * u.pn + wc] = part;
            asm volatile("" ::: "memory"); }
    }
};

typedef GAS unsigned gu32;
#define RLX_AGENT __ATOMIC_RELAXED, __HIP_MEMORY_SCOPE_AGENT
#define XB_TMO      128
#define XB_XCNT(j)  (256  + 64 * (j))
#define XB_XSUB(j)  (1280 + 64 * (j))
#define XB_XGEN(j)  (2304 + 64 * (j))
#define XB_TOP      3328
#define XB_TOPGEN   3392
#define XCD_BAR_WORDS 3456
#define XB_SPIN_CAP (1u << 22)
__device__ __forceinline__ unsigned xb_ld(unsigned* p)              { return __hip_atomic_load(p, __ATOMIC_RELAXED, __HIP_MEMORY_SCOPE_AGENT); }
__device__ __forceinline__ unsigned xb_add(unsigned* p, unsigned v) { return __hip_atomic_fetch_add(p, v, __ATOMIC_RELAXED, __HIP_MEMORY_SCOPE_AGENT); }
__device__ __forceinline__ unsigned xb_xcc_id() { return (unsigned)__builtin_amdgcn_s_getreg((3 << 11) | 20) & 0xFu; }
#define XB_SPIN(cond, bar) do { unsigned _sp = 0; while (cond) { __builtin_amdgcn_s_sleep(1); \
    if ((++_sp & 255u) == 0u) { if (xb_ld(&(bar)[XB_TMO])) break; if (_sp > XB_SPIN_CAP) { atomicAdd(&(bar)[XB_TMO], 1u); break; } } } } while (0)
struct XcdBarrier { unsigned* bar; unsigned x; volatile LAS unsigned* st; };
__device__ __forceinline__ XcdBarrier xcd_barrier_post(unsigned* bar, volatile LAS unsigned* st) {
    XcdBarrier b; b.bar = bar; b.x = xb_xcc_id(); b.st = st;
    if (threadIdx.x == 0) (void)xb_add(&bar[XB_XCNT(b.x)], 1u);
    return b;
}
__device__ __forceinline__ void xcd_barrier_complete(unsigned* bar, unsigned x, unsigned& nloc, unsigned& nx) {
    const unsigned G = gridDim.x * gridDim.y * gridDim.z;
    unsigned sum, cnt, mine, sp = 0u;
    for (;;) {
        sum = 0u; cnt = 0u; mine = 0u;
#pragma unroll
        for (unsigned j = 0; j < 16; ++j) { const unsigned c = xb_ld(&bar[XB_XCNT(j)]); sum += c; cnt += (c > 0u) ? 1u : 0u; mine = (j == x) ? c : mine; }
        if (sum == G) break;
        __builtin_amdgcn_s_sleep(1);
        if ((++sp & 255u) == 0u) { if (xb_ld(&bar[XB_TMO])) break; if (sp > XB_SPIN_CAP) { atomicAdd(&bar[XB_TMO], 1u); break; } }
    }
    nloc = mine > 0u ? mine : 1u; nx = cnt > 0u ? cnt : 1u;
}
__device__ __forceinline__ void xcd_barrier(const XcdBarrier& b) {
    asm volatile("s_waitcnt vmcnt(0)" ::: "memory");
    __syncthreads();
    if (threadIdx.x == 0) {
        unsigned* bar = b.bar;
        __builtin_amdgcn_s_waitcnt(0);
        unsigned nloc = b.st[0], nx = b.st[1];
        if (nloc == 0u) { xcd_barrier_complete(bar, b.x, nloc, nx); b.st[0] = nloc; b.st[1] = nx; }
        const unsigned old = xb_add(&bar[XB_XSUB(b.x)], 1u);
        const unsigned gen = old / nloc;
        if (old + 1u == (gen + 1u) * nloc) {
            __builtin_amdgcn_fence(__ATOMIC_RELEASE, "agent");
            asm volatile("s_waitcnt vmcnt(0)" ::: "memory");
            const unsigned og = xb_add(&bar[XB_TOP], 1u);
            const unsigned tg = og / nx;
            if (og + 1u == (tg + 1u) * nx) xb_add(&bar[XB_TOPGEN], 1u);
            else XB_SPIN(xb_ld(&bar[XB_TOPGEN]) == tg, bar);
            __builtin_amdgcn_fence(__ATOMIC_ACQUIRE, "agent");
            xb_add(&bar[XB_XGEN(b.x)], 1u);
            asm volatile("s_waitcnt vmcnt(0)" ::: "memory");
        } else {
            XB_SPIN(xb_ld(&bar[XB_XGEN(b.x)]) == gen, bar);
            __builtin_amdgcn_fence(__ATOMIC_ACQUIRE, "agent");
            asm volatile("s_waitcnt vmcnt(0)" ::: "memory");
        }
    }
    __syncthreads();
}

template <int MODE>
__device__ __forceinline__ void p0_transpose_item(const float* W, int K, int N, const float* gain, bf16* WT, int row_off, LAS float* scr, int item, int lane) {
    const int nblk = (N + 31) / 32, kb = item / nblk, nb = item % nblk, k0 = 64 * kb, n0 = 32 * nb;
    const int ncol = n0 + (lane & 31); const bool nok = ncol < N;
#pragma unroll 8
    for (int i = 0; i < 32; ++i) { const int kk = 2 * i + (lane >> 5); float v = nok ? W[(size_t)(k0 + kk) * N + ncol] : 0.f; if (gain) v *= gain[k0 + kk]; scr[kk * 33 + (lane & 31)] = v; }
    asm volatile("s_waitcnt lgkmcnt(0)" ::: "memory");
    const int c = lane & 7;
    int drow0;
    if (MODE == 0) drow0 = row_off + n0; else { const int isu = n0 >= FF ? 1 : 0, j0 = n0 - isu * FF; drow0 = 256 * (j0 / 128) + 128 * isu + (j0 % 128); }
#pragma unroll
    for (int j = 0; j < 4; ++j) { const int n = (lane >> 3) + 8 * j; const LAS float* s = scr + (8 * c) * 33 + n;
        v4u o; o.x = pk2(s[0 * 33], s[1 * 33]); o.y = pk2(s[2 * 33], s[3 * 33]); o.z = pk2(s[4 * 33], s[5 * 33]); o.w = pk2(s[6 * 33], s[7 * 33]);
        if (n0 + n < N) *(v4u*)(WT + (size_t)(drow0 + n) * K + k0 + 8 * c) = o; }
    asm volatile("s_waitcnt lgkmcnt(0)" ::: "memory");
}

struct Args { const float* in[19]; float* out; unsigned char* ws; int ph_lo, ph_hi; };
typedef const Args __attribute__((address_space(4))) CArgs;

__device__ __forceinline__ void p0_prologue(CArgs* A, LAS unsigned char* lds, int G, int vcu, int wave, int lane) {
    unsigned char* ws = A->ws;
    LAS float* scr = (LAS float*)(lds + wave * 16384);
    const int gw = vcu * NWAVES + wave, NGW = G * NWAVES;
    struct WI { int items; };
    constexpr int I_IN = 16 * 97, I_SQ = 16 * 32, I_KV = 16 * 16, I_GU = 16 * 176, I_DN = 44 * 32, I_PU = 4 * 32;
    constexpr int NITEMS = I_IN + I_SQ   + I_SQ   + I_KV + I_SQ   + 2 * I_GU + 2 * I_DN + 2 * I_SQ + 2 * I_PU;
    for (int it = gw; it < NITEMS; it += NGW) {
        int r = it;
        if (r < I_IN) { p0_transpose_item<0>(A->in[3], D, ML_IN, A->in[2], (bf16*)(ws + WS_WIN), 0, scr, r, lane); continue; } r -= I_IN;
        if (r < I_SQ) { p0_transpose_item<0>(A->in[6], D, D, nullptr, (bf16*)(ws + WS_WOUT), 0, scr, r, lane); continue; } r -= I_SQ;
        if (r < I_SQ) { p0_transpose_item<0>(A->in[10], D, D, A->in[2] + D, (bf16*)(ws + WS_WQKV1), 0, scr, r, lane); continue; } r -= I_SQ;
        if (r < I_KV) { p0_transpose_item<0>(A->in[8], D, 512, A->in[7], (bf16*)(ws + WS_WQKV1), D, scr, r, lane); continue; } r -= I_KV;
        if (r < I_SQ) { p0_transpose_item<0>(A->in[12], D, D, nullptr, (bf16*)(ws + WS_WO1), 0, scr, r, lane); continue; } r -= I_SQ;
        if (r < 2 * I_GU) { const int l = r / I_GU; p0_transpose_item<1>(A->in[14] + (size_t)l * D * 2 * FF, D, 2 * FF, A->in[13] + l * D, (bf16*)(ws + WS_WGU + l * 11 * MiB), 0, scr, r % I_GU, lane); continue; } r -= 2 * I_GU;
        if (r < 2 * I_DN) { const int l = r / I_DN; p0_transpose_item<0>(A->in[15] + (size_t)l * FF * D, FF, D, nullptr, (bf16*)(ws + WS_WDN + l * 6 * MiB), 0, scr, r % I_DN, lane); continue; } r -= 2 * I_DN;
        if (r < 2 * I_SQ) { const int l = r / I_SQ; p0_transpose_item<0>(A->in[17] + (size_t)l * D * D, D, D, A->in[16] + l * D, (bf16*)(ws + WS_WPG + l * 2 * MiB), 0, scr, r % I_SQ, lane); continue; } r -= 2 * I_SQ;
        { const int l = r / I_PU; p0_transpose_item<0>(A->in[18] + (size_t)l * PLE * D, PLE, D, nullptr, (bf16*)(ws + WS_WPU + l * (MiB / 2)), 0, scr, r % I_PU, lane); }
    }
    {
        const float* x = A->in[0]; bf16* hb = (bf16*)(ws + WS_HB); float* ssq = (float*)(ws + WS_SSQ);
        for (int m = gw; m < M; m += NGW) {
            const f32x4* xr = (const f32x4*)(x + (size_t)m * D) + lane; f32x4 v[4]; float s = 0.f;
#pragma unroll
            for (int j = 0; j < 4; ++j) { v[j] = xr[64 * j]; s += (v[j][0] * v[j][0] + v[j][1] * v[j][1]) + (v[j][2] * v[j][2] + v[j][3] * v[j][3]); }
            s = wave_sum(s, lane);
            unsigned long long* o8 = (unsigned long long*)(hb + (size_t)m * D) + lane;
#pragma unroll
            for (int j = 0; j < 4; ++j) o8[64 * j] = (unsigned long long)pk2(v[j][0], v[j][1]) | ((unsigned long long)pk2(v[j][2], v[j][3]) << 32);
            if (lane < 16) ssq[(size_t)m * 16 + lane] = (lane == 0) ? s : 0.f;
        }
    }
    {
        const float* p = A->in[1]; bf16* pb = (bf16*)(ws + WS_PB);
        const size_t n8 = (size_t)2 * M * PLE / 8, gt = (size_t)gw * 64 + lane, ngt = (size_t)NGW * 64;
        for (size_t i = gt; i < n8; i += ngt) { const f32x4 a = *(const f32x4*)(p + i * 8), b = *(const f32x4*)(p + i * 8 + 4);
            v4u w; w.x = pk2(a[0], a[1]); w.y = pk2(a[2], a[3]); w.z = pk2(b[0], b[1]); w.w = pk2(b[2], b[3]); *(v4u*)(pb + i * 8) = w; }
    }
    {
        float* rc = (float*)(ws + WS_ROPE); float* rsn = rc + SEQ * 8;
        const int gt = gw * 64 + lane;
        if (gt < SEQ * 8) { const int pos = gt >> 3, i = gt & 7;
            const float inv = (i == 0 ? 1.000000000e+00f : i == 1 ? 1.939227432e-01f : i == 2 ? 3.760603070e-02f : i == 3 ? 7.292664610e-03f : i == 4 ? 1.414213562e-03f : i == 5 ? 2.742481884e-04f : i == 6 ? 5.318295734e-05f : 1.031338525e-05f);
            const float angf = (float)pos * inv;
            const double rev = (double)angf * 0.15915494309189535; const double fr = rev - rint(rev);
            rc[gt] = __builtin_amdgcn_cosf((float)fr); rsn[gt] = __builtin_amdgcn_sinf((float)fr); }
    }
}

__device__ __forceinline__ float wave_incl_scan(float v, int lane) {
#pragma unroll
    for (int o = 1; o < 64; o <<= 1) { const float t = shup(v, o, lane); if (lane >= o) v += t; }
    return v;
}
__device__ __forceinline__ float wave_incl_max(float v, int lane) {
#pragma unroll
    for (int o = 1; o < 64; o <<= 1) { const float t = shup(v, o, lane); if (lane >= o) v = fmaxf(v, t); }
    return v;
}
__device__ __forceinline__ void mlstm_a(CArgs* A, LAS unsigned char* lds, int G, const int bx, const int tid) {
    unsigned char* ws = A->ws; const int lane = tid & 63;
    LAS float* kf = (LAS float*)lds;
    LAS float* vw = kf + 4096;
    LAS float* wl = vw + 8192;
    const float* gates = (const float*)(ws + WS_GATES); const bf16* K0 = (const bf16*)(ws + WS_K0); const bf16* V0 = (const bf16*)(ws + WS_V0);
    float* cloc = (float*)(ws + WS_CLOC); float* nloc = (float*)(ws + WS_NLOC); float* mloc = (float*)(ws + WS_MLOC); float* glast = (float*)(ws + WS_GLAST);
    for (int unit = bx; unit < NB_ * ML_H * ML_NC; unit += G) {
        const int bh = unit >> 6, c = unit & 63, b = bh >> 3, h = bh & 7, row0 = b * SEQ + c * ML_L;
        if (tid < 64) {
            const float li = gates[(size_t)(row0 + tid) * 16 + h], lf = gates[(size_t)(row0 + tid) * 16 + 8 + h];
            const float g = wave_incl_scan(lf, lane); const float gl = shidx(g, 63);
            const float a = gl - g + li; const float ml = wave_max(a, lane);
            wl[tid] = expf(a - ml);
            if (tid == 0) { mloc[unit] = ml; glast[unit] = gl; }
        }
        __syncthreads();
        { const int s = tid >> 3, kc = (tid & 7) * 8; const v4u kk = *(const v4u*)(K0 + (size_t)(row0 + s) * 512 + h * 64 + kc); LAS float* d = kf + s * 64 + kc;
          d[0] = bf_lo(kk.x); d[1] = bf_hi(kk.x); d[2] = bf_lo(kk.y); d[3] = bf_hi(kk.y); d[4] = bf_lo(kk.z); d[5] = bf_hi(kk.z); d[6] = bf_lo(kk.w); d[7] = bf_hi(kk.w);
          const int vc = (tid & 7) * 16; const float w = wl[s]; const v4u v0 = *(const v4u*)(V0 + (size_t)(row0 + s) * 1024 + h * 128 + vc), v1 = *(const v4u*)(V0 + (size_t)(row0 + s) * 1024 + h * 128 + vc + 8);
          LAS float* e = vw + s * 128 + vc;
          e[0] = w * bf_lo(v0.x); e[1] = w * bf_hi(v0.x); e[2] = w * bf_lo(v0.y); e[3] = w * bf_hi(v0.y); e[4] = w * bf_lo(v0.z); e[5] = w * bf_hi(v0.z); e[6] = w * bf_lo(v0.w); e[7] = w * bf_hi(v0.w);
          e[8] = w * bf_lo(v1.x); e[9] = w * bf_hi(v1.x); e[10] = w * bf_lo(v1.y); e[11] = w * bf_hi(v1.y); e[12] = w * bf_lo(v1.z); e[13] = w * bf_hi(v1.z); e[14] = w * bf_lo(v1.w); e[15] = w * bf_hi(v1.w); }
        __syncthreads();
        { const int v = tid >> 2, kg = (tid & 3) * 16; float acc[16];
#pragma unroll
          for (int i = 0; i < 16; ++i) acc[i] = 0.f;
          for (int s = 0; s < 64; ++s) { const float a = vw[s * 128 + v];
#pragma unroll
              for (int i = 0; i < 16; ++i) acc[i] += a * kf[s * 64 + kg + i]; }
          float* o = cloc + (size_t)unit * 8192 + v * 64 + kg;
#pragma unroll
          for (int i = 0; i < 4; ++i) *(f32x4*)(o + 4 * i) = (f32x4){acc[4 * i], acc[4 * i + 1], acc[4 * i + 2], acc[4 * i + 3]};
          if (tid < 64) { float n = 0.f; for (int s = 0; s < 64; ++s) n += wl[s] * kf[s * 64 + tid]; nloc[(size_t)unit * 64 + tid] = n; } }
        __syncthreads();
    }
}
__device__ __forceinline__ void mlstm_scan(CArgs* A, int G, const int bx, const int tid) {
    unsigned char* ws = A->ws;
    float* cloc = (float*)(ws + WS_CLOC); float* nloc = (float*)(ws + WS_NLOC); const float* mloc = (const float*)(ws + WS_MLOC); const float* glast = (const float*)(ws + WS_GLAST); float* mprev = (float*)(ws + WS_MPREV);
    for (int su = bx; su < 64 * 4; su += G) {
        const int bh = su >> 2, qt = su & 3;
        float* cp = cloc + (size_t)bh * 64 * 8192 + qt * 2048 + tid * 4;
        f32x4 C = (f32x4){0.f, 0.f, 0.f, 0.f}; float n = 0.f, m = 0.f;
        for (int c = 0; c < 64; ++c) {
            const float ml = mloc[bh * 64 + c], gl = glast[bh * 64 + c];
            const float mn = fmaxf(gl + m, ml), sp = expf(gl + m - mn), sl = expf(ml - mn);
            const f32x4 cl = *(const f32x4*)(cp + (size_t)c * 8192);
            *(f32x4*)(cp + (size_t)c * 8192) = C;
            C = C * sp + cl * sl;
            if (qt == 0 && tid < 64) { float* np = nloc + (size_t)(bh * 64 + c) * 64 + tid; const float nl = *np; *np = n; n = sp * n + sl * nl; }
            if (qt == 0 && tid == 0) mprev[bh * 64 + c] = m;
            m = mn;
        }
    }
}
__device__ __forceinline__ void mlstm_c(CArgs* A, LAS unsigned char* lds, int G, const int bx, const int tid) {
    unsigned char* ws = A->ws; const int lane = tid & 63;
    LAS float* qf = (LAS float*)lds;
    LAS float* kf = qf + 4096;
    LAS float* vf = kf + 4096;
    LAS float* cp = vf + 8192;
    LAS float* Sm = cp + 128 * 65;
    LAS float* sc = Sm + 64 * 65;
    const float* gates = (const float*)(ws + WS_GATES); const bf16* Q0 = (const bf16*)(ws + WS_Q0); const bf16* K0 = (const bf16*)(ws + WS_K0); const bf16* V0 = (const bf16*)(ws + WS_V0);
    const bf16* OG = (const bf16*)(ws + WS_OG); bf16* HC = (bf16*)(ws + WS_V0);
    const float* cprev = (const float*)(ws + WS_CLOC); const float* nprev = (const float*)(ws + WS_NLOC); const float* mprev = (const float*)(ws + WS_MPREV);
    const float* mh_gain = A->in[5];
    for (int unit = bx; unit < NB_ * ML_H * ML_NC; unit += G) {
        const int bh = unit >> 6, c = unit & 63, b = bh >> 3, h = bh & 7, row0 = b * SEQ + c * ML_L;
        if (tid < 64) {
            const float li = gates[(size_t)(row0 + tid) * 16 + h], lf = gates[(size_t)(row0 + tid) * 16 + 8 + h];
            const float g = wave_incl_scan(lf, lane);
            const float pm = wave_incl_max(li - g, lane);
            const float mintra = g + pm, minter = g + mprev[unit], mc = fmaxf(minter, mintra);
            sc[tid] = g; sc[64 + tid] = li; sc[128 + tid] = mc; sc[192 + tid] = expf(minter - mc); sc[320 + tid] = nprev[(size_t)unit * 64 + tid];
        }
        { const int s = tid >> 3, kc = (tid & 7) * 8;
          const v4u qq = *(const v4u*)(Q0 + (size_t)(row0 + s) * 512 + h * 64 + kc); LAS float* dq = qf + s * 64 + kc;
          dq[0] = bf_lo(qq.x); dq[1] = bf_hi(qq.x); dq[2] = bf_lo(qq.y); dq[3] = bf_hi(qq.y); dq[4] = bf_lo(qq.z); dq[5] = bf_hi(qq.z); dq[6] = bf_lo(qq.w); dq[7] = bf_hi(qq.w);
          const v4u kk = *(const v4u*)(K0 + (size_t)(row0 + s) * 512 + h * 64 + kc); LAS float* d = kf + s * 64 + kc;
          d[0] = bf_lo(kk.x); d[1] = bf_hi(kk.x); d[2] = bf_lo(kk.y); d[3] = bf_hi(kk.y); d[4] = bf_lo(kk.z); d[5] = bf_hi(kk.z); d[6] = bf_lo(kk.w); d[7] = bf_hi(kk.w);
          const int vc = (tid & 7) * 16; const v4u v0 = *(const v4u*)(V0 + (size_t)(row0 + s) * 1024 + h * 128 + vc), v1 = *(const v4u*)(V0 + (size_t)(row0 + s) * 1024 + h * 128 + vc + 8);
          LAS float* e = vf + s * 128 + vc;
          e[0] = bf_lo(v0.x); e[1] = bf_hi(v0.x); e[2] = bf_lo(v0.y); e[3] = bf_hi(v0.y); e[4] = bf_lo(v0.z); e[5] = bf_hi(v0.z); e[6] = bf_lo(v0.w); e[7] = bf_hi(v0.w);
          e[8] = bf_lo(v1.x); e[9] = bf_hi(v1.x); e[10] = bf_lo(v1.y); e[11] = bf_hi(v1.y); e[12] = bf_lo(v1.z); e[13] = bf_hi(v1.z); e[14] = bf_lo(v1.w); e[15] = bf_hi(v1.w);
          const float* cs = cprev + (size_t)unit * 8192;
#pragma unroll
          for (int i = 0; i < 4; ++i) { const int e4 = tid * 4 + i * 2048; const f32x4 cv = *(const f32x4*)(cs + e4); const int v = e4 >> 6, k = e4 & 63; LAS float* dd = cp + v * 65 + k; dd[0] = cv[0]; dd[1] = cv[1]; dd[2] = cv[2]; dd[3] = cv[3]; } }
        __syncthreads();
        { const int j = tid >> 3, sg = (tid & 7) * 8; const float gj = sc[j], mcj = sc[128 + j];
#pragma unroll
          for (int i = 0; i < 8; ++i) { const int s = sg + i; float d = 0.f;
              for (int k = 0; k < 64; ++k) d += qf[j * 64 + k] * kf[s * 64 + k];
              Sm[j * 65 + s] = (s <= j) ? d * expf(gj - sc[s] + sc[64 + s] - mcj) : 0.f; } }
        __syncthreads();
        if (tid < 64) { const int j = tid; float qn = 0.f, rsum = 0.f;
            for (int k = 0; k < 64; ++k) qn += qf[j * 64 + k] * sc[320 + k];
            for (int s = 0; s < 64; ++s) rsum += Sm[j * 65 + s];
            const float dn = sc[192 + j] * qn + rsum; sc[256 + j] = fmaxf(fabsf(dn), expf(-sc[128 + j])); }
        const int j = tid >> 3, vg = (tid & 7) * 16; float acc[16];
        { const float wi = sc[192 + j];
#pragma unroll
          for (int i = 0; i < 16; ++i) acc[i] = 0.f;
          for (int k = 0; k < 64; ++k) { const float q = qf[j * 64 + k];
#pragma unroll
              for (int i = 0; i < 16; ++i) acc[i] += q * cp[(vg + i) * 65 + k]; }
#pragma unroll
          for (int i = 0; i < 16; ++i) acc[i] *= wi;
          for (int s = 0; s < 64; ++s) { const float p = Sm[j * 65 + s];
#pragma unroll
              for (int i = 0; i < 16; ++i) acc[i] += p * vf[s * 128 + vg + i]; } }
        __syncthreads();
        { const float inv = 1.0f / sc[256 + j]; float ss = 0.f;
#pragma unroll
          for (int i = 0; i < 16; ++i) { acc[i] *= inv; ss += acc[i] * acc[i]; }
          ss += shx(ss, 1, lane); ss += shx(ss, 2, lane); ss += shx(ss, 4, lane);
          const float rn = __builtin_amdgcn_rsqf(ss * (1.0f / ML_DV) + EPS);
          const size_t off = (size_t)(row0 + j) * 1024 + h * 128 + vg;
          const v4u o0 = *(const v4u*)(OG + off), o1 = *(const v4u*)(OG + off + 8);
          float og[16] = {bf_lo(o0.x), bf_hi(o0.x), bf_lo(o0.y), bf_hi(o0.y), bf_lo(o0.z), bf_hi(o0.z), bf_lo(o0.w), bf_hi(o0.w), bf_lo(o1.x), bf_hi(o1.x), bf_lo(o1.y), bf_hi(o1.y), bf_lo(o1.z), bf_hi(o1.z), bf_lo(o1.w), bf_hi(o1.w)};
          float r[16];
#pragma unroll
          for (int i = 0; i < 16; ++i) r[i] = acc[i] * rn * mh_gain[vg + i] * sigmoidf_(og[i]);
          v4u w0, w1; w0.x = pk2(r[0], r[1]); w0.y = pk2(r[2], r[3]); w0.z = pk2(r[4], r[5]); w0.w = pk2(r[6], r[7]); w1.x = pk2(r[8], r[9]); w1.y = pk2(r[10], r[11]); w1.z = pk2(r[12], r[13]); w1.w = pk2(r[14], r[15]);
          *(v4u*)(HC + off) = w0; *(v4u*)(HC + off + 8) = w1; }
        __syncthreads();
    }
}

__device__ __forceinline__ void moba_fixup(CArgs* A, LAS unsigned char* lds, int G, const int bx, const int tid) {
    unsigned char* ws = A->ws;
    bf16* Q1 = (bf16*)(ws + WS_Q1); bf16* K1 = (bf16*)(ws + WS_K1); float* kmp = (float*)(ws + WS_KMP);
    const float* rc = (const float*)(ws + WS_ROPE); const float* rsn = rc + SEQ * 8;
    const float* qg = A->in[11]; const float* kg = A->in[9];
    LAS float* ks = (LAS float*)lds;
    for (int unit = bx; unit < M / 128; unit += G) {
        const int r0 = unit * 128;
        for (int it = tid; it < 128 * 20; it += NTHREADS) {
            const int rl = it / 20, hh = it % 20, row = r0 + rl, pos = row & (SEQ - 1);
            bf16* p = (hh < 16) ? Q1 + (size_t)row * 1024 + hh * 64 : K1 + (size_t)row * 256 + (hh - 16) * 64;
            const float* gn = (hh < 16) ? qg : kg;
            float v[64]; float ss = 0.f;
#pragma unroll
            for (int i = 0; i < 8; ++i) { const v4u w = *(const v4u*)(p + 8 * i); v[8 * i] = bf_lo(w.x); v[8 * i + 1] = bf_hi(w.x); v[8 * i + 2] = bf_lo(w.y); v[8 * i + 3] = bf_hi(w.y); v[8 * i + 4] = bf_lo(w.z); v[8 * i + 5] = bf_hi(w.z); v[8 * i + 6] = bf_lo(w.w); v[8 * i + 7] = bf_hi(w.w); }
#pragma unroll
            for (int i = 0; i < 64; ++i) ss += v[i] * v[i];
            const float rn = __builtin_amdgcn_rsqf(ss * (1.0f / 64.0f) + EPS);
#pragma unroll
            for (int i = 0; i < 64; ++i) v[i] = v[i] * rn * gn[i];
#pragma unroll
            for (int i = 0; i < 8; ++i) { const float cs = rc[pos * 8 + i], sn = rsn[pos * 8 + i]; const float x1 = v[i], x2 = v[8 + i]; v[i] = x1 * cs - x2 * sn; v[8 + i] = x2 * cs + x1 * sn; }
#pragma unroll
            for (int i = 0; i < 8; ++i) { v4u w; w.x = pk2(v[8 * i], v[8 * i + 1]); w.y = pk2(v[8 * i + 2], v[8 * i + 3]); w.z = pk2(v[8 * i + 4], v[8 * i + 5]); w.w = pk2(v[8 * i + 6], v[8 * i + 7]); *(v4u*)(p + 8 * i) = w; }
            if (hh >= 16) { LAS float* kd = ks + (rl * 4 + (hh - 16)) * 64;
#pragma unroll
                for (int i = 0; i < 64; ++i) kd[i] = v[i]; }
        }
        __syncthreads();
        if (tid < 256) { float s = 0.f; for (int r = 0; r < 128; ++r) s += ks[r * 256 + tid]; kmp[(size_t)unit * 256 + tid] = s; }
        __syncthreads();
    }
}
__device__ __forceinline__ void moba_attn(CArgs* A, LAS unsigned char* lds, int G, const int bx, const int tid) {
    unsigned char* ws = A->ws; const int lane = tid & 63, wave = tid >> 6;
    const bf16* Q1 = (const bf16*)(ws + WS_Q1); const bf16* K1 = (const bf16*)(ws + WS_K1); const bf16* V1 = (const bf16*)(ws + WS_V1); const float* kmp = (const float*)(ws + WS_KMP);
    bf16* AO = (bf16*)(ws + WS_AO);
    LAS float* qs = (LAS float*)lds + wave * 1088; LAS float* ps = qs + 64;
    const int nitems = M * MB_H / NWAVES;
    for (int it = bx; it < nitems; it += G) {
        const int item = it * NWAVES + wave, row = item >> 4, h = item & 15, kvh = h >> 2, b = row >> 12, t = row & (SEQ - 1), qb = t >> 8;
        { const bf16 qv = Q1[(size_t)row * 1024 + h * 64 + lane]; qs[lane] = __builtin_bit_cast(float, (unsigned)qv << 16); }
        asm volatile("s_waitcnt lgkmcnt(0)" ::: "memory");
        float q[64];
#pragma unroll
        for (int i = 0; i < 16; ++i) { const f32x4 t4 = *(const LAS f32x4*)(qs + 4 * i); q[4 * i] = t4[0]; q[4 * i + 1] = t4[1]; q[4 * i + 2] = t4[2]; q[4 * i + 3] = t4[3]; }
        float gv = -INFINITY;
        if (lane < qb) { const float* k0 = kmp + (size_t)((b * 32 + 2 * lane) * 4 + kvh) * 64; const float* k1 = k0 + 256; float s = 0.f;
#pragma unroll
            for (int i = 0; i < 16; ++i) { const f32x4 a = *(const f32x4*)(k0 + 4 * i) + *(const f32x4*)(k1 + 4 * i); s += (q[4 * i] * a[0] + q[4 * i + 1] * a[1]) + (q[4 * i + 2] * a[2] + q[4 * i + 3] * a[3]); }
            gv = s; }
        int sel0 = 0, sel1 = 0, sel2 = 0;
#pragma unroll
        for (int r = 0; r < 3; ++r) { float mv = gv; int mi = lane;
#pragma unroll
            for (int o = 32; o >= 1; o >>= 1) { const float ov = shx(mv, o, lane); const int oi = shxi(mi, o, lane); if (ov > mv || (ov == mv && oi < mi)) { mv = ov; mi = oi; } }
            const int sr = __builtin_amdgcn_readfirstlane(mi); if (lane == sr) gv = -INFINITY;
            if (r == 0) sel0 = sr; else if (r == 1) sel1 = sr; else sel2 = sr; }
        const int nvalid = qb < 3 ? qb : 3;
        float mx = -INFINITY;
#pragma unroll 1
        for (int jj = 0; jj < 16; ++jj) {
            const int j = jj >> 2, i = jj & 3; const bool active = (j == 3) || (j < nvalid); const int nblk = j == 0 ? sel0 : (j == 1 ? sel1 : (j == 2 ? sel2 : qb));
            float sv = -INFINITY;
            if (active) { const int pos = nblk * 256 + i * 64 + lane; const bf16* kp = K1 + (size_t)(b * SEQ + pos) * 256 + kvh * 64; float d = 0.f;
#pragma unroll
                for (int e = 0; e < 8; ++e) { const v4u w = *(const v4u*)(kp + 8 * e);
                    d += q[8 * e] * bf_lo(w.x) + q[8 * e + 1] * bf_hi(w.x) + q[8 * e + 2] * bf_lo(w.y) + q[8 * e + 3] * bf_hi(w.y) + q[8 * e + 4] * bf_lo(w.z) + q[8 * e + 5] * bf_hi(w.z) + q[8 * e + 6] * bf_lo(w.w) + q[8 * e + 7] * bf_hi(w.w); }
                sv = d * 0.125f; if (j == 3 && pos > t) sv = -INFINITY; }
            ps[jj * 64 + lane] = sv; mx = fmaxf(mx, sv);
        }
        mx = wave_max(mx, lane);
        float l = 0.f;
        float o[64];
#pragma unroll
        for (int i = 0; i < 64; ++i) o[i] = 0.f;
#pragma unroll 1
        for (int jj = 0; jj < 16; ++jj) {
            const int j = jj >> 2, i = jj & 3; const bool active = (j == 3) || (j < nvalid); const int nblk = j == 0 ? sel0 : (j == 1 ? sel1 : (j == 2 ? sel2 : qb));
            if (active) { const int pos = nblk * 256 + i * 64 + lane; const bf16* vp = V1 + (size_t)(b * SEQ + pos) * 256 + kvh * 64; const float p = __expf(ps[jj * 64 + lane] - mx); l += p;
#pragma unroll
                for (int e = 0; e < 8; ++e) { const v4u w = *(const v4u*)(vp + 8 * e);
                    o[8 * e] += p * bf_lo(w.x); o[8 * e + 1] += p * bf_hi(w.x); o[8 * e + 2] += p * bf_lo(w.y); o[8 * e + 3] += p * bf_hi(w.y); o[8 * e + 4] += p * bf_lo(w.z); o[8 * e + 5] += p * bf_hi(w.z); o[8 * e + 6] += p * bf_lo(w.w); o[8 * e + 7] += p * bf_hi(w.w); } }
        }
        l = wave_sum(l, lane);
#define RED_STEP(OFF, N) _Pragma("unroll") for (int i = 0; i < (N) / 2; ++i) { const bool up = (lane & (OFF)) != 0; const float send = up ? o[i] : o[i + (N) / 2]; const float keep = up ? o[i + (N) / 2] : o[i]; o[i] = keep + shx(send, OFF, lane); }
        RED_STEP(32, 64) RED_STEP(16, 32) RED_STEP(8, 16) RED_STEP(4, 8) RED_STEP(2, 4) RED_STEP(1, 2)
#undef RED_STEP
        AO[(size_t)row * 1024 + h * 64 + lane] = (bf16)f2bf(o[0] / l);
        asm volatile("s_waitcnt lgkmcnt(0)" ::: "memory");
    }
}

constexpr int N_PHASES = 18;
#define PHASE_TID() unsigned ones_ = ones; asm volatile("" : "+s"(ones_)); const int tid = (wave_s << 6) | (int)__builtin_amdgcn_mbcnt_hi(ones_, __builtin_amdgcn_mbcnt_lo(ones_, 0u));
__device__ __forceinline__ void run_phase(const int ph, CArgs* ap, LAS unsigned char* lds, const int G, const int bx, const int wave_s, const unsigned ones) {
    const int vcu = (G % 8 == 0) ? (bx % 8) * (G / 8) + bx / 8 : bx;
    CArgs* A = ap;
    unsigned char* ws = A->ws;
    const int l = ph >= 10 ? 1 : 0;
    bf16* HB0 = (bf16*)(ws + WS_HB); bf16* HB1 = (bf16*)(ws + WS_HB2); float* SSQ0 = (float*)(ws + WS_SSQ); float* SSQ1 = SSQ0 + (size_t)M * 16;
    bf16* HBl = l ? HB1 : HB0; bf16* HBo = l ? HB0 : HB1; float* SSQl = l ? SSQ1 : SSQ0; float* SSQo = l ? SSQ0 : SSQ1;
    float* OUT = A->out;
    switch (ph) {
    case 0: { PHASE_TID() p0_prologue(A, lds, G, vcu, wave_s, tid & 63); } break;
    case 1: { PHASE_TID() pg8::Gemm g{HB0, (const bf16*)(ws + WS_WIN), M, ML_INP, D}; pg8::StaticOrder S; S.init(M, ML_INP, G, bx);
        EpiMl E{ws, (float*)(ws + WS_GATES), SSQ0, A->in[4]};
        pg8::gemm_phase<EpiMl, pg8::StaticOrder, true, true>(lds, g, S, E, tid); } break;
    case 2: { PHASE_TID() mlstm_a(A, lds, G, bx, tid); } break;
    case 3: { PHASE_TID() mlstm_scan(A, G, bx, tid); } break;
    case 4: { PHASE_TID() mlstm_c(A, lds, G, bx, tid); } break;
    case 5: { PHASE_TID() pg8::Gemm g{(const bf16*)(ws + WS_V0), (const bf16*)(ws + WS_WOUT), M, D, D}; pg8::StaticOrder S; S.init(M, D, G, bx);
        EpiRes E{A->in[0], OUT, HB0, SSQ0};
        pg8::gemm_phase<EpiRes, pg8::StaticOrder, true, true>(lds, g, S, E, tid); } break;
    case 10: { PHASE_TID() pg8::Gemm g{HB1, (const bf16*)(ws + WS_WQKV1), M, 1536, D}; pg8::StaticOrder S; S.init(M, 1536, G, bx);
        EpiQkv1 E{ws, SSQ1};
        pg8::gemm_phase<EpiQkv1, pg8::StaticOrder, true, true>(lds, g, S, E, tid); } break;
    case 11: { PHASE_TID() moba_fixup(A, lds, G, bx, tid); } break;
    case 12: { PHASE_TID() moba_attn(A, lds, G, bx, tid); } break;
    case 13: case 7: case 15: {
        PHASE_TID() const bool dn = ph != 13;
        pg8::Gemm g{(const bf16*)(ws + (dn ? WS_ACT : WS_AO)), (const bf16*)(ws + (dn ? WS_WDN + l * 6 * MiB : WS_WO1)), M, D, dn ? FF : D}; pg8::StaticOrder S; S.init(M, D, G, bx);
        EpiRes E{OUT, OUT, HBl, SSQl};
        pg8::gemm_phase<EpiRes, pg8::StaticOrder, true, true>(lds, g, S, E, tid); } break;
    case 6: case 14: { PHASE_TID() pg8::Gemm g{HBl, (const bf16*)(ws + WS_WGU + l * 11 * MiB), M, 2 * FF, D}; pg8::StaticOrder S; S.init(M, 2 * FF, G, bx);
        EpiSwiglu E{(bf16*)(ws + WS_ACT), SSQl};
        pg8::gemm_phase<EpiSwiglu, pg8::StaticOrder, true, true>(lds, g, S, E, tid); } break;
    case 8: case 16: { PHASE_TID() pg8::Gemm g{(const bf16*)(ws + WS_PB) + (size_t)l * M * PLE, (const bf16*)(ws + WS_WPU + l * (MiB / 2)), M, D, PLE}; pg8::StaticOrder S; S.init(M, D, G, bx);
        EpiPlain E{(bf16*)(ws + WS_UP), D};
        pg8::gemm_phase<EpiPlain, pg8::StaticOrder, true, true>(lds, g, S, E, tid); } break;
    case 9: case 17: { PHASE_TID() pg8::Gemm g{HBl, (const bf16*)(ws + WS_WPG + l * 2 * MiB), M, D, D}; pg8::StaticOrder S; S.init(M, D, G, bx);
        EpiPle E{OUT, OUT, HBo, SSQo, SSQl, (const bf16*)(ws + WS_UP)};
        pg8::gemm_phase<EpiPle, pg8::StaticOrder, true, true>(lds, g, S, E, tid); } break;
    default: break;
    }
}
#ifndef PHASE_MASK
#define PHASE_MASK 0xFFFFFFFFu
#endif
__global__ void __launch_bounds__(NTHREADS, 2) yoco_fwd(Args args) {
    extern __shared__ __attribute__((aligned(16))) unsigned char lds_raw[];
    LAS unsigned char* lds = (LAS unsigned char*)lds_raw;
    volatile LAS unsigned* MISC = (volatile LAS unsigned*)(lds + LDSCTL_OFF);
    for (int u = threadIdx.x; u < (LDS_BYTES - LDSCTL_OFF) / 4; u += NTHREADS) ((LAS unsigned*)(lds + LDSCTL_OFF))[u] = 0u;
    __syncthreads();
    XcdBarrier bar; bar.bar = (unsigned*)(args.ws + WS_CTL) + 4096; bar.x = 0; bar.st = nullptr;
    if (MK_N_LAUNCHES == 1) bar = xcd_barrier_post((unsigned*)(args.ws + WS_CTL) + 4096, MISC + 8);
    const int lo = args.ph_lo, hi = args.ph_hi;
    const int wave_s = __builtin_amdgcn_readfirstlane(threadIdx.x >> 6);
#pragma unroll 1
    for (int ph = lo; ph < hi; ++ph) {
        CArgs* ap = (CArgs*)__builtin_amdgcn_kernarg_segment_ptr(); unsigned ones = ~0u; int G = gridDim.x, bx = blockIdx.x;
        asm volatile("" : "+s"(ap), "+s"(ones), "+s"(G), "+s"(bx));
        if ((PHASE_MASK >> ph) & 1u) run_phase(ph, ap, lds, G, bx, wave_s, ones);
        if (ph + 1 < hi) { XcdBarrier b2 = bar; asm volatile("" : "+s"(b2.bar)); xcd_barrier(b2); }
    }
}

extern "C" void kernel_launch(void* const* d_in, const int* in_sizes, int n_in, void* d_out, int out_size, void* d_ws, size_t ws_size, hipStream_t stream) {
    static int grid = 0;
    if (grid == 0) {
        if (n_in != 19 || in_sizes[0] != M * D || out_size != M * D || ws_size < WS_END) { fprintf(stderr, "kernel_launch: unexpected shapes (n_in %d, in0 %d, out %d, ws %zu); nothing launched\n", n_in, n_in > 0 ? in_sizes[0] : -1, out_size, ws_size); grid = -1; return; }
        int dev = 0, cus = 0, per_cu = 0;
        if (hipGetDevice(&dev) != hipSuccess || hipDeviceGetAttribute(&cus, hipDeviceAttributeMultiprocessorCount, dev) != hipSuccess) { grid = -1; return; }
        if (hipFuncSetAttribute((const void*)yoco_fwd, hipFuncAttributeMaxDynamicSharedMemorySize, LDS_BYTES) != hipSuccess) { fprintf(stderr, "kernel_launch: hipFuncSetAttribute failed\n"); grid = -1; return; }
        if (hipOccupancyMaxActiveBlocksPerMultiprocessor(&per_cu, (const void*)yoco_fwd, NTHREADS, LDS_BYTES) != hipSuccess || per_cu < 1) { fprintf(stderr, "kernel_launch: occupancy query says %d blocks per CU\n", per_cu); per_cu = 1; }
        (void)hipGetLastError();
        grid = cus;
    }
    if (grid < 0) return;
    (void)hipMemsetAsync((char*)d_ws + WS_CTL, 0, CTL_ZERO_BYTES, stream);
    Args a{};
    for (int i = 0; i < 19; ++i) a.in[i] = (const float*)d_in[i];
    a.out = (float*)d_out; a.ws = (unsigned char*)d_ws;
    if (MK_N_LAUNCHES == 1) {
        a.ph_lo = 0; a.ph_hi = N_PHASES;
        hipLaunchKernelGGL(yoco_fwd, dim3(grid), dim3(NTHREADS), LDS_BYTES, stream, a);
    } else {
        for (int p = 0; p < N_PHASES; ++p) { a.ph_lo = p; a.ph_hi = p + 1; hipLaunchKernelGGL(yoco_fwd, dim3(grid), dim3(NTHREADS), LDS_BYTES, stream, a); }
    }
}
```

```cpp
#include <hip/hip_runtime.h>
#include <hip/hip_bf16.h>
#include <cstdio>
#include <cstdint>

#ifndef MK_N_LAUNCHES
#define MK_N_LAUNCHES 1
#endif

#define LAS __attribute__((address_space(3)))
#define GAS __attribute__((address_space(1)))

namespace pg8 {
#define PG8_LAS __attribute__((address_space(3)))
typedef unsigned short bf16_t;
typedef short bf16x8 __attribute__((ext_vector_type(8)));
typedef float f32x4 __attribute__((ext_vector_type(4)));
typedef unsigned u32x4 __attribute__((ext_vector_type(4)));
typedef unsigned u32x2 __attribute__((ext_vector_type(2)));
constexpr int BM = 256, BK = 64, HALF = 128, HTB = HALF * BK * 2, STAGE_BYTES = 8 * HTB, NXCD = 8, WGM = 8;

__host__ __device__ __forceinline__ int lds_byte(int r, int c) { const int st = (r >> 4) * 2 + (c >> 5), rr = r & 15, cc = c & 31, ob = rr * 64 + cc * 2; return st * 1024 + (ob ^ (((ob >> 9) & 1) << 5)); }
__host__ __device__ __forceinline__ void stage_rc(int b, int& R, int& C) { const int st = b / 1024, sb = b % 1024, swz = sb ^ (((sb >> 9) & 1) << 5); R = (st >> 1) * 16 + swz / 64; C = (st & 1) * 32 + (swz % 64) / 2; }
__host__ __device__ __forceinline__ int perm32(int rho) { const int n = rho >> 4, i = rho & 15; return 8 * (i >> 2) + 4 * n + (i & 3); }

struct Unit { int pm, pn; };
struct Gemm { const bf16_t* A; const bf16_t* Bt; int M, N, K; };

struct StaticOrder {
    int nM, nN, nwg, G, c;
    __host__ __device__ void init(int M, int N, int G_, int c_) { nM = M / BM; nN = N / BM; nwg = nM * nN; G = G_; c = c_; }
    __host__ __device__ bool next(int i, Unit& u) const {
        const long L = (long)i * G + c; if (L >= nwg) return false;
        int wgid = (int)L; { const int q = nwg / NXCD, r = nwg % NXCD, xcd = wgid % NXCD, off = wgid / NXCD; wgid = (xcd < r ? xcd * (q + 1) : r * (q + 1) + (xcd - r) * q) + off; }
        const int nig = WGM * nN, gid = wgid / nig, fm = gid * WGM, gsz = (nM - fm) < WGM ? (nM - fm) : WGM;
        u.pm = fm + ((wgid % nig) % gsz); u.pn = (wgid % nig) / gsz; return true;
    }
    __device__ __forceinline__ void a_ready(const Unit&) const {}
    __device__ __forceinline__ void done(const Unit&) const {}
};

__device__ __forceinline__ unsigned cvt_pk_bf16(float lo, float hi) { unsigned r; asm volatile("v_cvt_pk_bf16_f32 %0, %1, %2" : "=v"(r) : "v"(lo), "v"(hi)); return r; }

template <class Epi, class Sched, bool ALIGN_EPI = false, bool SP2 = false>
__device__ __forceinline__ void gemm_phase(PG8_LAS unsigned char* lds, const Gemm g, const Sched& S, const Epi& E, const int tid) {
    const int wid = __builtin_amdgcn_readfirstlane(tid >> 6), lane = tid & 63, wr = wid >> 2, wc = wid & 3, fr = lane & 15, fq = lane >> 4;
    int K_ = g.K; asm volatile("" : "+s"(K_));
    const int K = K_, nt = K / BK;
    unsigned voffA[2], voffB[2];
#pragma unroll
    for (int i = 0; i < 2; ++i) { int R, C; stage_rc(tid * 16 + i * 8192, R, C); const int Rb = Epi::PERM ? ((R & ~31) + perm32(R & 31)) : R;
        voffA[i] = (unsigned)(R * K + C) * 2u; voffB[i] = (unsigned)(Rb * K + C) * 2u; }
    const size_t kstep = (size_t)(BK * 2);
    const size_t hstep = (size_t)HALF * K * 2;
    const size_t tstep = 2 * hstep;
    const unsigned ldsw = (unsigned)wid * 1024u;
    const int aoff = lds_byte(wr * 64 + fr, fq * 8), boff = lds_byte(wc * 32 + fr, fq * 8);
#define PG8_SA(b, h) (((b) * 2 + (h)) * HTB)
#define PG8_SB(b, h) ((4 + (b) * 2 + (h)) * HTB)
#define PG8_STAGE(bufoff, gbase, voff) do { _Pragma("unroll") for (int _i = 0; _i < 2; ++_i) \
        __builtin_amdgcn_global_load_lds((const unsigned*)((const char*)(gbase) + (voff)[_i]), (PG8_LAS unsigned*)(lds + (bufoff) + ldsw + _i * 8192), 16, 0, 0); } while (0)
#define PG8_LDA(dst, b, h) do { _Pragma("unroll") for (int m = 0; m < 4; ++m) _Pragma("unroll") for (int k = 0; k < 2; ++k) dst[m][k] = *(const PG8_LAS bf16x8*)(lds + PG8_SA(b, h) + aoff + m * 2048 + k * 1024); } while (0)
#define PG8_LDB(dst, b, h) do { _Pragma("unroll") for (int n = 0; n < 2; ++n) _Pragma("unroll") for (int k = 0; k < 2; ++k) dst[n][k] = *(const PG8_LAS bf16x8*)(lds + PG8_SB(b, h) + boff + n * 2048 + k * 1024); } while (0)
#define PG8_MMA(ai, bj, At, Bt) do { __builtin_amdgcn_s_setprio(1); _Pragma("unroll") for (int m = 0; m < 4; ++m) _Pragma("unroll") for (int n = 0; n < 2; ++n) _Pragma("unroll") for (int k = 0; k < 2; ++k) \
        acc[ai][bj][m][n] = __builtin_amdgcn_mfma_f32_16x16x32_bf16(Bt[n][k], At[m][k], acc[ai][bj][m][n], 0, 0, 0); __builtin_amdgcn_s_setprio(0); } while (0)
#define PG8_WAIT_V(n) asm volatile("s_waitcnt vmcnt(" #n ")" ::: "memory")
#define PG8_WAIT_L(n) asm volatile("s_waitcnt lgkmcnt(" #n ")" ::: "memory")
#define PG8_BAR __builtin_amdgcn_s_barrier()
#define PG8_SCHED __builtin_amdgcn_sched_barrier(0)
    Unit cur, nxt; int ui = 0;
    if (!S.next(0, cur)) return;
    f32x4 acc[2][2][4][2];
#pragma unroll
    for (int a = 0; a < 2; ++a)
#pragma unroll
        for (int b = 0; b < 2; ++b)
#pragma unroll
            for (int m = 0; m < 4; ++m)
#pragma unroll
                for (int n = 0; n < 2; ++n) acc[a][b][m][n] = (f32x4){0.f, 0.f, 0.f, 0.f};
    bf16x8 At[4][2], B0[2][2], B1[2][2];
    const char* cA = (const char*)g.A + (size_t)cur.pm * tstep; const char* cB = (const char*)g.Bt + (size_t)cur.pn * tstep;
    S.a_ready(cur);
    if constexpr (SP2) {
        PG8_STAGE(PG8_SB(0, 0), cB, voffB); PG8_STAGE(PG8_SB(0, 1), cB + hstep, voffB); PG8_STAGE(PG8_SA(0, 0), cA, voffA); PG8_STAGE(PG8_SA(0, 1), cA + hstep, voffA);
        if (wr == 1) PG8_BAR;
        PG8_WAIT_V(2); PG8_BAR;
        PG8_STAGE(PG8_SB(1, 0), cB + kstep, voffB); PG8_STAGE(PG8_SA(1, 0), cA + kstep, voffA); PG8_STAGE(PG8_SB(1, 1), cB + hstep + kstep, voffB);
        PG8_WAIT_V(6); PG8_BAR;
    } else {
        PG8_STAGE(PG8_SB(0, 0), cB, voffB); PG8_STAGE(PG8_SA(0, 0), cA, voffA); PG8_STAGE(PG8_SB(0, 1), cB + hstep, voffB); PG8_STAGE(PG8_SA(0, 1), cA + hstep, voffA);
        if (wr == 1) PG8_BAR;
        PG8_WAIT_V(4); PG8_BAR;
        PG8_STAGE(PG8_SB(1, 0), cB + kstep, voffB); PG8_STAGE(PG8_SA(1, 0), cA + kstep, voffA); PG8_STAGE(PG8_SB(1, 1), cB + hstep + kstep, voffB);
        PG8_WAIT_V(6); PG8_BAR;
    }
    for (;;) {
        const bool has_next = S.next(ui + 1, nxt);
        const char* nA = has_next ? (const char*)g.A + (size_t)nxt.pm * tstep : cA; const char* nB = has_next ? (const char*)g.Bt + (size_t)nxt.pn * tstep : cB;
        for (int t = 0; t < nt; t += 2) {
            const bool last = (t == nt - 2);
            const char* a1 = cA + (size_t)(t + 1) * kstep;
            const char* a2 = last ? nA : cA + (size_t)(t + 2) * kstep; const char* b2 = last ? nB : cB + (size_t)(t + 2) * kstep;
            const char* a3 = a2 + kstep; const char* b3 = b2 + kstep;
            if (last && has_next) S.a_ready(nxt);
            if constexpr (SP2) {
            PG8_LDB(B0, 0, 0); PG8_LDB(B1, 0, 1); PG8_SCHED; PG8_LDA(At, 0, 0); PG8_STAGE(PG8_SA(1, 1), a1 + hstep, voffA);
            PG8_WAIT_V(8); PG8_WAIT_L(0); PG8_BAR; PG8_MMA(0, 0, At, B0); PG8_MMA(0, 1, At, B1); PG8_BAR; PG8_SCHED;
            PG8_LDA(At, 0, 1); PG8_STAGE(PG8_SB(0, 0), b2, voffB); PG8_STAGE(PG8_SB(0, 1), b2 + hstep, voffB); PG8_STAGE(PG8_SA(0, 0), a2, voffA);
            PG8_WAIT_V(8); PG8_WAIT_L(0); PG8_BAR; PG8_MMA(1, 0, At, B0); PG8_MMA(1, 1, At, B1); PG8_BAR; PG8_SCHED;
            PG8_LDB(B0, 1, 0); PG8_LDB(B1, 1, 1); PG8_SCHED; PG8_LDA(At, 1, 0); PG8_STAGE(PG8_SA(0, 1), a2 + hstep, voffA);
            PG8_WAIT_V(8); PG8_WAIT_L(0); PG8_BAR; PG8_MMA(0, 0, At, B0); PG8_MMA(0, 1, At, B1); PG8_BAR; PG8_SCHED;
            PG8_LDA(At, 1, 1); PG8_STAGE(PG8_SB(1, 0), b3, voffB); PG8_STAGE(PG8_SB(1, 1), b3 + hstep, voffB); PG8_STAGE(PG8_SA(1, 0), a3, voffA);
            PG8_WAIT_V(8); PG8_WAIT_L(0); PG8_BAR; PG8_MMA(1, 0, At, B0); PG8_MMA(1, 1, At, B1); PG8_BAR; PG8_SCHED;
            } else {
            PG8_LDB(B0, 0, 0); PG8_SCHED; PG8_LDA(At, 0, 0); PG8_STAGE(PG8_SA(1, 1), a1 + hstep, voffA);
            PG8_WAIT_L(8); PG8_BAR; PG8_WAIT_L(0); PG8_MMA(0, 0, At, B0); PG8_BAR; PG8_SCHED;
            PG8_LDB(B1, 0, 1); PG8_STAGE(PG8_SB(0, 0), b2, voffB);
            PG8_BAR; PG8_WAIT_L(0); PG8_MMA(0, 1, At, B1); PG8_BAR;
            PG8_LDA(At, 0, 1); PG8_STAGE(PG8_SA(0, 0), a2, voffA);
            PG8_BAR; PG8_WAIT_L(0); PG8_MMA(1, 0, At, B0); PG8_BAR; PG8_SCHED;
            PG8_STAGE(PG8_SB(0, 1), b2 + hstep, voffB);
            PG8_WAIT_V(6); PG8_BAR; PG8_MMA(1, 1, At, B1); PG8_BAR;
            PG8_LDB(B0, 1, 0); PG8_SCHED; PG8_LDA(At, 1, 0); PG8_STAGE(PG8_SA(0, 1), a2 + hstep, voffA);
            PG8_WAIT_L(8); PG8_BAR; PG8_WAIT_L(0); PG8_MMA(0, 0, At, B0); PG8_BAR; PG8_SCHED;
            PG8_LDB(B1, 1, 1); PG8_STAGE(PG8_SB(1, 0), b3, voffB);
            PG8_BAR; PG8_WAIT_L(0); PG8_MMA(0, 1, At, B1); PG8_BAR;
            PG8_LDA(At, 1, 1); PG8_STAGE(PG8_SA(1, 0), a3, voffA);
            PG8_BAR; PG8_WAIT_L(0); PG8_MMA(1, 0, At, B0); PG8_BAR; PG8_SCHED;
            PG8_STAGE(PG8_SB(1, 1), b3 + hstep, voffB);
            PG8_WAIT_V(6); PG8_BAR; PG8_MMA(1, 1, At, B1); PG8_BAR;
            }
        }
        if constexpr (ALIGN_EPI) { if (wr == 0) PG8_BAR; }
        E(acc, cur, wr, wc, fr, fq); S.done(cur);
        if (!has_next) break;
#pragma unroll
        for (int a = 0; a < 2; ++a)
#pragma unroll
            for (int b = 0; b < 2; ++b)
#pragma unroll
                for (int m = 0; m < 4; ++m)
#pragma unroll
                    for (int n = 0; n < 2; ++n) acc[a][b][m][n] = (f32x4){0.f, 0.f, 0.f, 0.f};
        cur = nxt; cA = nA; cB = nB; ++ui;
        if constexpr (ALIGN_EPI) { if (wr == 1) PG8_BAR; }
    }
    PG8_WAIT_V(0);
    if constexpr (!ALIGN_EPI) { if (wr == 0) PG8_BAR; }
    PG8_BAR;
#undef PG8_SA
#undef PG8_SB
#undef PG8_STAGE
#undef PG8_LDA
#undef PG8_LDB
#undef PG8_MMA
#undef PG8_WAIT_V
#undef PG8_WAIT_L
#undef PG8_BAR
#undef PG8_SCHED
}
}

typedef unsigned short bf16;
typedef float f32x4 __attribute__((ext_vector_type(4)));
typedef unsigned v4u __attribute__((ext_vector_type(4)));
typedef unsigned v2u __attribute__((ext_vector_type(2)));
constexpr int NB_ = 8, SEQ = 4096, D = 1024, M = NB_ * SEQ;
constexpr int ML_H = 8, ML_DV = 128, ML_DQK = 64, ML_L = 64, ML_NC = SEQ / ML_L, ML_IN = 3088, ML_INP = 3328;
constexpr int MB_H = 16, MB_KVH = 4, MB_HD = 64, MB_BLK = 256, MB_NB = SEQ / MB_BLK;
constexpr int FF = 2816, PLE = 256;
constexpr float EPS = 1e-6f, GATE_CAP = 15.0f;
constexpr int NWAVES = 8, NTHREADS = 512;

constexpr size_t MiB = 1u << 20;
constexpr size_t WS_CTL = 0, CTL_ZERO_BYTES = 1 * MiB;
constexpr size_t WS_ROPE = 1 * MiB;
constexpr size_t WS_KMP = 1 * MiB + 512 * 1024;
constexpr size_t WS_SSQ = 2 * MiB;
constexpr size_t WS_GATES = 6 * MiB;
constexpr size_t WS_MLOC = 8 * MiB, WS_GLAST = WS_MLOC + 16384, WS_MPREV = WS_GLAST + 16384;
constexpr size_t WS_NLOC = 9 * MiB;
constexpr size_t WS_WIN = 10 * MiB, WS_WOUT = 17 * MiB, WS_WQKV1 = 19 * MiB, WS_WO1 = 22 * MiB, WS_WGU = 24 * MiB  , WS_WDN = 46 * MiB  , WS_WPG = 58 * MiB  , WS_WPU = 62 * MiB  ;
constexpr size_t WS_HB = 64 * MiB, WS_HB2 = 448 * MiB;
constexpr size_t WS_PB = 128 * MiB;
constexpr size_t WS_UP = 160 * MiB;
constexpr size_t WS_OG = 160 * MiB;
constexpr size_t WS_Q0 = 224 * MiB, WS_K0 = 256 * MiB, WS_V0 = 288 * MiB  , WS_CLOC = 384 * MiB  ;
constexpr size_t WS_ACT = 224 * MiB;
constexpr size_t WS_Q1 = 224 * MiB, WS_K1 = 288 * MiB, WS_V1 = 304 * MiB, WS_AO = 320 * MiB;
constexpr size_t WS_END = 512 * MiB;

constexpr int LDS_BYTES = 147456;
constexpr int RING_BYTES = 131072;
constexpr int LDSCTL_OFF = RING_BYTES;

__device__ __forceinline__ unsigned f2bf(float f) { unsigned u = __builtin_bit_cast(unsigned, f); return (u + 0x7fffu + ((u >> 16) & 1u)) >> 16; }
__device__ __forceinline__ unsigned pk2(float lo, float hi) { return pg8::cvt_pk_bf16(lo, hi); }
__device__ __forceinline__ float bf_lo(unsigned u) { return __builtin_bit_cast(float, u << 16); }
__device__ __forceinline__ float bf_hi(unsigned u) { return __builtin_bit_cast(float, u & 0xffff0000u); }
__device__ __forceinline__ float rstd_of(const float* ssq, int row) {
    const f32x4* p = (const f32x4*)(ssq + (size_t)row * 16);
    const f32x4 a = p[0], b = p[1], c = p[2], d = p[3];
    const float s = (((a[0] + a[1]) + (a[2] + a[3])) + ((b[0] + b[1]) + (b[2] + b[3]))) + (((c[0] + c[1]) + (c[2] + c[3])) + ((d[0] + d[1]) + (d[2] + d[3])));
    return __builtin_amdgcn_rsqf(s * (1.0f / D) + EPS);
}
__device__ __forceinline__ float sigmoidf_(float x) { return __builtin_amdgcn_rcpf(1.0f + __builtin_amdgcn_exp2f(-1.4426950408889634f * x)); }
__device__ __forceinline__ float shx(float v, int mask, int lane) { return __builtin_bit_cast(float, __builtin_amdgcn_ds_bpermute((lane ^ mask) << 2, __builtin_bit_cast(int, v))); }
__device__ __forceinline__ int shxi(int v, int mask, int lane) { return __builtin_amdgcn_ds_bpermute((lane ^ mask) << 2, v); }
__device__ __forceinline__ float shup(float v, int o, int lane) { return __builtin_bit_cast(float, __builtin_amdgcn_ds_bpermute((lane >= o ? lane - o : lane) << 2, __builtin_bit_cast(int, v))); }
__device__ __forceinline__ float shidx(float v, int src) { return __builtin_bit_cast(float, __builtin_amdgcn_ds_bpermute(src << 2, __builtin_bit_cast(int, v))); }
__device__ __forceinline__ float wave_sum(float v, int lane) {
#pragma unroll
    for (int o = 1; o < 64; o <<= 1) v += shx(v, o, lane);
    return v;
}
__device__ __forceinline__ float wave_max(float v, int lane) {
#pragma unroll
    for (int o = 1; o < 64; o <<= 1) v = fmaxf(v, shx(v, o, lane));
    return v;
}

using pg8::Unit; using pg8::HALF; using pg8::BM;
#define ROWS8 _Pragma("unroll") for (int ai = 0; ai < 2; ++ai) _Pragma("unroll") for (int m = 0; m < 4; ++m)

struct EpiMl {
    static constexpr bool PERM = true, AFTER_DRAIN = false;
    unsigned char* ws; float* gates; const float* ssq; const float* bgate;
    __device__ __forceinline__ void operator()(const f32x4 (&acc)[2][2][4][2], const Unit& u, int wr, int wc, int fr, int fq) const {
        const int row0 = u.pm * BM + wr * 64 + fr;
        float rs[2][4];
        ROWS8 { rs[ai][m] = rstd_of(ssq, row0 + ai * HALF + m * 16); }
        if (u.pn < 12) {
            const int t = u.pn < 2 ? 0 : (u.pn < 4 ? 1 : (u.pn < 8 ? 2 : 3));
            const size_t boff = t == 0 ? WS_Q0 : (t == 1 ? WS_K0 : (t == 2 ? WS_V0 : WS_OG));
            const int ld = t < 2 ? 512 : 1024, colt = (u.pn - (t == 0 ? 0 : (t == 1 ? 2 : (t == 2 ? 4 : 8)))) * 256; const float sc = t == 0 ? 0.125f : 1.f;
            bf16* base = (bf16*)(ws + boff);
            const int col0 = colt + wc * 32 + 8 * fq;
            ROWS8 { bf16* rowp = base + (size_t)(row0 + ai * HALF + m * 16) * ld + col0; const float r = rs[ai][m] * sc;
#pragma unroll
                for (int bj = 0; bj < 2; ++bj) { const f32x4 v0 = acc[ai][bj][m][0] * r, v1 = acc[ai][bj][m][1] * r; v4u w; w.x = pk2(v0[0], v0[1]); w.y = pk2(v0[2], v0[3]); w.z = pk2(v1[0], v1[1]); w.w = pk2(v1[2], v1[3]);
                    *(v4u*)(rowp + bj * HALF) = w; } }
        } else if (wc == 0 && fq < 2) {
            float bg[8];
#pragma unroll
            for (int j = 0; j < 8; ++j) bg[j] = bgate[8 * fq + j];
            ROWS8 { const int row = row0 + ai * HALF + m * 16; const float r = rs[ai][m]; float o[8];
#pragma unroll
                for (int j = 0; j < 8; ++j) { const float pre = acc[ai][0][m][j >> 2][j & 3] * r + bg[j]; const float c = GATE_CAP * tanhf(pre * (1.0f / GATE_CAP));
                    o[j] = (fq == 0) ? c : -log1pf(expf(-c)); }
                float* gp = gates + (size_t)row * 16 + 8 * fq; *(f32x4*)gp = (f32x4){o[0], o[1], o[2], o[3]}; *(f32x4*)(gp + 4) = (f32x4){o[4], o[5], o[6], o[7]}; }
        }
    }
};
struct EpiQkv1 {
    static constexpr bool PERM = true, AFTER_DRAIN = false;
    unsigned char* ws; const float* ssq;
    __device__ __forceinline__ void operator()(const f32x4 (&acc)[2][2][4][2], const Unit& u, int wr, int wc, int fr, int fq) const {
        const int row0 = u.pm * BM + wr * 64 + fr;
        const size_t boff = u.pn < 4 ? WS_Q1 : (u.pn == 4 ? WS_K1 : WS_V1); const int ld = u.pn < 4 ? 1024 : 256, colt = u.pn < 4 ? u.pn * 256 : 0;
        bf16* base = (bf16*)(ws + boff);
        const int col0 = colt + wc * 32 + 8 * fq;
        ROWS8 { const float r = rstd_of(ssq, row0 + ai * HALF + m * 16); bf16* rowp = base + (size_t)(row0 + ai * HALF + m * 16) * ld + col0;
#pragma unroll
            for (int bj = 0; bj < 2; ++bj) { const f32x4 v0 = acc[ai][bj][m][0] * r, v1 = acc[ai][bj][m][1] * r; v4u w; w.x = pk2(v0[0], v0[1]); w.y = pk2(v0[2], v0[3]); w.z = pk2(v1[0], v1[1]); w.w = pk2(v1[2], v1[3]);
                *(v4u*)(rowp + bj * HALF) = w; }
            if (m == 3) asm volatile("" ::: "memory"); }
    }
};
struct EpiPlain {
    static constexpr bool PERM = true, AFTER_DRAIN = false;
    bf16* O; int ld;
    __device__ __forceinline__ void operator()(const f32x4 (&acc)[2][2][4][2], const Unit& u, int wr, int wc, int fr, int fq) const {
        const int row0 = u.pm * BM + wr * 64 + fr, col0 = u.pn * BM + wc * 32 + 8 * fq;
        ROWS8 { bf16* rowp = O + (size_t)(row0 + ai * HALF + m * 16) * ld + col0;
#pragma unroll
            for (int bj = 0; bj < 2; ++bj) { const f32x4 v0 = acc[ai][bj][m][0], v1 = acc[ai][bj][m][1]; v4u w; w.x = pk2(v0[0], v0[1]); w.y = pk2(v0[2], v0[3]); w.z = pk2(v1[0], v1[1]); w.w = pk2(v1[2], v1[3]);
                *(v4u*)(rowp + bj * HALF) = w; } }
    }
};
struct EpiSwiglu {
    static constexpr bool PERM = true, AFTER_DRAIN = false;
    bf16* act; const float* ssq;
    __device__ __forceinline__ void operator()(const f32x4 (&acc)[2][2][4][2], const Unit& u, int wr, int wc, int fr, int fq) const {
        const int row0 = u.pm * BM + wr * 64 + fr, col0 = u.pn * HALF + wc * 32 + 8 * fq;
        ROWS8 { const float r = rstd_of(ssq, row0 + ai * HALF + m * 16); bf16* rowp = act + (size_t)(row0 + ai * HALF + m * 16) * FF + col0; float o[8];
#pragma unroll
            for (int n = 0; n < 2; ++n)
#pragma unroll
                for (int e = 0; e < 4; ++e) { const float gv = acc[ai][0][m][n][e] * r, uv = acc[ai][1][m][n][e] * r; o[4 * n + e] = gv * sigmoidf_(gv) * uv; }
            v4u w; w.x = pk2(o[0], o[1]); w.y = pk2(o[2], o[3]); w.z = pk2(o[4], o[5]); w.w = pk2(o[6], o[7]); *(v4u*)rowp = w;
            if (m == 3) asm volatile("" ::: "memory"); }
    }
};
struct EpiRes {
    static constexpr bool PERM = false, AFTER_DRAIN = false;
    const float* base; float* out; bf16* hb; float* ssq;
    __device__ __forceinline__ void operator()(const f32x4 (&acc)[2][2][4][2], const Unit& u, int wr, int wc, int fr, int fq) const {
        const int row0 = u.pm * BM + wr * 64 + fr, col0 = u.pn * BM + wc * 32 + 4 * fq;
        ROWS8 { const int row = row0 + ai * HALF + m * 16; const size_t off = (size_t)row * D + col0; float part = 0.f;
#pragma unroll
            for (int bj = 0; bj < 2; ++bj)
#pragma unroll
                for (int n = 0; n < 2; ++n) { const size_t o2 = off + bj * HALF + n * 16; const f32x4 o = *(const f32x4*)(base + o2) + acc[ai][bj][m][n];
                    *(f32x4*)(out + o2) = o; v2u w; w.x = pk2(o[0], o[1]); w.y = pk2(o[2], o[3]); *(v2u*)(hb + o2) = w; part += (o[0] * o[0] + o[1] * o[1]) + (o[2] * o[2] + o[3] * o[3]); }
            part += shx(part, 16, fr + 16 * fq); part += shx(part, 32, fr + 16 * fq);
            if (fq == 0) ssq[(size_t)row * 16 + 4 * u.pn + wc] = part;
            if (m & 1) asm volatile("" ::: "memory"); }
    }
};
struct EpiPle {
    static constexpr bool PERM = false, AFTER_DRAIN = false;
    const float* base; float* out; bf16* hb; float* ssq_out; const float* ssq_in; const bf16* up;
    __device__ __forceinline__ void operator()(const f32x4 (&acc)[2][2][4][2], const Unit& u, int wr, int wc, int fr, int fq) const {
        const int row0 = u.pm * BM + wr * 64 + fr, col0 = u.pn * BM + wc * 32 + 4 * fq;
        ROWS8 { const int row = row0 + ai * HALF + m * 16; const size_t off = (size_t)row * D + col0; const float r = rstd_of(ssq_in, row); float part = 0.f;
#pragma unroll
            for (int bj = 0; bj < 2; ++bj)
#pragma unroll
                for (int n = 0; n < 2; ++n) { const size_t o2 = off + bj * HALF + n * 16; const v2u uw = *(const v2u*)(up + o2); const f32x4 a = acc[ai][bj][m][n] * r;
                    f32x4 o = *(const f32x4*)(base + o2);
                    o[0] += bf_lo(uw.x) * sigmoidf_(a[0]); o[1] += bf_hi(uw.x) * sigmoidf_(a[1]); o[2] += bf_lo(uw.y) * sigmoidf_(a[2]); o[3] += bf_hi(uw.y) * sigmoidf_(a[3]);
                    *(f32x4*)(out + o2) = o; v2u w; w.x = pk2(o[0], o[1]); w.y = pk2(o[2], o[3]); *(v2u*)(hb + o2) = w; part += (o[0] * o[0] + o[1] * o[1]) + (o[2] * o[2] + o[3] * o[3]); }
            part += shx(part, 16, fr + 16 * fq); part += shx(part, 32, fr + 16 * fq);
            if (fq == 0) ssq_out[(size_t)row * 16 + 4 * u.pn + wc] = part;
            asm volatile("" ::: "memory"); }
    }
};

typedef GAS unsigned gu32;
#define RLX_AGENT __ATOMIC_RELAXED, __HIP_MEMORY_SCOPE_AGENT
#define XB_TMO      128
#define XB_XCNT(j)  (256  + 64 * (j))
#define XB_XSUB(j)  (1280 + 64 * (j))
#define XB_XGEN(j)  (2304 + 64 * (j))
#define XB_TOP      3328
#define XB_TOPGEN   3392
#define XCD_BAR_WORDS 3456
#define XB_SPIN_CAP (1u << 22)
__device__ __forceinline__ unsigned xb_ld(unsigned* p)              { return __hip_atomic_load(p, __ATOMIC_RELAXED, __HIP_MEMORY_SCOPE_AGENT); }
__device__ __forceinline__ unsigned xb_add(unsigned* p, unsigned v) { return __hip_atomic_fetch_add(p, v, __ATOMIC_RELAXED, __HIP_MEMORY_SCOPE_AGENT); }
__device__ __forceinline__ unsigned xb_xcc_id() { return (unsigned)__builtin_amdgcn_s_getreg((3 << 11) | 20) & 0xFu; }
#define XB_SPIN(cond, bar) do { unsigned _sp = 0; while (cond) { __builtin_amdgcn_s_sleep(1); \
    if ((++_sp & 255u) == 0u) { if (xb_ld(&(bar)[XB_TMO])) break; if (_sp > XB_SPIN_CAP) { atomicAdd(&(bar)[XB_TMO], 1u); break; } } } } while (0)
struct XcdBarrier { unsigned* bar; unsigned x; volatile LAS unsigned* st; };
__device__ __forceinline__ XcdBarrier xcd_barrier_post(unsigned* bar, volatile LAS unsigned* st) {
    XcdBarrier b; b.bar = bar; b.x = xb_xcc_id(); b.st = st;
    if (threadIdx.x == 0) (void)xb_add(&bar[XB_XCNT(b.x)], 1u);
    return b;
}
__device__ __forceinline__ void xcd_barrier_complete(unsigned* bar, unsigned x, unsigned& nloc, unsigned& nx) {
    const unsigned G = gridDim.x * gridDim.y * gridDim.z;
    unsigned sum, cnt, mine, sp = 0u;
    for (;;) {
        sum = 0u; cnt = 0u; mine = 0u;
#pragma unroll
        for (unsigned j = 0; j < 16; ++j) { const unsigned c = xb_ld(&bar[XB_XCNT(j)]); sum += c; cnt += (c > 0u) ? 1u : 0u; mine = (j == x) ? c : mine; }
        if (sum == G) break;
        __builtin_amdgcn_s_sleep(1);
        if ((++sp & 255u) == 0u) { if (xb_ld(&bar[XB_TMO])) break; if (sp > XB_SPIN_CAP) { atomicAdd(&bar[XB_TMO], 1u); break; } }
    }
    nloc = mine > 0u ? mine : 1u; nx = cnt > 0u ? cnt : 1u;
}
__device__ __forceinline__ void xcd_barrier(const XcdBarrier& b) {
    asm volatile("s_waitcnt vmcnt(0)" ::: "memory");
    __syncthreads();
    if (threadIdx.x == 0) {
        unsigned* bar = b.bar;
        __builtin_amdgcn_s_waitcnt(0);
        unsigned nloc = b.st[0], nx = b.st[1];
        if (nloc == 0u) { xcd_barrier_complete(bar, b.x, nloc, nx); b.st[0] = nloc; b.st[1] = nx; }
        const unsigned old = xb_add(&bar[XB_XSUB(b.x)], 1u);
        const unsigned gen = old / nloc;
        if (old + 1u == (gen + 1u) * nloc) {
            __builtin_amdgcn_fence(__ATOMIC_RELEASE, "agent");
            asm volatile("s_waitcnt vmcnt(0)" ::: "memory");
            const unsigned og = xb_add(&bar[XB_TOP], 1u);
            const unsigned tg = og / nx;
            if (og + 1u == (tg + 1u) * nx) xb_add(&bar[XB_TOPGEN], 1u);
            else XB_SPIN(xb_ld(&bar[XB_TOPGEN]) == tg, bar);
            __builtin_amdgcn_fence(__ATOMIC_ACQUIRE, "agent");
            xb_add(&bar[XB_XGEN(b.x)], 1u);
            asm volatile("s_waitcnt vmcnt(0)" ::: "memory");
        } else {
            XB_SPIN(xb_ld(&bar[XB_XGEN(b.x)]) == gen, bar);
            __builtin_amdgcn_fence(__ATOMIC_ACQUIRE, "agent");
            asm volatile("s_waitcnt vmcnt(0)" ::: "memory");
        }
    }
    __syncthreads();
}

template <int MODE>
__device__ __forceinline__ void p0_transpose_item(const float* W, int K, int N, const float* gain, bf16* WT, int row_off, LAS float* scr, int item, int lane) {
    const int nblk = (N + 31) / 32, kb = item / nblk, nb = item % nblk, k0 = 64 * kb, n0 = 32 * nb;
    const int ncol = n0 + (lane & 31); const bool nok = ncol < N;
#pragma unroll 8
    for (int i = 0; i < 32; ++i) { const int kk = 2 * i + (lane >> 5); float v = nok ? W[(size_t)(k0 + kk) * N + ncol] : 0.f; if (gain) v *= gain[k0 + kk]; scr[kk * 33 + (lane & 31)] = v; }
    asm volatile("s_waitcnt lgkmcnt(0)" ::: "memory");
    const int c = lane & 7;
    int drow0;
    if (MODE == 0) drow0 = row_off + n0; else { const int isu = n0 >= FF ? 1 : 0, j0 = n0 - isu * FF; drow0 = 256 * (j0 / 128) + 128 * isu + (j0 % 128); }
#pragma unroll
    for (int j = 0; j < 4; ++j) { const int n = (lane >> 3) + 8 * j; const LAS float* s = scr + (8 * c) * 33 + n;
        v4u o; o.x = pk2(s[0 * 33], s[1 * 33]); o.y = pk2(s[2 * 33], s[3 * 33]); o.z = pk2(s[4 * 33], s[5 * 33]); o.w = pk2(s[6 * 33], s[7 * 33]);
        if (n0 + n < N) *(v4u*)(WT + (size_t)(drow0 + n) * K + k0 + 8 * c) = o; }
    asm volatile("s_waitcnt lgkmcnt(0)" ::: "memory");
}

struct Args { const float* in[19]; float* out; unsigned char* ws; int ph_lo, ph_hi; };
typedef const Args __attribute__((address_space(4))) CArgs;

__device__ __forceinline__ void p0_prologue(CArgs* A, LAS unsigned char* lds, int G, int vcu, int wave, int lane) {
    unsigned char* ws = A->ws;
    LAS float* scr = (LAS float*)(lds + wave * 16384);
    const int gw = vcu * NWAVES + wave, NGW = G * NWAVES;
    struct WI { int items; };
    constexpr int I_IN = 16 * 97, I_SQ = 16 * 32, I_KV = 16 * 16, I_GU = 16 * 176, I_DN = 44 * 32, I_PU = 4 * 32;
    constexpr int NITEMS = I_IN + I_SQ   + I_SQ   + I_KV + I_SQ   + 2 * I_GU + 2 * I_DN + 2 * I_SQ + 2 * I_PU;
    for (int it = gw; it < NITEMS; it += NGW) {
        int r = it;
        if (r < I_IN) { p0_transpose_item<0>(A->in[3], D, ML_IN, A->in[2], (bf16*)(ws + WS_WIN), 0, scr, r, lane); continue; } r -= I_IN;
        if (r < I_SQ) { p0_transpose_item<0>(A->in[6], D, D, nullptr, (bf16*)(ws + WS_WOUT), 0, scr, r, lane); continue; } r -= I_SQ;
        if (r < I_SQ) { p0_transpose_item<0>(A->in[10], D, D, A->in[2] + D, (bf16*)(ws + WS_WQKV1), 0, scr, r, lane); continue; } r -= I_SQ;
        if (r < I_KV) { p0_transpose_item<0>(A->in[8], D, 512, A->in[7], (bf16*)(ws + WS_WQKV1), D, scr, r, lane); continue; } r -= I_KV;
        if (r < I_SQ) { p0_transpose_item<0>(A->in[12], D, D, nullptr, (bf16*)(ws + WS_WO1), 0, scr, r, lane); continue; } r -= I_SQ;
        if (r < 2 * I_GU) { const int l = r / I_GU; p0_transpose_item<1>(A->in[14] + (size_t)l * D * 2 * FF, D, 2 * FF, A->in[13] + l * D, (bf16*)(ws + WS_WGU + l * 11 * MiB), 0, scr, r % I_GU, lane); continue; } r -= 2 * I_GU;
        if (r < 2 * I_DN) { const int l = r / I_DN; p0_transpose_item<0>(A->in[15] + (size_t)l * FF * D, FF, D, nullptr, (bf16*)(ws + WS_WDN + l * 6 * MiB), 0, scr, r % I_DN, lane); continue; } r -= 2 * I_DN;
        if (r < 2 * I_SQ) { const int l = r / I_SQ; p0_transpose_item<0>(A->in[17] + (size_t)l * D * D, D, D, A->in[16] + l * D, (bf16*)(ws + WS_WPG + l * 2 * MiB), 0, scr, r % I_SQ, lane); continue; } r -= 2 * I_SQ;
        { const int l = r / I_PU; p0_transpose_item<0>(A->in[18] + (size_t)l * PLE * D, PLE, D, nullptr, (bf16*)(ws + WS_WPU + l * (MiB / 2)), 0, scr, r % I_PU, lane); }
    }
    {
        const float* x = A->in[0]; bf16* hb = (bf16*)(ws + WS_HB); float* ssq = (float*)(ws + WS_SSQ);
        for (int m = gw; m < M; m += NGW) {
            const f32x4* xr = (const f32x4*)(x + (size_t)m * D) + lane; f32x4 v[4]; float s = 0.f;
#pragma unroll
            for (int j = 0; j < 4; ++j) { v[j] = xr[64 * j]; s += (v[j][0] * v[j][0] + v[j][1] * v[j][1]) + (v[j][2] * v[j][2] + v[j][3] * v[j][3]); }
            s = wave_sum(s, lane);
            unsigned long long* o8 = (unsigned long long*)(hb + (size_t)m * D) + lane;
#pragma unroll
            for (int j = 0; j < 4; ++j) o8[64 * j] = (unsigned long long)pk2(v[j][0], v[j][1]) | ((unsigned long long)pk2(v[j][2], v[j][3]) << 32);
            if (lane < 16) ssq[(size_t)m * 16 + lane] = (lane == 0) ? s : 0.f;
        }
    }
    {
        const float* p = A->in[1]; bf16* pb = (bf16*)(ws + WS_PB);
        const size_t n8 = (size_t)2 * M * PLE / 8, gt = (size_t)gw * 64 + lane, ngt = (size_t)NGW * 64;
        for (size_t i = gt; i < n8; i += ngt) { const f32x4 a = *(const f32x4*)(p + i * 8), b = *(const f32x4*)(p + i * 8 + 4);
            v4u w; w.x = pk2(a[0], a[1]); w.y = pk2(a[2], a[3]); w.z = pk2(b[0], b[1]); w.w = pk2(b[2], b[3]); *(v4u*)(pb + i * 8) = w; }
    }
    {
        float* rc = (float*)(ws + WS_ROPE); float* rsn = rc + SEQ * 8;
        const int gt = gw * 64 + lane;
        if (gt < SEQ * 8) { const int pos = gt >> 3, i = gt & 7;
            const float inv = (i == 0 ? 1.000000000e+00f : i == 1 ? 1.939227432e-01f : i == 2 ? 3.760603070e-02f : i == 3 ? 7.292664610e-03f : i == 4 ? 1.414213562e-03f : i == 5 ? 2.742481884e-04f : i == 6 ? 5.318295734e-05f : 1.031338525e-05f);
            const float angf = (float)pos * inv;
            const double rev = (double)angf * 0.15915494309189535; const double fr = rev - rint(rev);
            rc[gt] = __builtin_amdgcn_cosf((float)fr); rsn[gt] = __builtin_amdgcn_sinf((float)fr); }
    }
}

__device__ __forceinline__ float wave_incl_scan(float v, int lane) {
#pragma unroll
    for (int o = 1; o < 64; o <<= 1) { const float t = shup(v, o, lane); if (lane >= o) v += t; }
    return v;
}
__device__ __forceinline__ float wave_incl_max(float v, int lane) {
#pragma unroll
    for (int o = 1; o < 64; o <<= 1) { const float t = shup(v, o, lane); if (lane >= o) v = fmaxf(v, t); }
    return v;
}
__device__ __forceinline__ void mlstm_a(CArgs* A, LAS unsigned char* lds, int G, const int bx, const int tid) {
    unsigned char* ws = A->ws; const int lane = tid & 63;
    LAS float* kf = (LAS float*)lds;
    LAS float* vw = kf + 4096;
    LAS float* wl = vw + 8192;
    const float* gates = (const float*)(ws + WS_GATES); const bf16* K0 = (const bf16*)(ws + WS_K0); const bf16* V0 = (const bf16*)(ws + WS_V0);
    float* cloc = (float*)(ws + WS_CLOC); float* nloc = (float*)(ws + WS_NLOC); float* mloc = (float*)(ws + WS_MLOC); float* glast = (float*)(ws + WS_GLAST);
    for (int unit = bx; unit < NB_ * ML_H * ML_NC; unit += G) {
        const int bh = unit >> 6, c = unit & 63, b = bh >> 3, h = bh & 7, row0 = b * SEQ + c * ML_L;
        if (tid < 64) {
            const float li = gates[(size_t)(row0 + tid) * 16 + h], lf = gates[(size_t)(row0 + tid) * 16 + 8 + h];
            const float g = wave_incl_scan(lf, lane); const float gl = shidx(g, 63);
            const float a = gl - g + li; const float ml = wave_max(a, lane);
            wl[tid] = expf(a - ml);
            if (tid == 0) { mloc[unit] = ml; glast[unit] = gl; }
        }
        __syncthreads();
        { const int s = tid >> 3, kc = (tid & 7) * 8; const v4u kk = *(const v4u*)(K0 + (size_t)(row0 + s) * 512 + h * 64 + kc); LAS float* d = kf + s * 64 + kc;
          d[0] = bf_lo(kk.x); d[1] = bf_hi(kk.x); d[2] = bf_lo(kk.y); d[3] = bf_hi(kk.y); d[4] = bf_lo(kk.z); d[5] = bf_hi(kk.z); d[6] = bf_lo(kk.w); d[7] = bf_hi(kk.w);
          const int vc = (tid & 7) * 16; const float w = wl[s]; const v4u v0 = *(const v4u*)(V0 + (size_t)(row0 + s) * 1024 + h * 128 + vc), v1 = *(const v4u*)(V0 + (size_t)(row0 + s) * 1024 + h * 128 + vc + 8);
          LAS float* e = vw + s * 128 + vc;
          e[0] = w * bf_lo(v0.x); e[1] = w * bf_hi(v0.x); e[2] = w * bf_lo(v0.y); e[3] = w * bf_hi(v0.y); e[4] = w * bf_lo(v0.z); e[5] = w * bf_hi(v0.z); e[6] = w * bf_lo(v0.w); e[7] = w * bf_hi(v0.w);
          e[8] = w * bf_lo(v1.x); e[9] = w * bf_hi(v1.x); e[10] = w * bf_lo(v1.y); e[11] = w * bf_hi(v1.y); e[12] = w * bf_lo(v1.z); e[13] = w * bf_hi(v1.z); e[14] = w * bf_lo(v1.w); e[15] = w * bf_hi(v1.w); }
        __syncthreads();
        { const int v = tid >> 2, kg = (tid & 3) * 16; float acc[16];
#pragma unroll
          for (int i = 0; i < 16; ++i) acc[i] = 0.f;
          for (int s = 0; s < 64; ++s) { const float a = vw[s * 128 + v];
#pragma unroll
              for (int i = 0; i < 16; ++i) acc[i] += a * kf[s * 64 + kg + i]; }
          float* o = cloc + (size_t)unit * 8192 + v * 64 + kg;
#pragma unroll
          for (int i = 0; i < 4; ++i) *(f32x4*)(o + 4 * i) = (f32x4){acc[4 * i], acc[4 * i + 1], acc[4 * i + 2], acc[4 * i + 3]};
          if (tid < 64) { float n = 0.f; for (int s = 0; s < 64; ++s) n += wl[s] * kf[s * 64 + tid]; nloc[(size_t)unit * 64 + tid] = n; } }
        __syncthreads();
    }
}
__device__ __forceinline__ void mlstm_scan(CArgs* A, int G, const int bx, const int tid) {
    unsigned char* ws = A->ws;
    float* cloc = (float*)(ws + WS_CLOC); float* nloc = (float*)(ws + WS_NLOC); const float* mloc = (const float*)(ws + WS_MLOC); const float* glast = (const float*)(ws + WS_GLAST); float* mprev = (float*)(ws + WS_MPREV);
    for (int su = bx; su < 64 * 4; su += G) {
        const int bh = su >> 2, qt = su & 3;
        float* cp = cloc + (size_t)bh * 64 * 8192 + qt * 2048 + tid * 4;
        f32x4 C = (f32x4){0.f, 0.f, 0.f, 0.f}; float n = 0.f, m = 0.f;
        for (int c = 0; c < 64; ++c) {
            const float ml = mloc[bh * 64 + c], gl = glast[bh * 64 + c];
            const float mn = fmaxf(gl + m, ml), sp = expf(gl + m - mn), sl = expf(ml - mn);
            const f32x4 cl = *(const f32x4*)(cp + (size_t)c * 8192);
            *(f32x4*)(cp + (size_t)c * 8192) = C;
            C = C * sp + cl * sl;
            if (qt == 0 && tid < 64) { float* np = nloc + (size_t)(bh * 64 + c) * 64 + tid; const float nl = *np; *np = n; n = sp * n + sl * nl; }
            if (qt == 0 && tid == 0) mprev[bh * 64 + c] = m;
            m = mn;
        }
    }
}
__device__ __forceinline__ void mlstm_c(CArgs* A, LAS unsigned char* lds, int G, const int bx, const int tid) {
    unsigned char* ws = A->ws; const int lane = tid & 63;
    LAS float* qf = (LAS float*)lds;
    LAS float* kf = qf + 4096;
    LAS float* vf = kf + 4096;
    LAS float* cp = vf + 8192;
    LAS float* Sm = cp + 128 * 65;
    LAS float* sc = Sm + 64 * 65;
    const float* gates = (const float*)(ws + WS_GATES); const bf16* Q0 = (const bf16*)(ws + WS_Q0); const bf16* K0 = (const bf16*)(ws + WS_K0); const bf16* V0 = (const bf16*)(ws + WS_V0);
    const bf16* OG = (const bf16*)(ws + WS_OG); bf16* HC = (bf16*)(ws + WS_V0);
    const float* cprev = (const float*)(ws + WS_CLOC); const float* nprev = (const float*)(ws + WS_NLOC); const float* mprev = (const float*)(ws + WS_MPREV);
    const float* mh_gain = A->in[5];
    for (int unit = bx; unit < NB_ * ML_H * ML_NC; unit += G) {
        const int bh = unit >> 6, c = unit & 63, b = bh >> 3, h = bh & 7, row0 = b * SEQ + c * ML_L;
        if (tid < 64) {
            const float li = gates[(size_t)(row0 + tid) * 16 + h], lf = gates[(size_t)(row0 + tid) * 16 + 8 + h];
            const float g = wave_incl_scan(lf, lane);
            const float pm = wave_incl_max(li - g, lane);
            const float mintra = g + pm, minter = g + mprev[unit], mc = fmaxf(minter, mintra);
            sc[tid] = g; sc[64 + tid] = li; sc[128 + tid] = mc; sc[192 + tid] = expf(minter - mc); sc[320 + tid] = nprev[(size_t)unit * 64 + tid];
        }
        { const int s = tid >> 3, kc = (tid & 7) * 8;
          const v4u qq = *(const v4u*)(Q0 + (size_t)(row0 + s) * 512 + h * 64 + kc); LAS float* dq = qf + s * 64 + kc;
          dq[0] = bf_lo(qq.x); dq[1] = bf_hi(qq.x); dq[2] = bf_lo(qq.y); dq[3] = bf_hi(qq.y); dq[4] = bf_lo(qq.z); dq[5] = bf_hi(qq.z); dq[6] = bf_lo(qq.w); dq[7] = bf_hi(qq.w);
          const v4u kk = *(const v4u*)(K0 + (size_t)(row0 + s) * 512 + h * 64 + kc); LAS float* d = kf + s * 64 + kc;
          d[0] = bf_lo(kk.x); d[1] = bf_hi(kk.x); d[2] = bf_lo(kk.y); d[3] = bf_hi(kk.y); d[4] = bf_lo(kk.z); d[5] = bf_hi(kk.z); d[6] = bf_lo(kk.w); d[7] = bf_hi(kk.w);
          const int vc = (tid & 7) * 16; const v4u v0 = *(const v4u*)(V0 + (size_t)(row0 + s) * 1024 + h * 128 + vc), v1 = *(const v4u*)(V0 + (size_t)(row0 + s) * 1024 + h * 128 + vc + 8);
          LAS float* e = vf + s * 128 + vc;
          e[0] = bf_lo(v0.x); e[1] = bf_hi(v0.x); e[2] = bf_lo(v0.y); e[3] = bf_hi(v0.y); e[4] = bf_lo(v0.z); e[5] = bf_hi(v0.z); e[6] = bf_lo(v0.w); e[7] = bf_hi(v0.w);
          e[8] = bf_lo(v1.x); e[9] = bf_hi(v1.x); e[10] = bf_lo(v1.y); e[11] = bf_hi(v1.y); e[12] = bf_lo(v1.z); e[13] = bf_hi(v1.z); e[14] = bf_lo(v1.w); e[15] = bf_hi(v1.w);
          const float* cs = cprev + (size_t)unit * 8192;
#pragma unroll
          for (int i = 0; i < 4; ++i) { const int e4 = tid * 4 + i * 2048; const f32x4 cv = *(const f32x4*)(cs + e4); const int v = e4 >> 6, k = e4 & 63; LAS float* dd = cp + v * 65 + k; dd[0] = cv[0]; dd[1] = cv[1]; dd[2] = cv[2]; dd[3] = cv[3]; } }
        __syncthreads();
        { const int j = tid >> 3, sg = (tid & 7) * 8; const float gj = sc[j], mcj = sc[128 + j];
#pragma unroll
          for (int i = 0; i < 8; ++i) { const int s = sg + i; float d = 0.f;
              for (int k = 0; k < 64; ++k) d += qf[j * 64 + k] * kf[s * 64 + k];
              Sm[j * 65 + s] = (s <= j) ? d * expf(gj - sc[s] + sc[64 + s] - mcj) : 0.f; } }
        __syncthreads();
        if (tid < 64) { const int j = tid; float qn = 0.f, rsum = 0.f;
            for (int k = 0; k < 64; ++k) qn += qf[j * 64 + k] * sc[320 + k];
            for (int s = 0; s < 64; ++s) rsum += Sm[j * 65 + s];
            const float dn = sc[192 + j] * qn + rsum; sc[256 + j] = fmaxf(fabsf(dn), expf(-sc[128 + j])); }
        const int j = tid >> 3, vg = (tid & 7) * 16; float acc[16];
        { const float wi = sc[192 + j];
#pragma unroll
          for (int i = 0; i < 16; ++i) acc[i] = 0.f;
          for (int k = 0; k < 64; ++k) { const float q = qf[j * 64 + k];
#pragma unroll
              for (int i = 0; i < 16; ++i) acc[i] += q * cp[(vg + i) * 65 + k]; }
#pragma unroll
          for (int i = 0; i < 16; ++i) acc[i] *= wi;
          for (int s = 0; s < 64; ++s) { const float p = Sm[j * 65 + s];
#pragma unroll
              for (int i = 0; i < 16; ++i) acc[i] += p * vf[s * 128 + vg + i]; } }
        __syncthreads();
        { const float inv = 1.0f / sc[256 + j]; float ss = 0.f;
#pragma unroll
          for (int i = 0; i < 16; ++i) { acc[i] *= inv; ss += acc[i] * acc[i]; }
          ss += shx(ss, 1, lane); ss += shx(ss, 2, lane); ss += shx(ss, 4, lane);
          const float rn = __builtin_amdgcn_rsqf(ss * (1.0f / ML_DV) + EPS);
          const size_t off = (size_t)(row0 + j) * 1024 + h * 128 + vg;
          const v4u o0 = *(const v4u*)(OG + off), o1 = *(const v4u*)(OG + off + 8);
          float og[16] = {bf_lo(o0.x), bf_hi(o0.x), bf_lo(o0.y), bf_hi(o0.y), bf_lo(o0.z), bf_hi(o0.z), bf_lo(o0.w), bf_hi(o0.w), bf_lo(o1.x), bf_hi(o1.x), bf_lo(o1.y), bf_hi(o1.y), bf_lo(o1.z), bf_hi(o1.z), bf_lo(o1.w), bf_hi(o1.w)};
          float r[16];
#pragma unroll
          for (int i = 0; i < 16; ++i) r[i] = acc[i] * rn * mh_gain[vg + i] * sigmoidf_(og[i]);
          v4u w0, w1; w0.x = pk2(r[0], r[1]); w0.y = pk2(r[2], r[3]); w0.z = pk2(r[4], r[5]); w0.w = pk2(r[6], r[7]); w1.x = pk2(r[8], r[9]); w1.y = pk2(r[10], r[11]); w1.z = pk2(r[12], r[13]); w1.w = pk2(r[14], r[15]);
          *(v4u*)(HC + off) = w0; *(v4u*)(HC + off + 8) = w1; }
        __syncthreads();
    }
}

__device__ __forceinline__ void moba_fixup(CArgs* A, LAS unsigned char* lds, int G, const int bx, const int tid) {
    unsigned char* ws = A->ws;
    bf16* Q1 = (bf16*)(ws + WS_Q1); bf16* K1 = (bf16*)(ws + WS_K1); float* kmp = (float*)(ws + WS_KMP);
    const float* rc = (const float*)(ws + WS_ROPE); const float* rsn = rc + SEQ * 8;
    const float* qg = A->in[11]; const float* kg = A->in[9];
    LAS float* ks = (LAS float*)lds;
    for (int unit = bx; unit < M / 128; unit += G) {
        const int r0 = unit * 128;
        for (int it = tid; it < 128 * 20; it += NTHREADS) {
            const int rl = it / 20, hh = it % 20, row = r0 + rl, pos = row & (SEQ - 1);
            bf16* p = (hh < 16) ? Q1 + (size_t)row * 1024 + hh * 64 : K1 + (size_t)row * 256 + (hh - 16) * 64;
            const float* gn = (hh < 16) ? qg : kg;
            float v[64]; float ss = 0.f;
#pragma unroll
            for (int i = 0; i < 8; ++i) { const v4u w = *(const v4u*)(p + 8 * i); v[8 * i] = bf_lo(w.x); v[8 * i + 1] = bf_hi(w.x); v[8 * i + 2] = bf_lo(w.y); v[8 * i + 3] = bf_hi(w.y); v[8 * i + 4] = bf_lo(w.z); v[8 * i + 5] = bf_hi(w.z); v[8 * i + 6] = bf_lo(w.w); v[8 * i + 7] = bf_hi(w.w); }
#pragma unroll
            for (int i = 0; i < 64; ++i) ss += v[i] * v[i];
            const float rn = __builtin_amdgcn_rsqf(ss * (1.0f / 64.0f) + EPS);
#pragma unroll
            for (int i = 0; i < 64; ++i) v[i] = v[i] * rn * gn[i];
            if (hh < 16) {
#pragma unroll
                for (int i = 0; i < 64; ++i) v[i] *= 0.125f * 1.4426950408889634f; }
#pragma unroll
            for (int i = 0; i < 8; ++i) { const float cs = rc[pos * 8 + i], sn = rsn[pos * 8 + i]; const float x1 = v[i], x2 = v[8 + i]; v[i] = x1 * cs - x2 * sn; v[8 + i] = x2 * cs + x1 * sn; }
#pragma unroll
            for (int i = 0; i < 8; ++i) { v4u w; w.x = pk2(v[8 * i], v[8 * i + 1]); w.y = pk2(v[8 * i + 2], v[8 * i + 3]); w.z = pk2(v[8 * i + 4], v[8 * i + 5]); w.w = pk2(v[8 * i + 6], v[8 * i + 7]); *(v4u*)(p + 8 * i) = w; }
            if (hh >= 16) { LAS float* kd = ks + (rl * 4 + (hh - 16)) * 64;
#pragma unroll
                for (int i = 0; i < 64; ++i) kd[i] = v[i]; }
        }
        __syncthreads();
        if (tid < 256) { float s = 0.f; for (int r = 0; r < 128; ++r) s += ks[r * 256 + tid]; kmp[(size_t)unit * 256 + tid] = s; }
        __syncthreads();
    }
}
__device__ __forceinline__ void moba_attn(CArgs* A, LAS unsigned char* lds, int G, const int bx, const int tid) {
    unsigned char* ws = A->ws; const int lane = tid & 63, wave = tid >> 6;
    const bf16* Q1 = (const bf16*)(ws + WS_Q1); const bf16* K1 = (const bf16*)(ws + WS_K1); const bf16* V1 = (const bf16*)(ws + WS_V1); const float* kmp = (const float*)(ws + WS_KMP);
    bf16* AO = (bf16*)(ws + WS_AO);
    LAS float* qs = (LAS float*)lds + wave * 1088; LAS float* ps = qs + 64;
    const int nitems = M * MB_H / NWAVES;
    for (int it = bx; it < nitems; it += G) {
        const int item = it * NWAVES + wave, row = item >> 4, h = item & 15, kvh = h >> 2, b = row >> 12, t = row & (SEQ - 1), qb = t >> 8;
        { const bf16 qv = Q1[(size_t)row * 1024 + h * 64 + lane]; qs[lane] = __builtin_bit_cast(float, (unsigned)qv << 16); }
        asm volatile("s_waitcnt lgkmcnt(0)" ::: "memory");
        float q[64];
#pragma unroll
        for (int i = 0; i < 16; ++i) { const f32x4 t4 = *(const LAS f32x4*)(qs + 4 * i); q[4 * i] = t4[0]; q[4 * i + 1] = t4[1]; q[4 * i + 2] = t4[2]; q[4 * i + 3] = t4[3]; }
        float gv = -INFINITY;
        if (lane < qb) { const float* k0 = kmp + (size_t)((b * 32 + 2 * lane) * 4 + kvh) * 64; const float* k1 = k0 + 256; float s = 0.f;
#pragma unroll
            for (int i = 0; i < 16; ++i) { const f32x4 a = *(const f32x4*)(k0 + 4 * i) + *(const f32x4*)(k1 + 4 * i); s += (q[4 * i] * a[0] + q[4 * i + 1] * a[1]) + (q[4 * i + 2] * a[2] + q[4 * i + 3] * a[3]); }
            gv = s; }
        int sel0 = 0, sel1 = 0, sel2 = 0;
#pragma unroll
        for (int r = 0; r < 3; ++r) { float mv = gv; int mi = lane;
#pragma unroll
            for (int o = 32; o >= 1; o >>= 1) { const float ov = shx(mv, o, lane); const int oi = shxi(mi, o, lane); if (ov > mv || (ov == mv && oi < mi)) { mv = ov; mi = oi; } }
            const int sr = __builtin_amdgcn_readfirstlane(mi); if (lane == sr) gv = -INFINITY;
            if (r == 0) sel0 = sr; else if (r == 1) sel1 = sr; else sel2 = sr; }
        const int nvalid = qb < 3 ? qb : 3;
        float mx = -INFINITY;
#pragma unroll 1
        for (int jj = 0; jj < 16; ++jj) {
            const int j = jj >> 2, i = jj & 3; const bool active = (j == 3) || (j < nvalid); const int nblk = j == 0 ? sel0 : (j == 1 ? sel1 : (j == 2 ? sel2 : qb));
            float sv = -INFINITY;
            if (active) { const int pos = nblk * 256 + i * 64 + lane; const bf16* kp = K1 + (size_t)(b * SEQ + pos) * 256 + kvh * 64; float d = 0.f;
#pragma unroll
                for (int e = 0; e < 8; ++e) { const v4u w = *(const v4u*)(kp + 8 * e);
                    d += q[8 * e] * bf_lo(w.x) + q[8 * e + 1] * bf_hi(w.x) + q[8 * e + 2] * bf_lo(w.y) + q[8 * e + 3] * bf_hi(w.y) + q[8 * e + 4] * bf_lo(w.z) + q[8 * e + 5] * bf_hi(w.z) + q[8 * e + 6] * bf_lo(w.w) + q[8 * e + 7] * bf_hi(w.w); }
                sv = d * 0.6931471805599453f; if (j == 3 && pos > t) sv = -INFINITY; }
            ps[jj * 64 + lane] = sv; mx = fmaxf(mx, sv);
        }
        mx = wave_max(mx, lane);
        float l = 0.f;
        float o[64];
#pragma unroll
        for (int i = 0; i < 64; ++i) o[i] = 0.f;
#pragma unroll 1
        for (int jj = 0; jj < 16; ++jj) {
            const int j = jj >> 2, i = jj & 3; const bool active = (j == 3) || (j < nvalid); const int nblk = j == 0 ? sel0 : (j == 1 ? sel1 : (j == 2 ? sel2 : qb));
            if (active) { const int pos = nblk * 256 + i * 64 + lane; const bf16* vp = V1 + (size_t)(b * SEQ + pos) * 256 + kvh * 64; const float p = __expf(ps[jj * 64 + lane] - mx); l += p;
#pragma unroll
                for (int e = 0; e < 8; ++e) { const v4u w = *(const v4u*)(vp + 8 * e);
                    o[8 * e] += p * bf_lo(w.x); o[8 * e + 1] += p * bf_hi(w.x); o[8 * e + 2] += p * bf_lo(w.y); o[8 * e + 3] += p * bf_hi(w.y); o[8 * e + 4] += p * bf_lo(w.z); o[8 * e + 5] += p * bf_hi(w.z); o[8 * e + 6] += p * bf_lo(w.w); o[8 * e + 7] += p * bf_hi(w.w); } }
        }
        l = wave_sum(l, lane);
#define RED_STEP(OFF, N) _Pragma("unroll") for (int i = 0; i < (N) / 2; ++i) { const bool up = (lane & (OFF)) != 0; const float send = up ? o[i] : o[i + (N) / 2]; const float keep = up ? o[i + (N) / 2] : o[i]; o[i] = keep + shx(send, OFF, lane); }
        RED_STEP(32, 64) RED_STEP(16, 32) RED_STEP(8, 16) RED_STEP(4, 8) RED_STEP(2, 4) RED_STEP(1, 2)
#undef RED_STEP
        AO[(size_t)row * 1024 + h * 64 + lane] = (bf16)f2bf(o[0] / l);
        asm volatile("s_waitcnt lgkmcnt(0)" ::: "memory");
    }
}

namespace mattn {
using bf16=__hip_bfloat16;
using bf16x8=__attribute__((ext_vector_type(8)))short;
using s16x4=__attribute__((ext_vector_type(4)))short;
using f32x16=__attribute__((ext_vector_type(16)))float;
using u32x4=__attribute__((ext_vector_type(4)))unsigned;
constexpr int BATCH=8,NHEAD=16,SEQ=4096,D=64,DM=NHEAD*D,KP=256;
constexpr int NW=8,QBLK=32,QB=QBLK*NW,KVBLK=64,NQB=SEQ/QB;
constexpr int ATTN_PITCH=DM, ATTN_UNIT_ROWS=QB;
__device__ __forceinline__ int crow(int r,int hi){return (r&3)+8*(r>>2)+4*hi;}
#define SBAR() __builtin_amdgcn_sched_barrier(0)
__device__ __forceinline__ void cmask(f32x16&p0,f32x16&p1,int jb,int qrel,int hi){
  const float NEG=-INFINITY; int kb=64*jb+4*hi;
  #pragma unroll
  for(int r=0;r<16;++r){int kv=kb+(r&3)+8*(r>>2); if(kv>qrel)p0[r]=NEG; if(kv+32>qrel)p1[r]=NEG;}
}

constexpr int NSLOT=3, SLOTB=8192;
constexpr int LDS_K=0, LDS_V=NSLOT*SLOTB, LDS_WS=2*NSLOT*SLOTB, LDS_OST=LDS_WS+NW*64*4, LDS_KM=LDS_OST+NW*4096, LDS_BYTES=LDS_KM+4096;
constexpr float C2=0.125f*1.4426950408889634f;
__device__ __forceinline__ void glds16(const void*sbase,unsigned voff,unsigned lds_dst){unsigned keep;
  asm volatile("s_nop 4\n\ts_mov_b32 %0, m0\n\ts_mov_b32 m0, %3\n\ts_nop 0\n\tglobal_load_lds_dwordx4 %1, %2\n\ts_mov_b32 m0, %0":"=&s"(keep):"v"(voff),"s"(sbase),"s"(lds_dst):"memory");}
__device__ __forceinline__ float max3f(float a,float b,float c){float r;asm("v_max3_f32 %0, %1, %2, %3":"=v"(r):"v"(a),"v"(b),"v"(c));return r;}
__device__ __forceinline__ float max2f(float a,float b){float r;asm("v_max_f32_e32 %0, %1, %2":"=v"(r):"v"(a),"v"(b));return r;}
__device__ __forceinline__ float fadd_s(float a,float b){float r;asm("v_add_f32_e32 %0, %1, %2":"=v"(r):"v"(a),"v"(b));return r;}
__device__ __forceinline__ float fsub_s(float a,float b){float r;asm("v_sub_f32_e32 %0, %1, %2":"=v"(r):"v"(a),"v"(b));return r;}
typedef float f32x2_t __attribute__((ext_vector_type(2))); typedef __bf16 bf16x2_t __attribute__((ext_vector_type(2)));
__device__ __forceinline__ unsigned cvtpk_s(float lo,float hi){f32x2_t v={lo,hi};bf16x2_t b=__builtin_convertvector(v,bf16x2_t);return __builtin_bit_cast(unsigned,b);}
#define WAIT_BAR(N) asm volatile("s_waitcnt vmcnt(" #N ") lgkmcnt(0)\n\ts_barrier":::"memory")

__device__ __forceinline__ void qkt(f32x16&p0,f32x16&p1,const char*Kslot,const bf16x8*qr,const f32x16&negm,int r32,int hi){
  const char*kb=Kslot+hi*1024+r32*16;
  #pragma unroll
  for(int d0=0;d0<4;++d0){
    const bf16x8 b0=*reinterpret_cast<const bf16x8*>(kb+d0*2048);
    const bf16x8 b1=*reinterpret_cast<const bf16x8*>(kb+d0*2048+512);
    if(d0==0){p0=__builtin_amdgcn_mfma_f32_32x32x16_bf16(b0,qr[0],negm,0,0,0);p1=__builtin_amdgcn_mfma_f32_32x32x16_bf16(b1,qr[0],negm,0,0,0);}
    else{p0=__builtin_amdgcn_mfma_f32_32x32x16_bf16(b0,qr[d0],p0,0,0,0);p1=__builtin_amdgcn_mfma_f32_32x32x16_bf16(b1,qr[d0],p1,0,0,0);}}
}
typedef __attribute__((address_space(3))) const char* lds_cptr;
typedef short v4i16_t __attribute__((ext_vector_type(4)));
__device__ __forceinline__ void kload8(bf16x8*kf,lds_cptr kp){
  kf[0]=*(const __attribute__((address_space(3))) bf16x8*)(kp);      kf[1]=*(const __attribute__((address_space(3))) bf16x8*)(kp+512);
  kf[2]=*(const __attribute__((address_space(3))) bf16x8*)(kp+2048); kf[3]=*(const __attribute__((address_space(3))) bf16x8*)(kp+2560);
  kf[4]=*(const __attribute__((address_space(3))) bf16x8*)(kp+4096); kf[5]=*(const __attribute__((address_space(3))) bf16x8*)(kp+4608);
  kf[6]=*(const __attribute__((address_space(3))) bf16x8*)(kp+6144); kf[7]=*(const __attribute__((address_space(3))) bf16x8*)(kp+6656);
}
__device__ __forceinline__ void kload2(bf16x8*kf,lds_cptr kp,int j){ kf[2*j]=*(const __attribute__((address_space(3))) bf16x8*)(kp+j*2048); kf[2*j+1]=*(const __attribute__((address_space(3))) bf16x8*)(kp+j*2048+512); }
__device__ __forceinline__ s16x4 vtr(lds_cptr p){ return __builtin_bit_cast(s16x4,__builtin_amdgcn_ds_read_tr16_b64_v4i16((__attribute__((address_space(3))) v4i16_t*)p)); }
__device__ __forceinline__ float rowmax(const f32x16&p0,const f32x16&p1){
  float a=max3f(p0[0],p0[1],p1[0]),b=max3f(p0[2],p0[3],p1[1]);a=max3f(a,p1[2],p1[3]);
  #pragma unroll
  for(int r=4;r<16;r+=4){a=max3f(a,p0[r],p0[r+1]);b=max3f(b,p0[r+2],p0[r+3]);a=max3f(a,p1[r],p1[r+1]);b=max3f(b,p1[r+2],p1[r+3]);}
  const float m=max2f(a,b);
  auto rr=__builtin_amdgcn_permlane32_swap(__float_as_uint(m),__float_as_uint(m),false,false);
  return max2f(__uint_as_float(rr[0]),__uint_as_float(rr[1]));
}
__device__ __forceinline__ void pv(f32x16*o,int vb,bf16x8 pa0,bf16x8 pa1,bf16x8 pa2,bf16x8 pa3){
  #pragma unroll
  for(int d0=0;d0<2;++d0){s16x4 lo[4],hi[4];
    #pragma unroll
    for(int ks=0;ks<4;++ks){
      asm volatile("ds_read_b64_tr_b16 %0,%1 offset:%c2":"=&v"(lo[ks]):"v"(vb),"i"(d0*4096+ks*1024):"memory");
      asm volatile("ds_read_b64_tr_b16 %0,%1 offset:%c2":"=&v"(hi[ks]):"v"(vb),"i"(d0*4096+ks*1024+512):"memory");}
    asm volatile("s_waitcnt lgkmcnt(0)":::"memory");SBAR();
    #define PK(k) (bf16x8){lo[k][0],lo[k][1],lo[k][2],lo[k][3],hi[k][0],hi[k][1],hi[k][2],hi[k][3]}
    o[d0]=__builtin_amdgcn_mfma_f32_32x32x16_bf16(pa0,PK(0),o[d0],0,0,0);
    o[d0]=__builtin_amdgcn_mfma_f32_32x32x16_bf16(pa1,PK(1),o[d0],0,0,0);
    o[d0]=__builtin_amdgcn_mfma_f32_32x32x16_bf16(pa2,PK(2),o[d0],0,0,0);
    o[d0]=__builtin_amdgcn_mfma_f32_32x32x16_bf16(pa3,PK(3),o[d0],0,0,0);
    #undef PK
  }
}

#ifndef ATTN_STORE16
#define ATTN_STORE16(p,v) (*(u32x4*)(p)=(v))
#endif
__device__ __forceinline__ void attn_unit(int b,int h,int qb,const bf16*Q,const bf16*__restrict__ K,const bf16*__restrict__ V,bf16*O,char*shm,const float*kmsum,const float mref,const int tid){
  const int lane=tid&63,r32=lane&31,hi=lane>>5; const int wid=__builtin_amdgcn_readfirstlane(tid>>6);
  const long rowbase=(long)b*SEQ; const int q0=qb*QB;
  const bf16*Qw=Q+(rowbase+q0+wid*QBLK)*DM+h*D;
  const bf16*Kh=K+rowbase*KP+(h>>2)*D,*Vh=V+rowbase*KP+(h>>2)*D;
  const lds_cptr shm3=(lds_cptr)shm;
  const unsigned lds0=(unsigned)(uintptr_t)shm;
  float*wsf=(float*)(shm+LDS_WS)+wid*64;
  const unsigned kvoff=(unsigned)(lane*KP+wid*8)*2u;
  const unsigned vvoff=(unsigned)((16*(wid&3)+(lane>>2))*KP+(wid>>2)*32+(lane&3)*8)*2u;
  const unsigned kdst=lds0+LDS_K+wid*1024, vdst=lds0+LDS_V+wid*1024;
  #define DMA_K(t,slot) glds16(Kh+(long)(t)*KVBLK*KP,kvoff,(unsigned)__builtin_amdgcn_readfirstlane(kdst+(slot)))
  #define DMA_V(t,slot) glds16(Vh+(long)(t)*KVBLK*KP,vvoff,(unsigned)__builtin_amdgcn_readfirstlane(vdst+(slot)))
  const int vb0=(int)(lds0+LDS_V)+((lane>>4)&1)*32+(lane&3)*8+(4*hi+((lane&15)>>2))*64;
  const char*Kbase=shm+LDS_K; bf16x8 kf[8];
  const lds_cptr kp0=shm3+LDS_K+hi*1024+r32*16; const lds_cptr vp0=shm3+LDS_V+((lane>>4)&1)*32+(lane&3)*8+(4*hi+((lane&15)>>2))*64;
  const int NT=(q0+QB)/KVBLK;
  typedef __attribute__((address_space(3))) float ldsf;
  { ldsf*km=(ldsf*)(shm3+LDS_KM); const float*ks0=kmsum+((size_t)b*32*4+(h>>2))*64;
    #pragma unroll
    for(int i=0;i<2;++i){const int idx=tid+512*i,n=idx>>6,d=idx&63; km[idx]=ks0[(size_t)(2*n)*256+d]+ks0[(size_t)(2*n+1)*256+d];}
    asm volatile("s_waitcnt vmcnt(0) lgkmcnt(0)\n\ts_barrier":::"memory"); }
  DMA_K(0,0);DMA_V(0,0);DMA_K(1,SLOTB);
  bf16x8 qr[4];
  #pragma unroll
  for(int d0=0;d0<4;++d0)qr[d0]=*reinterpret_cast<const bf16x8*>(&Qw[(long)r32*DM+d0*16+hi*8]);
  unsigned selm=1u<<qb;
  if(qb>0){
    float qf[32];
    #pragma unroll
    for(int d0=0;d0<4;++d0)
      #pragma unroll
      for(int j=0;j<8;++j)qf[8*d0+j]=__uint_as_float(((unsigned)(unsigned short)qr[d0][j])<<16);
    float g[15];
    const ldsf*kmr=(const ldsf*)(shm3+LDS_KM)+8*hi;
    #pragma unroll
    for(int n=0;n<15;++n){ g[n]=-INFINITY;
      if(n<qb){ float a=0.f;
        #pragma unroll
        for(int d0=0;d0<4;++d0)
          #pragma unroll
          for(int j=0;j<8;++j)a+=qf[8*d0+j]*kmr[n*64+16*d0+j];
        auto rr=__builtin_amdgcn_permlane32_swap(__float_as_uint(a),__float_as_uint(a),false,false);
        g[n]=__uint_as_float(rr[0])+__uint_as_float(rr[1]); } }
    #pragma unroll
    for(int r=0;r<3;++r){ float best=-INFINITY; int bi=0;
      #pragma unroll
      for(int n=0;n<15;++n)if(g[n]>best){best=g[n];bi=n;}
      if(best>-INFINITY)selm|=1u<<bi;
      #pragma unroll
      for(int n=0;n<15;++n)g[n]=(n==bi)?-INFINITY:g[n]; }
  }
  float l_reg=0.f;f32x16 o[2];o[0]=f32x16{};o[1]=f32x16{};f32x16 negm;
  #define SETNEG(t) do{ const float v_=((selm>>((t)>>2))&1u)?-mref:-INFINITY; _Pragma("unroll") for(int r=0;r<16;++r)negm[r]=v_; asm volatile("":"+v"(negm)); }while(0)
  SETNEG(0);
  const int qrel=wid*QBLK+r32;
  #define CMASK(P0,P1,t) do{int jb_=(t)-(NT-4); if(jb_>=0)cmask(P0,P1,jb_,qrel,hi);}while(0)
  #define START(P0,P1) do{ _Pragma("unroll") for(int r=0;r<16;++r)P0[r]=__builtin_amdgcn_exp2f(P0[r]); }while(0)
  #define RESC() do{}while(0)
  f32x16 pA0,pA1,pB0,pB1;
  int sl_prev=0,sl_cur=0,sl_next=SLOTB;
  #define ROT() do{sl_prev=sl_cur;sl_cur=sl_next;sl_next=(sl_next==(NSLOT-1)*SLOTB)?0:sl_next+SLOTB;}while(0)
  DMA_K(2,2*SLOTB);
  WAIT_BAR(3);
  qkt(pA0,pA1,Kbase,qr,negm,r32,hi);asm volatile("s_nop 15\n\ts_nop 7":"+v"(pA0),"+v"(pA1));CMASK(pA0,pA1,0);
  START(pA0,pA1);
  _Pragma("unroll") for(int r=0;r<16;++r)pA1[r]=__builtin_amdgcn_exp2f(pA1[r]);
  WAIT_BAR(0);
  DMA_K(3,0);DMA_V(1,SLOTB);
  ROT();
  kload8(kf,kp0+sl_cur);
  WAIT_BAR(2);
  s16x4 vlo[8],vhi[8]; u32x4 pw0,pw1,pw2,pw3;
  #define PKW(P,B) cvtpk_s(P[B],P[B+1])
  #define PAF(k) __builtin_bit_cast(bf16x8,pw##k)
  #define VFR(i) (bf16x8){vlo[i][0],vlo[i][1],vlo[i][2],vlo[i][3],vhi[i][0],vhi[i][1],vhi[i][2],vhi[i][3]}
  #define PIN(x) asm volatile("":"+v"(x))
  #define MX3(a,b,c) __builtin_fmaxf(__builtin_fmaxf((a),(b)),(c))
  #define GAPA(MF,A0,A1,A2,A3,W0,W1,PW) do{ MF; sacc+=A0; sacc+=A1; sacc+=A2; sacc+=A3; PIN(sacc); W0; W1; PIN(PW); SBAR(); }while(0)
  #define EX(v) __builtin_amdgcn_exp2f(v)
  #define GAPB(MF,X,B) do{ MF; X[B]=EX(X[B]); X[B+1]=EX(X[B+1]); X[B+2]=EX(X[B+2]); X[B+3]=EX(X[B+3]); PIN(X); SBAR(); }while(0)
  #define VRD(i) do{ vlo[i]=vtr(vp_+(((i)>>2)*4096+((i)&3)*1024)); vhi[i]=vtr(vp_+(((i)>>2)*4096+((i)&3)*1024+512)); }while(0)
  #define KRD(G,j) do{ if(G){ kload2(kf,kp0+sl_next,j); SBAR(); } }while(0)
  #define STEP(C0,C1,P0,P1,t,GK,GV,GL) do{ if((((t))&3)==0){SETNEG(t);} SBAR(); \
    const lds_cptr vp_=vp0+sl_prev; \
    VRD(0); SBAR(); float sacc=(P0[0]+P0[1]); \
    GAPA(C0=__builtin_amdgcn_mfma_f32_32x32x16_bf16(kf[0],qr[0],negm,0,0,0), P0[2],P0[3],P0[4],P0[5],     pw0[0]=PKW(P0,0), pw0[1]=PKW(P0,2), pw0); \
    VRD(4); SBAR(); GAPA(C1=__builtin_amdgcn_mfma_f32_32x32x16_bf16(kf[1],qr[0],negm,0,0,0), P0[6],P0[7],P0[8],P0[9],     pw0[2]=PKW(P0,4), pw0[3]=PKW(P0,6), pw0); \
    VRD(1); SBAR(); GAPA(C0=__builtin_amdgcn_mfma_f32_32x32x16_bf16(kf[2],qr[1],C0,0,0,0),   P0[10],P0[11],P0[12],P0[13], pw1[0]=PKW(P0,8), pw1[1]=PKW(P0,10), pw1); \
    VRD(5); SBAR(); GAPA(C1=__builtin_amdgcn_mfma_f32_32x32x16_bf16(kf[3],qr[1],C1,0,0,0),   P0[14],P0[15],P1[0],P1[1],   pw1[2]=PKW(P0,12),pw1[3]=PKW(P0,14), pw1); \
    VRD(2); SBAR(); GAPA(C0=__builtin_amdgcn_mfma_f32_32x32x16_bf16(kf[4],qr[2],C0,0,0,0),   P1[2],P1[3],P1[4],P1[5],     pw2[0]=PKW(P1,0), pw2[1]=PKW(P1,2), pw2); \
    VRD(6); SBAR(); GAPA(C1=__builtin_amdgcn_mfma_f32_32x32x16_bf16(kf[5],qr[2],C1,0,0,0),   P1[6],P1[7],P1[8],P1[9],     pw2[2]=PKW(P1,4), pw2[3]=PKW(P1,6), pw2); \
    VRD(3); SBAR(); GAPA(C0=__builtin_amdgcn_mfma_f32_32x32x16_bf16(kf[6],qr[3],C0,0,0,0),   P1[10],P1[11],P1[12],P1[13], pw3[0]=PKW(P1,8), pw3[1]=PKW(P1,10), pw3); \
    VRD(7); SBAR(); GAPA(C1=__builtin_amdgcn_mfma_f32_32x32x16_bf16(kf[7],qr[3],C1,0,0,0),   P1[14],P1[15],0.f,0.f,       pw3[2]=PKW(P1,12),pw3[3]=PKW(P1,14), pw3); \
    l_reg+=sacc; \
    if(GK){DMA_K((t)+3,sl_cur);} if(GV){DMA_V((t)+1,sl_next);} \
    CMASK(C0,C1,t); \
    SBAR(); \
    GAPB(o[0]=__builtin_amdgcn_mfma_f32_32x32x16_bf16(PAF(0),VFR(0),o[0],0,0,0), C0,0); \
    GAPB(o[1]=__builtin_amdgcn_mfma_f32_32x32x16_bf16(PAF(0),VFR(4),o[1],0,0,0), C0,4); \
    KRD(GL,0); GAPB(o[0]=__builtin_amdgcn_mfma_f32_32x32x16_bf16(PAF(1),VFR(1),o[0],0,0,0), C0,8); \
    KRD(GL,1); GAPB(o[1]=__builtin_amdgcn_mfma_f32_32x32x16_bf16(PAF(1),VFR(5),o[1],0,0,0), C0,12); \
    KRD(GL,2); GAPB(o[0]=__builtin_amdgcn_mfma_f32_32x32x16_bf16(PAF(2),VFR(2),o[0],0,0,0), C1,0); \
    KRD(GL,3); GAPB(o[1]=__builtin_amdgcn_mfma_f32_32x32x16_bf16(PAF(2),VFR(6),o[1],0,0,0), C1,4); \
    GAPB(o[0]=__builtin_amdgcn_mfma_f32_32x32x16_bf16(PAF(3),VFR(3),o[0],0,0,0), C1,8); \
    GAPB(o[1]=__builtin_amdgcn_mfma_f32_32x32x16_bf16(PAF(3),VFR(7),o[1],0,0,0), C1,12); \
    }while(0)
  int t=1;
  #undef CMASK
  #define CMASK(P0,P1,t) do{}while(0)
  for(;t+5<NT;t+=2){
    STEP(pB0,pB1,pA0,pA1,t,true,true,true);     WAIT_BAR(2); RESC(); ROT();
    STEP(pA0,pA1,pB0,pB1,t+1,true,true,true);   WAIT_BAR(2); RESC(); ROT();
  }
  #undef CMASK
  #define CMASK(P0,P1,t) do{int jb_=(t)-(NT-4); if(jb_>=0)cmask(P0,P1,jb_,qrel,hi);}while(0)
  #define ENDW(tt) do{ if((tt)+3<NT){WAIT_BAR(2);} else if((tt)+2<NT){WAIT_BAR(1);} else {WAIT_BAR(0);} }while(0)
  for(;t+1<NT;t+=2){
    STEP(pB0,pB1,pA0,pA1,t,(t+3<NT),(t+1<NT),(t+1<NT));       ENDW(t);   RESC(); ROT();
    STEP(pA0,pA1,pB0,pB1,t+1,(t+4<NT),(t+2<NT),(t+2<NT));     ENDW(t+1); RESC(); ROT();
  }
  STEP(pB0,pB1,pA0,pA1,NT-1,false,false,false); RESC();
  { float sacc=pB0[0]+pB0[1]; _Pragma("unroll") for(int r=2;r<16;++r)sacc+=pB0[r]; _Pragma("unroll") for(int r=0;r<16;++r)sacc+=pB1[r]; l_reg+=sacc;
    pw0=(u32x4){PKW(pB0,0),PKW(pB0,2),PKW(pB0,4),PKW(pB0,6)};pw1=(u32x4){PKW(pB0,8),PKW(pB0,10),PKW(pB0,12),PKW(pB0,14)};pw2=(u32x4){PKW(pB1,0),PKW(pB1,2),PKW(pB1,4),PKW(pB1,6)};pw3=(u32x4){PKW(pB1,8),PKW(pB1,10),PKW(pB1,12),PKW(pB1,14)};
    SBAR(); pv(o,vb0+sl_cur,PAF(0),PAF(1),PAF(2),PAF(3)); }
  #undef PKW
  #undef PAF
  #undef VFR
  #undef PIN
  #undef MX3
  #undef GAPA
  #undef GAPB
  #undef EX
  #undef VRD
  #undef KRD
  #undef STEP
  #undef ENDW
  {auto rr=__builtin_amdgcn_permlane32_swap(__float_as_uint(l_reg),__float_as_uint(l_reg),false,false);l_reg=__uint_as_float(rr[0])+__uint_as_float(rr[1]);}
  if(hi==0)wsf[32+r32]=l_reg;asm volatile("s_waitcnt lgkmcnt(0)":::"memory");
  float rli[16];
  #pragma unroll
  for(int r=0;r<16;++r)rli[r]=__builtin_amdgcn_rcpf(wsf[32+crow(r,hi)]);
  bf16*Ow=O+(rowbase+q0+wid*QBLK)*DM+h*D;
  { bf16*stg=(bf16*)(shm+LDS_OST)+wid*2048;
    #pragma unroll
    for(int r=0;r<16;++r){const int orow=crow(r,hi);
      #pragma unroll
      for(int d0=0;d0<2;++d0)stg[orow*64+d0*32+r32]=__float2bfloat16(o[d0][r]*rli[r]);}
    asm volatile("s_waitcnt lgkmcnt(0)":::"memory");
    #pragma unroll
    for(int i=0;i<4;++i){const int row=i*8+(lane>>3),ch=lane&7; const u32x4 v=*(const u32x4*)(stg+row*64+ch*8); ATTN_STORE16(Ow+(long)row*DM+ch*8,v);} }
  asm volatile("s_waitcnt lgkmcnt(0)\n\ts_barrier":::"memory");
  #undef DMA_K
  #undef DMA_V
  #undef CMASK
  #undef START
  #undef SETNEG
  #undef RESC
  #undef ROT
}
constexpr int ATTN_LDS_BYTES=LDS_BYTES;
struct AttnTensors { const bf16* Q; const bf16* K; const bf16* V; bf16* O; const float* kmsum; };
struct AttnUnit { int bh; int qb; };
struct StaticOrder {
  int vcu, G;
  __device__ __forceinline__ StaticOrder(int grid,int vc):vcu(vc),G(grid){}
  __device__ __forceinline__ bool next(int i,AttnUnit&u)const{ const int uu=vcu+i*G; if(uu>=2048)return false; const int v=uu&255,ii=uu>>8,hf=v&1,j=ii>>1; u.bh=v>>1; u.qb=(ii&1)?15-2*j-hf:2*j+hf; return true; }
};
__device__ __forceinline__ void attn_phase(char*lds,const AttnTensors&T,const StaticOrder&S,const float mref,const int tid){
  AttnUnit u;
  for(int i=0;S.next(i,u);++i){ attn_unit(u.bh/NHEAD,u.bh%NHEAD,u.qb,T.Q,T.K,T.V,T.O,lds,T.kmsum,mref,tid); }
}
#undef SBAR
#undef WAIT_BAR
}

constexpr int N_PHASES = 18;
#define PHASE_TID() unsigned ones_ = ones; asm volatile("" : "+s"(ones_)); const int tid = (wave_s << 6) | (int)__builtin_amdgcn_mbcnt_hi(ones_, __builtin_amdgcn_mbcnt_lo(ones_, 0u));
__device__ __forceinline__ void run_phase(const int ph, CArgs* ap, LAS unsigned char* lds, const int G, const int bx, const int wave_s, const unsigned ones) {
    const int vcu = (G % 8 == 0) ? (bx % 8) * (G / 8) + bx / 8 : bx;
    CArgs* A = ap;
    unsigned char* ws = A->ws;
    const int l = ph >= 10 ? 1 : 0;
    bf16* HB0 = (bf16*)(ws + WS_HB); bf16* HB1 = (bf16*)(ws + WS_HB2); float* SSQ0 = (float*)(ws + WS_SSQ); float* SSQ1 = SSQ0 + (size_t)M * 16;
    bf16* HBl = l ? HB1 : HB0; bf16* HBo = l ? HB0 : HB1; float* SSQl = l ? SSQ1 : SSQ0; float* SSQo = l ? SSQ0 : SSQ1;
    float* OUT = A->out;
    switch (ph) {
    case 0: { PHASE_TID() p0_prologue(A, lds, G, vcu, wave_s, tid & 63); } break;
    case 1: { PHASE_TID() pg8::Gemm g{HB0, (const bf16*)(ws + WS_WIN), M, ML_INP, D}; pg8::StaticOrder S; S.init(M, ML_INP, G, bx);
        EpiMl E{ws, (float*)(ws + WS_GATES), SSQ0, A->in[4]};
        pg8::gemm_phase<EpiMl, pg8::StaticOrder, true, true>(lds, g, S, E, tid); } break;
    case 2: { PHASE_TID() mlstm_a(A, lds, G, bx, tid); } break;
    case 3: { PHASE_TID() mlstm_scan(A, G, bx, tid); } break;
    case 4: { PHASE_TID() mlstm_c(A, lds, G, bx, tid); } break;
    case 5: { PHASE_TID() pg8::Gemm g{(const bf16*)(ws + WS_V0), (const bf16*)(ws + WS_WOUT), M, D, D}; pg8::StaticOrder S; S.init(M, D, G, bx);
        EpiRes E{A->in[0], OUT, HB0, SSQ0};
        pg8::gemm_phase<EpiRes, pg8::StaticOrder, true, true>(lds, g, S, E, tid); } break;
    case 10: { PHASE_TID() pg8::Gemm g{HB1, (const bf16*)(ws + WS_WQKV1), M, 1536, D}; pg8::StaticOrder S; S.init(M, 1536, G, bx);
        EpiQkv1 E{ws, SSQ1};
        pg8::gemm_phase<EpiQkv1, pg8::StaticOrder, true, true>(lds, g, S, E, tid); } break;
    case 11: { PHASE_TID() moba_fixup(A, lds, G, bx, tid); } break;
    case 12: { PHASE_TID()
#if defined(MOBA_NAIVE)
        moba_attn(A, lds, G, bx, tid);
#else
        const mattn::AttnTensors AT{(const mattn::bf16*)(ws + WS_Q1), (const mattn::bf16*)(ws + WS_K1), (const mattn::bf16*)(ws + WS_V1), (mattn::bf16*)(ws + WS_AO), (const float*)(ws + WS_KMP)};
        const mattn::StaticOrder S(G, vcu);
        float mref; { const int lane = tid & 63; const float gq = wave_max(fabsf(A->in[11][lane]), lane), gk = wave_max(fabsf(A->in[9][lane]), lane);
            mref = __builtin_bit_cast(float, __builtin_amdgcn_readfirstlane(__builtin_bit_cast(int, 64.0f * 0.125f * 1.4426950408889634f * gq * gk))); }
        mattn::attn_phase((char*)lds, AT, S, mref, tid);
#endif
        } break;
    case 13: case 7: case 15: {
        PHASE_TID() const bool dn = ph != 13;
        pg8::Gemm g{(const bf16*)(ws + (dn ? WS_ACT : WS_AO)), (const bf16*)(ws + (dn ? WS_WDN + l * 6 * MiB : WS_WO1)), M, D, dn ? FF : D}; pg8::StaticOrder S; S.init(M, D, G, bx);
        EpiRes E{OUT, OUT, HBl, SSQl};
        pg8::gemm_phase<EpiRes, pg8::StaticOrder, true, true>(lds, g, S, E, tid); } break;
    case 6: case 14: { PHASE_TID() pg8::Gemm g{HBl, (const bf16*)(ws + WS_WGU + l * 11 * MiB), M, 2 * FF, D}; pg8::StaticOrder S; S.init(M, 2 * FF, G, bx);
        EpiSwiglu E{(bf16*)(ws + WS_ACT), SSQl};
        pg8::gemm_phase<EpiSwiglu, pg8::StaticOrder, true, true>(lds, g, S, E, tid); } break;
    case 8: case 16: { PHASE_TID() pg8::Gemm g{(const bf16*)(ws + WS_PB) + (size_t)l * M * PLE, (const bf16*)(ws + WS_WPU + l * (MiB / 2)), M, D, PLE}; pg8::StaticOrder S; S.init(M, D, G, bx);
        EpiPlain E{(bf16*)(ws + WS_UP), D};
        pg8::gemm_phase<EpiPlain, pg8::StaticOrder, true, true>(lds, g, S, E, tid); } break;
    case 9: case 17: { PHASE_TID() pg8::Gemm g{HBl, (const bf16*)(ws + WS_WPG + l * 2 * MiB), M, D, D}; pg8::StaticOrder S; S.init(M, D, G, bx);
        EpiPle E{OUT, OUT, HBo, SSQo, SSQl, (const bf16*)(ws + WS_UP)};
        pg8::gemm_phase<EpiPle, pg8::StaticOrder, true, true>(lds, g, S, E, tid); } break;
    default: break;
    }
}
#ifndef PHASE_MASK
#define PHASE_MASK 0xFFFFFFFFu
#endif
__global__ void __launch_bounds__(NTHREADS, 2) yoco_fwd(Args args) {
    extern __shared__ __attribute__((aligned(16))) unsigned char lds_raw[];
    LAS unsigned char* lds = (LAS unsigned char*)lds_raw;
    volatile LAS unsigned* MISC = (volatile LAS unsigned*)(lds + LDSCTL_OFF);
    for (int u = threadIdx.x; u < (LDS_BYTES - LDSCTL_OFF) / 4; u += NTHREADS) ((LAS unsigned*)(lds + LDSCTL_OFF))[u] = 0u;
    __syncthreads();
    XcdBarrier bar; bar.bar = (unsigned*)(args.ws + WS_CTL) + 4096; bar.x = 0; bar.st = nullptr;
    if (MK_N_LAUNCHES == 1) bar = xcd_barrier_post((unsigned*)(args.ws + WS_CTL) + 4096, MISC + 8);
    const int lo = args.ph_lo, hi = args.ph_hi;
    const int wave_s = __builtin_amdgcn_readfirstlane(threadIdx.x >> 6);
#pragma unroll 1
    for (int ph = lo; ph < hi; ++ph) {
        CArgs* ap = (CArgs*)__builtin_amdgcn_kernarg_segment_ptr(); unsigned ones = ~0u; int G = gridDim.x, bx = blockIdx.x;
        asm volatile("" : "+s"(ap), "+s"(ones), "+s"(G), "+s"(bx));
        if ((PHASE_MASK >> ph) & 1u) run_phase(ph, ap, lds, G, bx, wave_s, ones);
        if (ph + 1 < hi) { XcdBarrier b2 = bar; asm volatile("" : "+s"(b2.bar)); xcd_barrier(b2); }
    }
}

extern "C" void kernel_launch(void* const* d_in, const int* in_sizes, int n_in, void* d_out, int out_size, void* d_ws, size_t ws_size, hipStream_t stream) {
    static int grid = 0;
    if (grid == 0) {
        if (n_in != 19 || in_sizes[0] != M * D || out_size != M * D || ws_size < WS_END) { fprintf(stderr, "kernel_launch: unexpected shapes (n_in %d, in0 %d, out %d, ws %zu); nothing launched\n", n_in, n_in > 0 ? in_sizes[0] : -1, out_size, ws_size); grid = -1; return; }
        int dev = 0, cus = 0, per_cu = 0;
        if (hipGetDevice(&dev) != hipSuccess || hipDeviceGetAttribute(&cus, hipDeviceAttributeMultiprocessorCount, dev) != hipSuccess) { grid = -1; return; }
        if (hipFuncSetAttribute((const void*)yoco_fwd, hipFuncAttributeMaxDynamicSharedMemorySize, LDS_BYTES) != hipSuccess) { fprintf(stderr, "kernel_launch: hipFuncSetAttribute failed\n"); grid = -1; return; }
        if (hipOccupancyMaxActiveBlocksPerMultiprocessor(&per_cu, (const void*)yoco_fwd, NTHREADS, LDS_BYTES) != hipSuccess || per_cu < 1) { fprintf(stderr, "kernel_launch: occupancy query says %d blocks per CU\n", per_cu); per_cu = 1; }
        (void)hipGetLastError();
        grid = cus;
    }
    if (grid < 0) return;
    (void)hipMemsetAsync((char*)d_ws + WS_CTL, 0, CTL_ZERO_BYTES, stream);
    Args a{};
    for (int i = 0; i < 19; ++i) a.in[i] = (const float*)d_in[i];
    a.out = (float*)d_out; a.ws = (unsigned char*)d_ws;
    if (MK_N_LAUNCHES == 1) {
        a.ph_lo = 0; a.ph_hi = N_PHASES;
        hipLaunchKernelGGL(yoco_fwd, dim3(grid), dim3(NTHREADS), LDS_BYTES, stream, a);
    } else {
        for (int p = 0; p < N_PHASES; ++p) { a.ph_lo = p; a.ph_hi = p + 1; hipLaunchKernelGGL(yoco_fwd, dim3(grid), dim3(NTHREADS), LDS_BYTES, stream, a); }
    }
}
```

```cpp
#include <hip/hip_runtime.h>
#include <hip/hip_bf16.h>
#include <cstdio>
#include <cstdint>

#ifndef MK_N_LAUNCHES
#define MK_N_LAUNCHES 1
#endif

#define LAS __attribute__((address_space(3)))
#define GAS __attribute__((address_space(1)))

namespace pg8 {
#define PG8_LAS __attribute__((address_space(3)))
typedef unsigned short bf16_t;
typedef short bf16x8 __attribute__((ext_vector_type(8)));
typedef float f32x4 __attribute__((ext_vector_type(4)));
typedef unsigned u32x4 __attribute__((ext_vector_type(4)));
typedef unsigned u32x2 __attribute__((ext_vector_type(2)));
constexpr int BM = 256, BK = 64, HALF = 128, HTB = HALF * BK * 2, STAGE_BYTES = 8 * HTB, NXCD = 8, WGM = 8;

__host__ __device__ __forceinline__ int lds_byte(int r, int c) { const int st = (r >> 4) * 2 + (c >> 5), rr = r & 15, cc = c & 31, ob = rr * 64 + cc * 2; return st * 1024 + (ob ^ (((ob >> 9) & 1) << 5)); }
__host__ __device__ __forceinline__ void stage_rc(int b, int& R, int& C) { const int st = b / 1024, sb = b % 1024, swz = sb ^ (((sb >> 9) & 1) << 5); R = (st >> 1) * 16 + swz / 64; C = (st & 1) * 32 + (swz % 64) / 2; }
__host__ __device__ __forceinline__ int perm32(int rho) { const int n = rho >> 4, i = rho & 15; return 8 * (i >> 2) + 4 * n + (i & 3); }

struct Unit { int pm, pn; };
struct Gemm { const bf16_t* A; const bf16_t* Bt; int M, N, K; };

struct StaticOrder {
    int nM, nN, nwg, G, c;
    __host__ __device__ void init(int M, int N, int G_, int c_) { nM = M / BM; nN = N / BM; nwg = nM * nN; G = G_; c = c_; }
    __host__ __device__ bool next(int i, Unit& u) const {
        const long L = (long)i * G + c; if (L >= nwg) return false;
        int wgid = (int)L; { const int q = nwg / NXCD, r = nwg % NXCD, xcd = wgid % NXCD, off = wgid / NXCD; wgid = (xcd < r ? xcd * (q + 1) : r * (q + 1) + (xcd - r) * q) + off; }
        const int nig = WGM * nN, gid = wgid / nig, fm = gid * WGM, gsz = (nM - fm) < WGM ? (nM - fm) : WGM;
        u.pm = fm + ((wgid % nig) % gsz); u.pn = (wgid % nig) / gsz; return true;
    }
    __device__ __forceinline__ void a_ready(const Unit&) const {}
    __device__ __forceinline__ void done(const Unit&) const {}
};

typedef float f32x2_t __attribute__((ext_vector_type(2))); typedef __bf16 bf16x2_t __attribute__((ext_vector_type(2)));
__device__ __forceinline__ unsigned cvt_pk_bf16(float lo, float hi) { f32x2_t v = {lo, hi}; bf16x2_t b = __builtin_convertvector(v, bf16x2_t); return __builtin_bit_cast(unsigned, b); }

template <class Epi, class Sched, bool ALIGN_EPI = false, bool SP2 = false>
__device__ __forceinline__ void gemm_phase(PG8_LAS unsigned char* lds, const Gemm g, const Sched& S, const Epi& E, const int tid) {
    const int wid = __builtin_amdgcn_readfirstlane(tid >> 6), lane = tid & 63, wr = wid >> 2, wc = wid & 3, fr = lane & 15, fq = lane >> 4;
    int K_ = g.K; asm volatile("" : "+s"(K_));
    const int K = K_, nt = K / BK;
    unsigned voffA[2], voffB[2];
#pragma unroll
    for (int i = 0; i < 2; ++i) { int R, C; stage_rc(tid * 16 + i * 8192, R, C); const int Rb = Epi::PERM ? ((R & ~31) + perm32(R & 31)) : R;
        voffA[i] = (unsigned)(R * K + C) * 2u; voffB[i] = (unsigned)(Rb * K + C) * 2u; }
    const size_t kstep = (size_t)(BK * 2);
    const size_t hstep = (size_t)HALF * K * 2;
    const size_t tstep = 2 * hstep;
    const unsigned ldsw = (unsigned)wid * 1024u;
    const int aoff = lds_byte(wr * 64 + fr, fq * 8), boff = lds_byte(wc * 32 + fr, fq * 8);
#define PG8_SA(b, h) (((b) * 2 + (h)) * HTB)
#define PG8_SB(b, h) ((4 + (b) * 2 + (h)) * HTB)
#define PG8_STAGE(bufoff, gbase, voff) do { _Pragma("unroll") for (int _i = 0; _i < 2; ++_i) \
        __builtin_amdgcn_global_load_lds((const unsigned*)((const char*)(gbase) + (voff)[_i]), (PG8_LAS unsigned*)(lds + (bufoff) + ldsw + _i * 8192), 16, 0, 0); } while (0)
#define PG8_LDA(dst, b, h) do { _Pragma("unroll") for (int m = 0; m < 4; ++m) _Pragma("unroll") for (int k = 0; k < 2; ++k) dst[m][k] = *(const PG8_LAS bf16x8*)(lds + PG8_SA(b, h) + aoff + m * 2048 + k * 1024); } while (0)
#define PG8_LDB(dst, b, h) do { _Pragma("unroll") for (int n = 0; n < 2; ++n) _Pragma("unroll") for (int k = 0; k < 2; ++k) dst[n][k] = *(const PG8_LAS bf16x8*)(lds + PG8_SB(b, h) + boff + n * 2048 + k * 1024); } while (0)
#define PG8_MMA(ai, bj, At, Bt) do { __builtin_amdgcn_s_setprio(1); _Pragma("unroll") for (int m = 0; m < 4; ++m) _Pragma("unroll") for (int n = 0; n < 2; ++n) _Pragma("unroll") for (int k = 0; k < 2; ++k) \
        acc[ai][bj][m][n] = __builtin_amdgcn_mfma_f32_16x16x32_bf16(Bt[n][k], At[m][k], acc[ai][bj][m][n], 0, 0, 0); __builtin_amdgcn_s_setprio(0); } while (0)
#define PG8_WAIT_V(n) asm volatile("s_waitcnt vmcnt(" #n ")" ::: "memory")
#define PG8_WAIT_L(n) asm volatile("s_waitcnt lgkmcnt(" #n ")" ::: "memory")
#define PG8_BAR __builtin_amdgcn_s_barrier()
#define PG8_SCHED __builtin_amdgcn_sched_barrier(0)
    Unit cur, nxt; int ui = 0;
    if (!S.next(0, cur)) return;
    f32x4 acc[2][2][4][2];
#pragma unroll
    for (int a = 0; a < 2; ++a)
#pragma unroll
        for (int b = 0; b < 2; ++b)
#pragma unroll
            for (int m = 0; m < 4; ++m)
#pragma unroll
                for (int n = 0; n < 2; ++n) acc[a][b][m][n] = (f32x4){0.f, 0.f, 0.f, 0.f};
    bf16x8 At[4][2], B0[2][2], B1[2][2];
    const char* cA = (const char*)g.A + (size_t)cur.pm * tstep; const char* cB = (const char*)g.Bt + (size_t)cur.pn * tstep;
    S.a_ready(cur);
    if constexpr (SP2) {
        PG8_STAGE(PG8_SB(0, 0), cB, voffB); PG8_STAGE(PG8_SB(0, 1), cB + hstep, voffB); PG8_STAGE(PG8_SA(0, 0), cA, voffA); PG8_STAGE(PG8_SA(0, 1), cA + hstep, voffA);
        if (wr == 1) PG8_BAR;
        PG8_WAIT_V(2); PG8_BAR;
        PG8_STAGE(PG8_SB(1, 0), cB + kstep, voffB); PG8_STAGE(PG8_SA(1, 0), cA + kstep, voffA); PG8_STAGE(PG8_SB(1, 1), cB + hstep + kstep, voffB);
        PG8_WAIT_V(6); PG8_BAR;
    } else {
        PG8_STAGE(PG8_SB(0, 0), cB, voffB); PG8_STAGE(PG8_SA(0, 0), cA, voffA); PG8_STAGE(PG8_SB(0, 1), cB + hstep, voffB); PG8_STAGE(PG8_SA(0, 1), cA + hstep, voffA);
        if (wr == 1) PG8_BAR;
        PG8_WAIT_V(4); PG8_BAR;
        PG8_STAGE(PG8_SB(1, 0), cB + kstep, voffB); PG8_STAGE(PG8_SA(1, 0), cA + kstep, voffA); PG8_STAGE(PG8_SB(1, 1), cB + hstep + kstep, voffB);
        PG8_WAIT_V(6); PG8_BAR;
    }
    for (;;) {
        const bool has_next = S.next(ui + 1, nxt);
        const char* nA = has_next ? (const char*)g.A + (size_t)nxt.pm * tstep : cA; const char* nB = has_next ? (const char*)g.Bt + (size_t)nxt.pn * tstep : cB;
        for (int t = 0; t < nt; t += 2) {
            const bool last = (t == nt - 2);
            const char* a1 = cA + (size_t)(t + 1) * kstep;
            const char* a2 = last ? nA : cA + (size_t)(t + 2) * kstep; const char* b2 = last ? nB : cB + (size_t)(t + 2) * kstep;
            const char* a3 = a2 + kstep; const char* b3 = b2 + kstep;
            if (last && has_next) S.a_ready(nxt);
            if constexpr (SP2) {
            PG8_LDB(B0, 0, 0); PG8_LDB(B1, 0, 1); PG8_SCHED; PG8_LDA(At, 0, 0); PG8_STAGE(PG8_SA(1, 1), a1 + hstep, voffA);
            PG8_WAIT_V(8); PG8_WAIT_L(0); PG8_BAR; PG8_MMA(0, 0, At, B0); PG8_MMA(0, 1, At, B1); PG8_BAR; PG8_SCHED;
            PG8_LDA(At, 0, 1); PG8_STAGE(PG8_SB(0, 0), b2, voffB); PG8_STAGE(PG8_SB(0, 1), b2 + hstep, voffB); PG8_STAGE(PG8_SA(0, 0), a2, voffA);
            PG8_WAIT_V(8); PG8_WAIT_L(0); PG8_BAR; PG8_MMA(1, 0, At, B0); PG8_MMA(1, 1, At, B1); PG8_BAR; PG8_SCHED;
            PG8_LDB(B0, 1, 0); PG8_LDB(B1, 1, 1); PG8_SCHED; PG8_LDA(At, 1, 0); PG8_STAGE(PG8_SA(0, 1), a2 + hstep, voffA);
            PG8_WAIT_V(8); PG8_WAIT_L(0); PG8_BAR; PG8_MMA(0, 0, At, B0); PG8_MMA(0, 1, At, B1); PG8_BAR; PG8_SCHED;
            PG8_LDA(At, 1, 1); PG8_STAGE(PG8_SB(1, 0), b3, voffB); PG8_STAGE(PG8_SB(1, 1), b3 + hstep, voffB); PG8_STAGE(PG8_SA(1, 0), a3, voffA);
            PG8_WAIT_V(8); PG8_WAIT_L(0); PG8_BAR; PG8_MMA(1, 0, At, B0); PG8_MMA(1, 1, At, B1); PG8_BAR; PG8_SCHED;
            } else {
            PG8_LDB(B0, 0, 0); PG8_SCHED; PG8_LDA(At, 0, 0); PG8_STAGE(PG8_SA(1, 1), a1 + hstep, voffA);
            PG8_WAIT_L(8); PG8_BAR; PG8_WAIT_L(0); PG8_MMA(0, 0, At, B0); PG8_BAR; PG8_SCHED;
            PG8_LDB(B1, 0, 1); PG8_STAGE(PG8_SB(0, 0), b2, voffB);
            PG8_BAR; PG8_WAIT_L(0); PG8_MMA(0, 1, At, B1); PG8_BAR;
            PG8_LDA(At, 0, 1); PG8_STAGE(PG8_SA(0, 0), a2, voffA);
            PG8_BAR; PG8_WAIT_L(0); PG8_MMA(1, 0, At, B0); PG8_BAR; PG8_SCHED;
            PG8_STAGE(PG8_SB(0, 1), b2 + hstep, voffB);
            PG8_WAIT_V(6); PG8_BAR; PG8_MMA(1, 1, At, B1); PG8_BAR;
            PG8_LDB(B0, 1, 0); PG8_SCHED; PG8_LDA(At, 1, 0); PG8_STAGE(PG8_SA(0, 1), a2 + hstep, voffA);
            PG8_WAIT_L(8); PG8_BAR; PG8_WAIT_L(0); PG8_MMA(0, 0, At, B0); PG8_BAR; PG8_SCHED;
            PG8_LDB(B1, 1, 1); PG8_STAGE(PG8_SB(1, 0), b3, voffB);
            PG8_BAR; PG8_WAIT_L(0); PG8_MMA(0, 1, At, B1); PG8_BAR;
            PG8_LDA(At, 1, 1); PG8_STAGE(PG8_SA(1, 0), a3, voffA);
            PG8_BAR; PG8_WAIT_L(0); PG8_MMA(1, 0, At, B0); PG8_BAR; PG8_SCHED;
            PG8_STAGE(PG8_SB(1, 1), b3 + hstep, voffB);
            PG8_WAIT_V(6); PG8_BAR; PG8_MMA(1, 1, At, B1); PG8_BAR;
            }
        }
        if constexpr (ALIGN_EPI) { if (wr == 0) PG8_BAR; }
        E(acc, cur, wr, wc, fr, fq); S.done(cur);
        if (!has_next) break;
#pragma unroll
        for (int a = 0; a < 2; ++a)
#pragma unroll
            for (int b = 0; b < 2; ++b)
#pragma unroll
                for (int m = 0; m < 4; ++m)
#pragma unroll
                    for (int n = 0; n < 2; ++n) acc[a][b][m][n] = (f32x4){0.f, 0.f, 0.f, 0.f};
        cur = nxt; cA = nA; cB = nB; ++ui;
        if constexpr (ALIGN_EPI) { if (wr == 1) PG8_BAR; }
    }
    PG8_WAIT_V(0);
    if constexpr (!ALIGN_EPI) { if (wr == 0) PG8_BAR; }
    PG8_BAR;
#undef PG8_SA
#undef PG8_SB
#undef PG8_STAGE
#undef PG8_LDA
#undef PG8_LDB
#undef PG8_MMA
#undef PG8_WAIT_V
#undef PG8_WAIT_L
#undef PG8_BAR
#undef PG8_SCHED
}
}

typedef unsigned short bf16;
typedef float f32x4 __attribute__((ext_vector_type(4)));
typedef unsigned v4u __attribute__((ext_vector_type(4)));
typedef unsigned v2u __attribute__((ext_vector_type(2)));
constexpr int NB_ = 8, SEQ = 4096, D = 1024, M = NB_ * SEQ;
constexpr int ML_H = 8, ML_DV = 128, ML_DQK = 64, ML_L = 64, ML_NC = SEQ / ML_L, ML_IN = 3088, ML_INP = 3328;
constexpr int MB_H = 16, MB_KVH = 4, MB_HD = 64, MB_BLK = 256, MB_NB = SEQ / MB_BLK;
constexpr int FF = 2816, PLE = 256;
constexpr float EPS = 1e-6f, GATE_CAP = 15.0f;
constexpr int NWAVES = 8, NTHREADS = 512;

constexpr size_t MiB = 1u << 20;
constexpr size_t WS_CTL = 0, CTL_ZERO_BYTES = 1 * MiB;
constexpr size_t WS_ROPE = 1 * MiB;
constexpr size_t WS_KMP = 1 * MiB + 512 * 1024;
constexpr size_t WS_SSQ = 2 * MiB;
constexpr size_t WS_GATES = 6 * MiB;
constexpr size_t WS_MLOC = 8 * MiB, WS_GLAST = WS_MLOC + 16384, WS_MPREV = WS_GLAST + 16384;
constexpr size_t WS_NLOC = 9 * MiB;
constexpr size_t WS_WIN = 10 * MiB, WS_WOUT = 17 * MiB, WS_WQKV1 = 19 * MiB, WS_WO1 = 22 * MiB, WS_WGU = 24 * MiB  , WS_WDN = 46 * MiB  , WS_WPG = 58 * MiB  , WS_WPU = 62 * MiB  ;
constexpr size_t WS_HB = 64 * MiB, WS_HB2 = 448 * MiB;
constexpr size_t WS_PB = 128 * MiB;
constexpr size_t WS_UP = 160 * MiB;
constexpr size_t WS_OG = 160 * MiB;
constexpr size_t WS_Q0 = 224 * MiB, WS_K0 = 256 * MiB, WS_V0 = 288 * MiB  , WS_CLOC = 384 * MiB  ;
constexpr size_t WS_ACT = 224 * MiB;
constexpr size_t WS_Q1 = 224 * MiB, WS_K1 = 288 * MiB, WS_V1 = 304 * MiB, WS_AO = 320 * MiB;
constexpr size_t WS_END = 512 * MiB;

constexpr int LDS_BYTES = 147456;
constexpr int RING_BYTES = 131072;
constexpr int LDSCTL_OFF = RING_BYTES;

__device__ __forceinline__ unsigned f2bf(float f) { unsigned u = __builtin_bit_cast(unsigned, f); return (u + 0x7fffu + ((u >> 16) & 1u)) >> 16; }
__device__ __forceinline__ unsigned pk2(float lo, float hi) { return pg8::cvt_pk_bf16(lo, hi); }
__device__ __forceinline__ float bf_lo(unsigned u) { return __builtin_bit_cast(float, u << 16); }
__device__ __forceinline__ float bf_hi(unsigned u) { return __builtin_bit_cast(float, u & 0xffff0000u); }
__device__ __forceinline__ float rstd_of(const float* ssq, int row) {
    const f32x4* p = (const f32x4*)(ssq + (size_t)row * 16);
    const f32x4 a = p[0], b = p[1], c = p[2], d = p[3];
    const float s = (((a[0] + a[1]) + (a[2] + a[3])) + ((b[0] + b[1]) + (b[2] + b[3]))) + (((c[0] + c[1]) + (c[2] + c[3])) + ((d[0] + d[1]) + (d[2] + d[3])));
    return __builtin_amdgcn_rsqf(s * (1.0f / D) + EPS);
}
__device__ __forceinline__ float sigmoidf_(float x) { return __builtin_amdgcn_rcpf(1.0f + __builtin_amdgcn_exp2f(-1.4426950408889634f * x)); }
__device__ __forceinline__ float shx(float v, int mask, int lane) { return __builtin_bit_cast(float, __builtin_amdgcn_ds_bpermute((lane ^ mask) << 2, __builtin_bit_cast(int, v))); }
__device__ __forceinline__ int shxi(int v, int mask, int lane) { return __builtin_amdgcn_ds_bpermute((lane ^ mask) << 2, v); }
__device__ __forceinline__ float shup(float v, int o, int lane) { return __builtin_bit_cast(float, __builtin_amdgcn_ds_bpermute((lane >= o ? lane - o : lane) << 2, __builtin_bit_cast(int, v))); }
__device__ __forceinline__ float shidx(float v, int src) { return __builtin_bit_cast(float, __builtin_amdgcn_ds_bpermute(src << 2, __builtin_bit_cast(int, v))); }
__device__ __forceinline__ float wave_sum(float v, int lane) {
#pragma unroll
    for (int o = 1; o < 64; o <<= 1) v += shx(v, o, lane);
    return v;
}
__device__ __forceinline__ float wave_max(float v, int lane) {
#pragma unroll
    for (int o = 1; o < 64; o <<= 1) v = fmaxf(v, shx(v, o, lane));
    return v;
}

using pg8::Unit; using pg8::HALF; using pg8::BM;
#define ROWS8 _Pragma("unroll") for (int ai = 0; ai < 2; ++ai) _Pragma("unroll") for (int m = 0; m < 4; ++m)

struct EpiMl {
    static constexpr bool PERM = true, AFTER_DRAIN = false;
    unsigned char* ws; float* gates; const float* ssq; const float* bgate;
    __device__ __forceinline__ void operator()(const f32x4 (&acc)[2][2][4][2], const Unit& u, int wr, int wc, int fr, int fq) const {
        const int row0 = u.pm * BM + wr * 64 + fr;
        float rs[2][4];
        ROWS8 { rs[ai][m] = rstd_of(ssq, row0 + ai * HALF + m * 16); }
        if (u.pn < 12) {
            const int t = u.pn < 2 ? 0 : (u.pn < 4 ? 1 : (u.pn < 8 ? 2 : 3));
            const size_t boff = t == 0 ? WS_Q0 : (t == 1 ? WS_K0 : (t == 2 ? WS_V0 : WS_OG));
            const int ld = t < 2 ? 512 : 1024, colt = (u.pn - (t == 0 ? 0 : (t == 1 ? 2 : (t == 2 ? 4 : 8)))) * 256; const float sc = t == 0 ? 0.125f : 1.f;
            bf16* base = (bf16*)(ws + boff);
            const int col0 = colt + wc * 32 + 8 * fq;
            ROWS8 { bf16* rowp = base + (size_t)(row0 + ai * HALF + m * 16) * ld + col0; const float r = rs[ai][m] * sc;
#pragma unroll
                for (int bj = 0; bj < 2; ++bj) { const f32x4 v0 = acc[ai][bj][m][0] * r, v1 = acc[ai][bj][m][1] * r; v4u w; w.x = pk2(v0[0], v0[1]); w.y = pk2(v0[2], v0[3]); w.z = pk2(v1[0], v1[1]); w.w = pk2(v1[2], v1[3]);
                    *(v4u*)(rowp + bj * HALF) = w; } }
        } else if (wc == 0 && fq < 2) {
            float bg[8];
#pragma unroll
            for (int j = 0; j < 8; ++j) bg[j] = bgate[8 * fq + j];
            ROWS8 { const int row = row0 + ai * HALF + m * 16; const float r = rs[ai][m]; float o[8];
#pragma unroll
                for (int j = 0; j < 8; ++j) { const float pre = acc[ai][0][m][j >> 2][j & 3] * r + bg[j]; const float c = GATE_CAP * tanhf(pre * (1.0f / GATE_CAP));
                    o[j] = (fq == 0) ? c : -log1pf(expf(-c)); }
                float* gp = gates + (size_t)row * 16 + 8 * fq; *(f32x4*)gp = (f32x4){o[0], o[1], o[2], o[3]}; *(f32x4*)(gp + 4) = (f32x4){o[4], o[5], o[6], o[7]}; }
        }
    }
};
struct EpiQkv1 {
    static constexpr bool PERM = true, AFTER_DRAIN = false;
    unsigned char* ws; const float* ssq;
    __device__ __forceinline__ void operator()(const f32x4 (&acc)[2][2][4][2], const Unit& u, int wr, int wc, int fr, int fq) const {
        const int row0 = u.pm * BM + wr * 64 + fr;
        const size_t boff = u.pn < 4 ? WS_Q1 : (u.pn == 4 ? WS_K1 : WS_V1); const int ld = u.pn < 4 ? 1024 : 256, colt = u.pn < 4 ? u.pn * 256 : 0;
        bf16* base = (bf16*)(ws + boff);
        const int col0 = colt + wc * 32 + 8 * fq;
        ROWS8 { const float r = rstd_of(ssq, row0 + ai * HALF + m * 16); bf16* rowp = base + (size_t)(row0 + ai * HALF + m * 16) * ld + col0;
#pragma unroll
            for (int bj = 0; bj < 2; ++bj) { const f32x4 v0 = acc[ai][bj][m][0] * r, v1 = acc[ai][bj][m][1] * r; v4u w; w.x = pk2(v0[0], v0[1]); w.y = pk2(v0[2], v0[3]); w.z = pk2(v1[0], v1[1]); w.w = pk2(v1[2], v1[3]);
                *(v4u*)(rowp + bj * HALF) = w; }
            if (m == 3) asm volatile("" ::: "memory"); }
    }
};
struct EpiPlain {
    static constexpr bool PERM = true, AFTER_DRAIN = false;
    bf16* O; int ld;
    __device__ __forceinline__ void operator()(const f32x4 (&acc)[2][2][4][2], const Unit& u, int wr, int wc, int fr, int fq) const {
        const int row0 = u.pm * BM + wr * 64 + fr, col0 = u.pn * BM + wc * 32 + 8 * fq;
        ROWS8 { bf16* rowp = O + (size_t)(row0 + ai * HALF + m * 16) * ld + col0;
#pragma unroll
            for (int bj = 0; bj < 2; ++bj) { const f32x4 v0 = acc[ai][bj][m][0], v1 = acc[ai][bj][m][1]; v4u w; w.x = pk2(v0[0], v0[1]); w.y = pk2(v0[2], v0[3]); w.z = pk2(v1[0], v1[1]); w.w = pk2(v1[2], v1[3]);
                *(v4u*)(rowp + bj * HALF) = w; } }
    }
};
struct EpiSwiglu {
    static constexpr bool PERM = true, AFTER_DRAIN = false;
    bf16* act; const float* ssq;
    __device__ __forceinline__ void operator()(const f32x4 (&acc)[2][2][4][2], const Unit& u, int wr, int wc, int fr, int fq) const {
        const int row0 = u.pm * BM + wr * 64 + fr, col0 = u.pn * HALF + wc * 32 + 8 * fq;
        ROWS8 { const float r = rstd_of(ssq, row0 + ai * HALF + m * 16); bf16* rowp = act + (size_t)(row0 + ai * HALF + m * 16) * FF + col0; float o[8];
#pragma unroll
            for (int n = 0; n < 2; ++n)
#pragma unroll
                for (int e = 0; e < 4; ++e) { const float gv = acc[ai][0][m][n][e] * r, uv = acc[ai][1][m][n][e] * r; o[4 * n + e] = gv * sigmoidf_(gv) * uv; }
            v4u w; w.x = pk2(o[0], o[1]); w.y = pk2(o[2], o[3]); w.z = pk2(o[4], o[5]); w.w = pk2(o[6], o[7]); *(v4u*)rowp = w;
            if (m == 3) asm volatile("" ::: "memory"); }
    }
};
struct EpiRes {
    static constexpr bool PERM = false, AFTER_DRAIN = false;
    const float* base; float* out; bf16* hb; float* ssq;
    __device__ __forceinline__ void operator()(const f32x4 (&acc)[2][2][4][2], const Unit& u, int wr, int wc, int fr, int fq) const {
        const int row0 = u.pm * BM + wr * 64 + fr, col0 = u.pn * BM + wc * 32 + 4 * fq;
        ROWS8 { const int row = row0 + ai * HALF + m * 16; const size_t off = (size_t)row * D + col0; float part = 0.f;
#pragma unroll
            for (int bj = 0; bj < 2; ++bj)
#pragma unroll
                for (int n = 0; n < 2; ++n) { const size_t o2 = off + bj * HALF + n * 16; const f32x4 o = *(const f32x4*)(base + o2) + acc[ai][bj][m][n];
                    *(f32x4*)(out + o2) = o; v2u w; w.x = pk2(o[0], o[1]); w.y = pk2(o[2], o[3]); *(v2u*)(hb + o2) = w; part += (o[0] * o[0] + o[1] * o[1]) + (o[2] * o[2] + o[3] * o[3]); }
            part += shx(part, 16, fr + 16 * fq); part += shx(part, 32, fr + 16 * fq);
            if (fq == 0) ssq[(size_t)row * 16 + 4 * u.pn + wc] = part;
            if (m & 1) asm volatile("" ::: "memory"); }
    }
};
struct EpiPle {
    static constexpr bool PERM = false, AFTER_DRAIN = false;
    const float* base; float* out; bf16* hb; float* ssq_out; const float* ssq_in; const bf16* up;
    __device__ __forceinline__ void operator()(const f32x4 (&acc)[2][2][4][2], const Unit& u, int wr, int wc, int fr, int fq) const {
        const int row0 = u.pm * BM + wr * 64 + fr, col0 = u.pn * BM + wc * 32 + 4 * fq;
        ROWS8 { const int row = row0 + ai * HALF + m * 16; const size_t off = (size_t)row * D + col0; const float r = rstd_of(ssq_in, row); float part = 0.f;
#pragma unroll
            for (int bj = 0; bj < 2; ++bj)
#pragma unroll
                for (int n = 0; n < 2; ++n) { const size_t o2 = off + bj * HALF + n * 16; const v2u uw = *(const v2u*)(up + o2); const f32x4 a = acc[ai][bj][m][n] * r;
                    f32x4 o = *(const f32x4*)(base + o2);
                    o[0] += bf_lo(uw.x) * sigmoidf_(a[0]); o[1] += bf_hi(uw.x) * sigmoidf_(a[1]); o[2] += bf_lo(uw.y) * sigmoidf_(a[2]); o[3] += bf_hi(uw.y) * sigmoidf_(a[3]);
                    *(f32x4*)(out + o2) = o; v2u w; w.x = pk2(o[0], o[1]); w.y = pk2(o[2], o[3]); *(v2u*)(hb + o2) = w; part += (o[0] * o[0] + o[1] * o[1]) + (o[2] * o[2] + o[3] * o[3]); }
            part += shx(part, 16, fr + 16 * fq); part += shx(part, 32, fr + 16 * fq);
            if (fq == 0) ssq_out[(size_t)row * 16 + 4 * u.pn + wc] = part;
            asm volatile("" ::: "memory"); }
    }
};

typedef GAS unsigned gu32;
#define RLX_AGENT __ATOMIC_RELAXED, __HIP_MEMORY_SCOPE_AGENT
#define XB_TMO      128
#define XB_XCNT(j)  (256  + 64 * (j))
#define XB_XSUB(j)  (1280 + 64 * (j))
#define XB_XGEN(j)  (2304 + 64 * (j))
#define XB_TOP      3328
#define XB_TOPGEN   3392
#define XCD_BAR_WORDS 3456
#define XB_SPIN_CAP (1u << 22)
__device__ __forceinline__ unsigned xb_ld(unsigned* p)              { return __hip_atomic_load(p, __ATOMIC_RELAXED, __HIP_MEMORY_SCOPE_AGENT); }
__device__ __forceinline__ unsigned xb_add(unsigned* p, unsigned v) { return __hip_atomic_fetch_add(p, v, __ATOMIC_RELAXED, __HIP_MEMORY_SCOPE_AGENT); }
__device__ __forceinline__ unsigned xb_xcc_id() { return (unsigned)__builtin_amdgcn_s_getreg((3 << 11) | 20) & 0xFu; }
#define XB_SPIN(cond, bar) do { unsigned _sp = 0; while (cond) { __builtin_amdgcn_s_sleep(1); \
    if ((++_sp & 255u) == 0u) { if (xb_ld(&(bar)[XB_TMO])) break; if (_sp > XB_SPIN_CAP) { atomicAdd(&(bar)[XB_TMO], 1u); break; } } } } while (0)
struct XcdBarrier { unsigned* bar; unsigned x; volatile LAS unsigned* st; };
__device__ __forceinline__ XcdBarrier xcd_barrier_post(unsigned* bar, volatile LAS unsigned* st) {
    XcdBarrier b; b.bar = bar; b.x = xb_xcc_id(); b.st = st;
    if (threadIdx.x == 0) (void)xb_add(&bar[XB_XCNT(b.x)], 1u);
    return b;
}
__device__ __forceinline__ void xcd_barrier_complete(unsigned* bar, unsigned x, unsigned& nloc, unsigned& nx) {
    const unsigned G = gridDim.x * gridDim.y * gridDim.z;
    unsigned sum, cnt, mine, sp = 0u;
    for (;;) {
        sum = 0u; cnt = 0u; mine = 0u;
#pragma unroll
        for (unsigned j = 0; j < 16; ++j) { const unsigned c = xb_ld(&bar[XB_XCNT(j)]); sum += c; cnt += (c > 0u) ? 1u : 0u; mine = (j == x) ? c : mine; }
        if (sum == G) break;
        __builtin_amdgcn_s_sleep(1);
        if ((++sp & 255u) == 0u) { if (xb_ld(&bar[XB_TMO])) break; if (sp > XB_SPIN_CAP) { atomicAdd(&bar[XB_TMO], 1u); break; } }
    }
    nloc = mine > 0u ? mine : 1u; nx = cnt > 0u ? cnt : 1u;
}
__device__ __forceinline__ void xcd_barrier(const XcdBarrier& b) {
    asm volatile("s_waitcnt vmcnt(0)" ::: "memory");
    __syncthreads();
    if (threadIdx.x == 0) {
        unsigned* bar = b.bar;
        __builtin_amdgcn_s_waitcnt(0);
        unsigned nloc = b.st[0], nx = b.st[1];
        if (nloc == 0u) { xcd_barrier_complete(bar, b.x, nloc, nx); b.st[0] = nloc; b.st[1] = nx; }
        const unsigned old = xb_add(&bar[XB_XSUB(b.x)], 1u);
        const unsigned gen = old / nloc;
        if (old + 1u == (gen + 1u) * nloc) {
            __builtin_amdgcn_fence(__ATOMIC_RELEASE, "agent");
            asm volatile("s_waitcnt vmcnt(0)" ::: "memory");
            const unsigned og = xb_add(&bar[XB_TOP], 1u);
            const unsigned tg = og / nx;
            if (og + 1u == (tg + 1u) * nx) xb_add(&bar[XB_TOPGEN], 1u);
            else XB_SPIN(xb_ld(&bar[XB_TOPGEN]) == tg, bar);
            __builtin_amdgcn_fence(__ATOMIC_ACQUIRE, "agent");
            xb_add(&bar[XB_XGEN(b.x)], 1u);
            asm volatile("s_waitcnt vmcnt(0)" ::: "memory");
        } else {
            XB_SPIN(xb_ld(&bar[XB_XGEN(b.x)]) == gen, bar);
            __builtin_amdgcn_fence(__ATOMIC_ACQUIRE, "agent");
            asm volatile("s_waitcnt vmcnt(0)" ::: "memory");
        }
    }
    __syncthreads();
}

template <int MODE>
__device__ __forceinline__ void p0_transpose_item(const float* W, int K, int N, const float* gain, bf16* WT, int row_off, LAS float* scr, int item, int lane) {
    const int nblk = (N + 31) / 32, kb = item / nblk, nb = item % nblk, k0 = 64 * kb, n0 = 32 * nb;
    const int ncol = n0 + (lane & 31); const bool nok = ncol < N;
#pragma unroll 8
    for (int i = 0; i < 32; ++i) { const int kk = 2 * i + (lane >> 5); float v = nok ? W[(size_t)(k0 + kk) * N + ncol] : 0.f; if (gain) v *= gain[k0 + kk]; scr[kk * 33 + (lane & 31)] = v; }
    asm volatile("s_waitcnt lgkmcnt(0)" ::: "memory");
    const int c = lane & 7;
    int drow0;
    if (MODE == 0) drow0 = row_off + n0; else { const int isu = n0 >= FF ? 1 : 0, j0 = n0 - isu * FF; drow0 = 256 * (j0 / 128) + 128 * isu + (j0 % 128); }
#pragma unroll
    for (int j = 0; j < 4; ++j) { const int n = (lane >> 3) + 8 * j; const LAS float* s = scr + (8 * c) * 33 + n;
        v4u o; o.x = pk2(s[0 * 33], s[1 * 33]); o.y = pk2(s[2 * 33], s[3 * 33]); o.z = pk2(s[4 * 33], s[5 * 33]); o.w = pk2(s[6 * 33], s[7 * 33]);
        if (n0 + n < N) *(v4u*)(WT + (size_t)(drow0 + n) * K + k0 + 8 * c) = o; }
    asm volatile("s_waitcnt lgkmcnt(0)" ::: "memory");
}

struct Args { const float* in[19]; float* out; unsigned char* ws; int ph_lo, ph_hi; };
typedef const Args __attribute__((address_space(4))) CArgs;

__device__ __forceinline__ void p0_prologue(CArgs* A, LAS unsigned char* lds, int G, int vcu, int wave, int lane) {
    unsigned char* ws = A->ws;
    LAS float* scr = (LAS float*)(lds + wave * 16384);
    const int gw = vcu * NWAVES + wave, NGW = G * NWAVES;
    struct WI { int items; };
    constexpr int I_IN = 16 * 97, I_SQ = 16 * 32, I_KV = 16 * 16, I_GU = 16 * 176, I_DN = 44 * 32, I_PU = 4 * 32;
    constexpr int NITEMS = I_IN + I_SQ   + I_SQ   + I_KV + I_SQ   + 2 * I_GU + 2 * I_DN + 2 * I_SQ + 2 * I_PU;
    for (int it = gw; it < NITEMS; it += NGW) {
        int r = it;
        if (r < I_IN) { p0_transpose_item<0>(A->in[3], D, ML_IN, A->in[2], (bf16*)(ws + WS_WIN), 0, scr, r, lane); continue; } r -= I_IN;
        if (r < I_SQ) { p0_transpose_item<0>(A->in[6], D, D, nullptr, (bf16*)(ws + WS_WOUT), 0, scr, r, lane); continue; } r -= I_SQ;
        if (r < I_SQ) { p0_transpose_item<0>(A->in[10], D, D, A->in[2] + D, (bf16*)(ws + WS_WQKV1), 0, scr, r, lane); continue; } r -= I_SQ;
        if (r < I_KV) { p0_transpose_item<0>(A->in[8], D, 512, A->in[7], (bf16*)(ws + WS_WQKV1), D, scr, r, lane); continue; } r -= I_KV;
        if (r < I_SQ) { p0_transpose_item<0>(A->in[12], D, D, nullptr, (bf16*)(ws + WS_WO1), 0, scr, r, lane); continue; } r -= I_SQ;
        if (r < 2 * I_GU) { const int l = r / I_GU; p0_transpose_item<1>(A->in[14] + (size_t)l * D * 2 * FF, D, 2 * FF, A->in[13] + l * D, (bf16*)(ws + WS_WGU + l * 11 * MiB), 0, scr, r % I_GU, lane); continue; } r -= 2 * I_GU;
        if (r < 2 * I_DN) { const int l = r / I_DN; p0_transpose_item<0>(A->in[15] + (size_t)l * FF * D, FF, D, nullptr, (bf16*)(ws + WS_WDN + l * 6 * MiB), 0, scr, r % I_DN, lane); continue; } r -= 2 * I_DN;
        if (r < 2 * I_SQ) { const int l = r / I_SQ; p0_transpose_item<0>(A->in[17] + (size_t)l * D * D, D, D, A->in[16] + l * D, (bf16*)(ws + WS_WPG + l * 2 * MiB), 0, scr, r % I_SQ, lane); continue; } r -= 2 * I_SQ;
        { const int l = r / I_PU; p0_transpose_item<0>(A->in[18] + (size_t)l * PLE * D, PLE, D, nullptr, (bf16*)(ws + WS_WPU + l * (MiB / 2)), 0, scr, r % I_PU, lane); }
    }
    {
        const float* x = A->in[0]; bf16* hb = (bf16*)(ws + WS_HB); float* ssq = (float*)(ws + WS_SSQ);
        for (int m = gw; m < M; m += NGW) {
            const f32x4* xr = (const f32x4*)(x + (size_t)m * D) + lane; f32x4 v[4]; float s = 0.f;
#pragma unroll
            for (int j = 0; j < 4; ++j) { v[j] = xr[64 * j]; s += (v[j][0] * v[j][0] + v[j][1] * v[j][1]) + (v[j][2] * v[j][2] + v[j][3] * v[j][3]); }
            s = wave_sum(s, lane);
            unsigned long long* o8 = (unsigned long long*)(hb + (size_t)m * D) + lane;
#pragma unroll
            for (int j = 0; j < 4; ++j) o8[64 * j] = (unsigned long long)pk2(v[j][0], v[j][1]) | ((unsigned long long)pk2(v[j][2], v[j][3]) << 32);
            if (lane < 16) ssq[(size_t)m * 16 + lane] = (lane == 0) ? s : 0.f;
        }
    }
    {
        const float* p = A->in[1]; bf16* pb = (bf16*)(ws + WS_PB);
        const size_t n8 = (size_t)2 * M * PLE / 8, gt = (size_t)gw * 64 + lane, ngt = (size_t)NGW * 64;
        for (size_t i = gt; i < n8; i += ngt) { const f32x4 a = *(const f32x4*)(p + i * 8), b = *(const f32x4*)(p + i * 8 + 4);
            v4u w; w.x = pk2(a[0], a[1]); w.y = pk2(a[2], a[3]); w.z = pk2(b[0], b[1]); w.w = pk2(b[2], b[3]); *(v4u*)(pb + i * 8) = w; }
    }
    {
        float* rc = (float*)(ws + WS_ROPE); float* rsn = rc + SEQ * 8;
        const int gt = gw * 64 + lane;
        if (gt < SEQ * 8) { const int pos = gt >> 3, i = gt & 7;
            const float inv = (i == 0 ? 1.000000000e+00f : i == 1 ? 1.939227432e-01f : i == 2 ? 3.760603070e-02f : i == 3 ? 7.292664610e-03f : i == 4 ? 1.414213562e-03f : i == 5 ? 2.742481884e-04f : i == 6 ? 5.318295734e-05f : 1.031338525e-05f);
            const float angf = (float)pos * inv;
            const double rev = (double)angf * 0.15915494309189535; const double fr = rev - rint(rev);
            rc[gt] = __builtin_amdgcn_cosf((float)fr); rsn[gt] = __builtin_amdgcn_sinf((float)fr); }
    }
}

__device__ __forceinline__ float wave_incl_scan(float v, int lane) {
#pragma unroll
    for (int o = 1; o < 64; o <<= 1) { const float t = shup(v, o, lane); if (lane >= o) v += t; }
    return v;
}
__device__ __forceinline__ float wave_incl_max(float v, int lane) {
#pragma unroll
    for (int o = 1; o < 64; o <<= 1) { const float t = shup(v, o, lane); if (lane >= o) v = fmaxf(v, t); }
    return v;
}
__device__ __forceinline__ void mlstm_a(CArgs* A, LAS unsigned char* lds, int G, const int bx, const int tid) {
    unsigned char* ws = A->ws; const int lane = tid & 63;
    LAS float* kf = (LAS float*)lds;
    LAS float* vw = kf + 4096;
    LAS float* wl = vw + 8192;
    const float* gates = (const float*)(ws + WS_GATES); const bf16* K0 = (const bf16*)(ws + WS_K0); const bf16* V0 = (const bf16*)(ws + WS_V0);
    bf16* cloc = (bf16*)(ws + WS_CLOC); float* nloc = (float*)(ws + WS_NLOC); float* mloc = (float*)(ws + WS_MLOC); float* glast = (float*)(ws + WS_GLAST);
    for (int unit = bx; unit < NB_ * ML_H * ML_NC; unit += G) {
        const int bh = unit >> 6, c = unit & 63, b = bh >> 3, h = bh & 7, row0 = b * SEQ + c * ML_L;
        if (tid < 64) {
            const float li = gates[(size_t)(row0 + tid) * 16 + h], lf = gates[(size_t)(row0 + tid) * 16 + 8 + h];
            const float g = wave_incl_scan(lf, lane); const float gl = shidx(g, 63);
            const float a = gl - g + li; const float ml = wave_max(a, lane);
            wl[tid] = expf(a - ml);
            if (tid == 0) { mloc[unit] = ml; glast[unit] = gl; }
        }
        __syncthreads();
        { const int s = tid >> 3, kc = (tid & 7) * 8; const v4u kk = *(const v4u*)(K0 + (size_t)(row0 + s) * 512 + h * 64 + kc); LAS float* d = kf + s * 64 + kc;
          d[0] = bf_lo(kk.x); d[1] = bf_hi(kk.x); d[2] = bf_lo(kk.y); d[3] = bf_hi(kk.y); d[4] = bf_lo(kk.z); d[5] = bf_hi(kk.z); d[6] = bf_lo(kk.w); d[7] = bf_hi(kk.w);
          const int vc = (tid & 7) * 16; const float w = wl[s]; const v4u v0 = *(const v4u*)(V0 + (size_t)(row0 + s) * 1024 + h * 128 + vc), v1 = *(const v4u*)(V0 + (size_t)(row0 + s) * 1024 + h * 128 + vc + 8);
          LAS float* e = vw + s * 128 + vc;
          e[0] = w * bf_lo(v0.x); e[1] = w * bf_hi(v0.x); e[2] = w * bf_lo(v0.y); e[3] = w * bf_hi(v0.y); e[4] = w * bf_lo(v0.z); e[5] = w * bf_hi(v0.z); e[6] = w * bf_lo(v0.w); e[7] = w * bf_hi(v0.w);
          e[8] = w * bf_lo(v1.x); e[9] = w * bf_hi(v1.x); e[10] = w * bf_lo(v1.y); e[11] = w * bf_hi(v1.y); e[12] = w * bf_lo(v1.z); e[13] = w * bf_hi(v1.z); e[14] = w * bf_lo(v1.w); e[15] = w * bf_hi(v1.w); }
        __syncthreads();
        { const int v = tid >> 2, kg = (tid & 3) * 16; float acc[16];
#pragma unroll
          for (int i = 0; i < 16; ++i) acc[i] = 0.f;
          for (int s = 0; s < 64; ++s) { const float a = vw[s * 128 + v];
#pragma unroll
              for (int i = 0; i < 16; ++i) acc[i] += a * kf[s * 64 + kg + i]; }
          bf16* o = cloc + (size_t)unit * 8192 + v * 64 + kg;
          { v4u w0, w1; w0.x = pk2(acc[0], acc[1]); w0.y = pk2(acc[2], acc[3]); w0.z = pk2(acc[4], acc[5]); w0.w = pk2(acc[6], acc[7]); w1.x = pk2(acc[8], acc[9]); w1.y = pk2(acc[10], acc[11]); w1.z = pk2(acc[12], acc[13]); w1.w = pk2(acc[14], acc[15]);
            *(v4u*)o = w0; *(v4u*)(o + 8) = w1; }
          if (tid < 64) { float n = 0.f; for (int s = 0; s < 64; ++s) n += wl[s] * kf[s * 64 + tid]; nloc[(size_t)unit * 64 + tid] = n; } }
        __syncthreads();
    }
}
__device__ __forceinline__ void mlstm_scan(CArgs* A, int G, const int bx, const int tid) {
    unsigned char* ws = A->ws;
    float* cloc = (float*)(ws + WS_CLOC); float* nloc = (float*)(ws + WS_NLOC); const float* mloc = (const float*)(ws + WS_MLOC); const float* glast = (const float*)(ws + WS_GLAST); float* mprev = (float*)(ws + WS_MPREV);
    for (int su = bx; su < 64 * 4; su += G) {
        const int bh = su >> 2, qt = su & 3;
        float* cp = cloc + (size_t)bh * 64 * 8192 + qt * 2048 + tid * 4;
        f32x4 C = (f32x4){0.f, 0.f, 0.f, 0.f}; float n = 0.f, m = 0.f;
        for (int c = 0; c < 64; ++c) {
            const float ml = mloc[bh * 64 + c], gl = glast[bh * 64 + c];
            const float mn = fmaxf(gl + m, ml), sp = expf(gl + m - mn), sl = expf(ml - mn);
            const f32x4 cl = *(const f32x4*)(cp + (size_t)c * 8192);
            *(f32x4*)(cp + (size_t)c * 8192) = C;
            C = C * sp + cl * sl;
            if (qt == 0 && tid < 64) { float* np = nloc + (size_t)(bh * 64 + c) * 64 + tid; const float nl = *np; *np = n; n = sp * n + sl * nl; }
            if (qt == 0 && tid == 0) mprev[bh * 64 + c] = m;
            m = mn;
        }
    }
}
__device__ __forceinline__ void mlstm_c(CArgs* A, LAS unsigned char* lds, int G, const int bx, const int tid) {
    unsigned char* ws = A->ws; const int lane = tid & 63;
    LAS float* qf = (LAS float*)lds;
    LAS float* kf = qf + 4096;
    LAS float* vf = kf + 4096;
    LAS float* cp = vf + 8192;
    LAS float* Sm = cp + 128 * 65;
    LAS float* sc = Sm + 64 * 65;
    const float* gates = (const float*)(ws + WS_GATES); const bf16* Q0 = (const bf16*)(ws + WS_Q0); const bf16* K0 = (const bf16*)(ws + WS_K0); const bf16* V0 = (const bf16*)(ws + WS_V0);
    const bf16* OG = (const bf16*)(ws + WS_OG); bf16* HC = (bf16*)(ws + WS_V0);
    const bf16* cprev = (const bf16*)(ws + WS_CLOC); const float* nprev = (const float*)(ws + WS_NLOC); const float* mprev = (const float*)(ws + WS_MPREV);
    const float* mh_gain = A->in[5];
    for (int unit = bx; unit < NB_ * ML_H * ML_NC; unit += G) {
        const int bh = unit >> 6, c = unit & 63, b = bh >> 3, h = bh & 7, row0 = b * SEQ + c * ML_L;
        if (tid < 64) {
            const float li = gates[(size_t)(row0 + tid) * 16 + h], lf = gates[(size_t)(row0 + tid) * 16 + 8 + h];
            const float g = wave_incl_scan(lf, lane);
            const float pm = wave_incl_max(li - g, lane);
            const float mintra = g + pm, minter = g + mprev[unit], mc = fmaxf(minter, mintra);
            sc[tid] = g; sc[64 + tid] = li; sc[128 + tid] = mc; sc[192 + tid] = expf(minter - mc); sc[320 + tid] = nprev[(size_t)unit * 64 + tid];
        }
        { const int s = tid >> 3, kc = (tid & 7) * 8;
          const v4u qq = *(const v4u*)(Q0 + (size_t)(row0 + s) * 512 + h * 64 + kc); LAS float* dq = qf + s * 64 + kc;
          dq[0] = bf_lo(qq.x); dq[1] = bf_hi(qq.x); dq[2] = bf_lo(qq.y); dq[3] = bf_hi(qq.y); dq[4] = bf_lo(qq.z); dq[5] = bf_hi(qq.z); dq[6] = bf_lo(qq.w); dq[7] = bf_hi(qq.w);
          const v4u kk = *(const v4u*)(K0 + (size_t)(row0 + s) * 512 + h * 64 + kc); LAS float* d = kf + s * 64 + kc;
          d[0] = bf_lo(kk.x); d[1] = bf_hi(kk.x); d[2] = bf_lo(kk.y); d[3] = bf_hi(kk.y); d[4] = bf_lo(kk.z); d[5] = bf_hi(kk.z); d[6] = bf_lo(kk.w); d[7] = bf_hi(kk.w);
          const int vc = (tid & 7) * 16; const v4u v0 = *(const v4u*)(V0 + (size_t)(row0 + s) * 1024 + h * 128 + vc), v1 = *(const v4u*)(V0 + (size_t)(row0 + s) * 1024 + h * 128 + vc + 8);
          LAS float* e = vf + s * 128 + vc;
          e[0] = bf_lo(v0.x); e[1] = bf_hi(v0.x); e[2] = bf_lo(v0.y); e[3] = bf_hi(v0.y); e[4] = bf_lo(v0.z); e[5] = bf_hi(v0.z); e[6] = bf_lo(v0.w); e[7] = bf_hi(v0.w);
          e[8] = bf_lo(v1.x); e[9] = bf_hi(v1.x); e[10] = bf_lo(v1.y); e[11] = bf_hi(v1.y); e[12] = bf_lo(v1.z); e[13] = bf_hi(v1.z); e[14] = bf_lo(v1.w); e[15] = bf_hi(v1.w);
          const bf16* cs = cprev + (size_t)unit * 8192;
#pragma unroll
          for (int i = 0; i < 4; ++i) { const int e4 = tid * 4 + i * 2048; const v2u cv = *(const v2u*)(cs + e4); const int v = e4 >> 6, k = e4 & 63; LAS float* dd = cp + v * 65 + k; dd[0] = bf_lo(cv.x); dd[1] = bf_hi(cv.x); dd[2] = bf_lo(cv.y); dd[3] = bf_hi(cv.y); } }
        __syncthreads();
        { const int j = tid >> 3, sg = (tid & 7) * 8; const float gj = sc[j], mcj = sc[128 + j];
#pragma unroll
          for (int i = 0; i < 8; ++i) { const int s = sg + i; float d = 0.f;
              for (int k = 0; k < 64; ++k) d += qf[j * 64 + k] * kf[s * 64 + k];
              Sm[j * 65 + s] = (s <= j) ? d * expf(gj - sc[s] + sc[64 + s] - mcj) : 0.f; } }
        __syncthreads();
        if (tid < 64) { const int j = tid; float qn = 0.f, rsum = 0.f;
            for (int k = 0; k < 64; ++k) qn += qf[j * 64 + k] * sc[320 + k];
            for (int s = 0; s < 64; ++s) rsum += Sm[j * 65 + s];
            const float dn = sc[192 + j] * qn + rsum; sc[256 + j] = fmaxf(fabsf(dn), expf(-sc[128 + j])); }
        const int j = tid >> 3, vg = (tid & 7) * 16; float acc[16];
        { const float wi = sc[192 + j];
#pragma unroll
          for (int i = 0; i < 16; ++i) acc[i] = 0.f;
          for (int k = 0; k < 64; ++k) { const float q = qf[j * 64 + k];
#pragma unroll
              for (int i = 0; i < 16; ++i) acc[i] += q * cp[(vg + i) * 65 + k]; }
#pragma unroll
          for (int i = 0; i < 16; ++i) acc[i] *= wi;
          for (int s = 0; s < 64; ++s) { const float p = Sm[j * 65 + s];
#pragma unroll
              for (int i = 0; i < 16; ++i) acc[i] += p * vf[s * 128 + vg + i]; } }
        __syncthreads();
        { const float inv = 1.0f / sc[256 + j]; float ss = 0.f;
#pragma unroll
          for (int i = 0; i < 16; ++i) { acc[i] *= inv; ss += acc[i] * acc[i]; }
          ss += shx(ss, 1, lane); ss += shx(ss, 2, lane); ss += shx(ss, 4, lane);
          const float rn = __builtin_amdgcn_rsqf(ss * (1.0f / ML_DV) + EPS);
          const size_t off = (size_t)(row0 + j) * 1024 + h * 128 + vg;
          const v4u o0 = *(const v4u*)(OG + off), o1 = *(const v4u*)(OG + off + 8);
          float og[16] = {bf_lo(o0.x), bf_hi(o0.x), bf_lo(o0.y), bf_hi(o0.y), bf_lo(o0.z), bf_hi(o0.z), bf_lo(o0.w), bf_hi(o0.w), bf_lo(o1.x), bf_hi(o1.x), bf_lo(o1.y), bf_hi(o1.y), bf_lo(o1.z), bf_hi(o1.z), bf_lo(o1.w), bf_hi(o1.w)};
          float r[16];
#pragma unroll
          for (int i = 0; i < 16; ++i) r[i] = acc[i] * rn * mh_gain[vg + i] * sigmoidf_(og[i]);
          v4u w0, w1; w0.x = pk2(r[0], r[1]); w0.y = pk2(r[2], r[3]); w0.z = pk2(r[4], r[5]); w0.w = pk2(r[6], r[7]); w1.x = pk2(r[8], r[9]); w1.y = pk2(r[10], r[11]); w1.z = pk2(r[12], r[13]); w1.w = pk2(r[14], r[15]);
          *(v4u*)(HC + off) = w0; *(v4u*)(HC + off + 8) = w1; }
        __syncthreads();
    }
}

namespace ml {
typedef short bf16x8 __attribute__((ext_vector_type(8)));
typedef short s16x4 __attribute__((ext_vector_type(4)));
typedef short v4i16_t __attribute__((ext_vector_type(4)));
constexpr int KST = 160, VST = 288, QST = 144;
__device__ __forceinline__ s16x4 tr16(const LAS unsigned char* p) { return __builtin_bit_cast(s16x4, __builtin_amdgcn_ds_read_tr16_b64_v4i16((LAS v4i16_t*)p)); }
__device__ __forceinline__ bf16x8 cat8(s16x4 a, s16x4 b) { return (bf16x8){a[0], a[1], a[2], a[3], b[0], b[1], b[2], b[3]}; }
__device__ __forceinline__ bf16x8 trfrag(const LAS unsigned char* img, int stride, int ks, int col0, int c, int g) {
    const LAS unsigned char* p = img + (32 * ks + 4 * g + (c >> 2)) * stride + (col0 + 4 * (c & 3)) * 2;
    return cat8(tr16(p), tr16(p + 16 * stride));
}
__device__ __forceinline__ void st8(LAS unsigned char* d, float a, float b, float c, float e) { v2u w; w.x = pk2(a, b); w.y = pk2(c, e); *(LAS v2u*)d = w; }

__device__ __forceinline__ void phase_a(CArgs* A, LAS unsigned char* lds, int G, const int bx, const int tid) {
    unsigned char* ws = A->ws; const int lane = tid & 63, wid = __builtin_amdgcn_readfirstlane(tid >> 6), c = lane & 15, g = lane >> 4;
    LAS unsigned char* Ks = lds; LAS unsigned char* Vs = lds + 64 * KST; LAS float* wl = (LAS float*)(Vs + 64 * VST);
    const float* gates = (const float*)(ws + WS_GATES); const bf16* K0 = (const bf16*)(ws + WS_K0); const bf16* V0 = (const bf16*)(ws + WS_V0);
    bf16* cloc = (bf16*)(ws + WS_CLOC); float* nloc = (float*)(ws + WS_NLOC); float* mloc = (float*)(ws + WS_MLOC); float* glast = (float*)(ws + WS_GLAST);
    const int NU = NB_ * ML_H * ML_NC, srow = tid >> 3, pc = tid & 7;
    v4u kx, vx0, vx1; float li = 0.f, lf = 0.f;
#define MLA_LOAD(unit) do { const int bh_ = (unit) >> 6, c_ = (unit) & 63, b_ = bh_ >> 3, h_ = bh_ & 7, r_ = b_ * SEQ + c_ * ML_L + srow; \
        kx = *(const v4u*)(K0 + (size_t)r_ * 512 + h_ * 64 + pc * 8); vx0 = *(const v4u*)(V0 + (size_t)r_ * 1024 + h_ * 128 + pc * 16); vx1 = *(const v4u*)(V0 + (size_t)r_ * 1024 + h_ * 128 + pc * 16 + 8); \
        if (tid < 64) { const size_t gr_ = (size_t)(b_ * SEQ + c_ * ML_L + tid) * 16; li = gates[gr_ + h_]; lf = gates[gr_ + 8 + h_]; } } while (0)
    int unit = bx;
    if (unit < NU) MLA_LOAD(unit);
    for (; unit < NU; unit += G) {
        if (tid < 64) {
            const float gs = wave_incl_scan(lf, lane); const float gl = shidx(gs, 63);
            const float a = gl - gs + li; const float ml = wave_max(a, lane);
            wl[tid] = __expf(a - ml);
            if (tid == 0) { mloc[unit] = ml; glast[unit] = gl; }
        }
        *(LAS v4u*)(Ks + srow * KST + pc * 16) = kx;
        __syncthreads();
        { const float w = wl[srow];
          v4u o0, o1;
          o0.x = pk2(w * bf_lo(vx0.x), w * bf_hi(vx0.x)); o0.y = pk2(w * bf_lo(vx0.y), w * bf_hi(vx0.y)); o0.z = pk2(w * bf_lo(vx0.z), w * bf_hi(vx0.z)); o0.w = pk2(w * bf_lo(vx0.w), w * bf_hi(vx0.w));
          o1.x = pk2(w * bf_lo(vx1.x), w * bf_hi(vx1.x)); o1.y = pk2(w * bf_lo(vx1.y), w * bf_hi(vx1.y)); o1.z = pk2(w * bf_lo(vx1.z), w * bf_hi(vx1.z)); o1.w = pk2(w * bf_lo(vx1.w), w * bf_hi(vx1.w));
          *(LAS v4u*)(Vs + srow * VST + pc * 32) = o0; *(LAS v4u*)(Vs + srow * VST + pc * 32 + 16) = o1; }
        __syncthreads();
        const int nxt = unit + G;
        if (nxt < NU) MLA_LOAD(nxt);
        { bf16x8 bfr[2];
#pragma unroll
          for (int ks = 0; ks < 2; ++ks) bfr[ks] = trfrag(Vs, VST, ks, 16 * wid, c, g);
          bf16* orow = cloc + ((size_t)unit * 128 + 16 * wid + c) * 64 + 4 * g;
#pragma unroll
          for (int kt = 0; kt < 4; ++kt) { f32x4 acc = (f32x4){0.f, 0.f, 0.f, 0.f};
#pragma unroll
              for (int ks = 0; ks < 2; ++ks) acc = __builtin_amdgcn_mfma_f32_16x16x32_bf16(trfrag(Ks, KST, ks, 16 * kt, c, g), bfr[ks], acc, 0, 0, 0);
              v2u w; w.x = pk2(acc[0], acc[1]); w.y = pk2(acc[2], acc[3]); *(v2u*)(orow + 16 * kt) = w; }
          if (tid < 64) { float n = 0.f;
#pragma unroll 8
              for (int s = 0; s < 64; ++s) n += wl[s] * bf_lo((unsigned)*(const LAS unsigned short*)(Ks + s * KST + tid * 2));
              nloc[(size_t)unit * 64 + tid] = n; } }
        __syncthreads();
    }
#undef MLA_LOAD
}
__device__ __forceinline__ void phase_scan(CArgs* A, int G, const int bx, const int tid) {
    unsigned char* ws = A->ws;
    bf16* cloc = (bf16*)(ws + WS_CLOC); float* nloc = (float*)(ws + WS_NLOC); const float* mloc = (const float*)(ws + WS_MLOC); const float* glast = (const float*)(ws + WS_GLAST); float* mprev = (float*)(ws + WS_MPREV);
    for (int su = bx; su < 64 * 4; su += G) {
        const int bh = su >> 2, qt = su & 3;
        bf16* cp = cloc + (size_t)bh * 64 * 8192 + qt * 2048 + tid * 4;
        float C0 = 0.f, C1 = 0.f, C2 = 0.f, C3 = 0.f, n = 0.f, m = 0.f;
#pragma unroll 1
        for (int c0 = 0; c0 < 64; c0 += 8) {
            v2u cl[8]; float ml[8], gl[8], nl[8];
#pragma unroll
            for (int i = 0; i < 8; ++i) { cl[i] = *(const v2u*)(cp + (size_t)(c0 + i) * 8192); ml[i] = mloc[bh * 64 + c0 + i]; gl[i] = glast[bh * 64 + c0 + i];
                nl[i] = (qt == 0 && tid < 64) ? nloc[(size_t)(bh * 64 + c0 + i) * 64 + tid] : 0.f; }
#pragma unroll
            for (int i = 0; i < 8; ++i) {
                const float mn = fmaxf(gl[i] + m, ml[i]), sp = __expf(gl[i] + m - mn), sl = __expf(ml[i] - mn);
                v2u o; o.x = pk2(C0, C1); o.y = pk2(C2, C3); *(v2u*)(cp + (size_t)(c0 + i) * 8192) = o;
                C0 = sp * C0 + sl * bf_lo(cl[i].x); C1 = sp * C1 + sl * bf_hi(cl[i].x); C2 = sp * C2 + sl * bf_lo(cl[i].y); C3 = sp * C3 + sl * bf_hi(cl[i].y);
                if (qt == 0 && tid < 64) { nloc[(size_t)(bh * 64 + c0 + i) * 64 + tid] = n; n = sp * n + sl * nl[i]; }
                if (qt == 0 && tid == 0) mprev[bh * 64 + c0 + i] = m;
                m = mn;
            }
        }
    }
}
__device__ __forceinline__ void phase_c(CArgs* A, LAS unsigned char* lds, int G, const int bx, const int tid) {
    unsigned char* ws = A->ws; const int lane = tid & 63, wid = __builtin_amdgcn_readfirstlane(tid >> 6), c = lane & 15, g = lane >> 4, jt = wid & 3, vh = wid >> 2;
    LAS unsigned char* Qs = lds; LAS unsigned char* Ks = Qs + 64 * QST; LAS unsigned char* Cs = Ks + 64 * QST; LAS unsigned char* Vs = Cs + 128 * QST; LAS unsigned char* Os = Vs + 64 * VST;
    LAS float* sc = (LAS float*)(Os + 64 * VST);
    const float* gates = (const float*)(ws + WS_GATES); const bf16* Q0 = (const bf16*)(ws + WS_Q0); const bf16* K0 = (const bf16*)(ws + WS_K0); const bf16* V0 = (const bf16*)(ws + WS_V0);
    const bf16* OG = (const bf16*)(ws + WS_OG); bf16* HC = (bf16*)(ws + WS_V0);
    const bf16* cprev = (const bf16*)(ws + WS_CLOC); const float* nprev = (const float*)(ws + WS_NLOC); const float* mprev = (const float*)(ws + WS_MPREV);
    const float* mh_gain = A->in[5];
    const int NU = NB_ * ML_H * ML_NC, srow = tid >> 3, pc = tid & 7;
    v4u qx, kx, vx0, vx1, cx0, cx1, ox0, ox1; float li = 0.f, lf = 0.f, mp = 0.f, np = 0.f;
#define MLC_LOAD(unit) do { const int bh_ = (unit) >> 6, c_ = (unit) & 63, b_ = bh_ >> 3, h_ = bh_ & 7, r_ = b_ * SEQ + c_ * ML_L + srow; \
        qx = *(const v4u*)(Q0 + (size_t)r_ * 512 + h_ * 64 + pc * 8); kx = *(const v4u*)(K0 + (size_t)r_ * 512 + h_ * 64 + pc * 8); \
        vx0 = *(const v4u*)(V0 + (size_t)r_ * 1024 + h_ * 128 + pc * 16); vx1 = *(const v4u*)(V0 + (size_t)r_ * 1024 + h_ * 128 + pc * 16 + 8); \
        ox0 = *(const v4u*)(OG + (size_t)r_ * 1024 + h_ * 128 + pc * 16); ox1 = *(const v4u*)(OG + (size_t)r_ * 1024 + h_ * 128 + pc * 16 + 8); \
        cx0 = *(const v4u*)(cprev + (size_t)(unit) * 8192 + tid * 16); cx1 = *(const v4u*)(cprev + (size_t)(unit) * 8192 + tid * 16 + 8); \
        if (tid < 64) { const size_t gr_ = (size_t)(b_ * SEQ + c_ * ML_L + tid) * 16; li = gates[gr_ + h_]; lf = gates[gr_ + 8 + h_]; mp = mprev[unit]; np = nprev[(size_t)(unit) * 64 + tid]; } } while (0)
    int unit = bx;
    if (unit < NU) MLC_LOAD(unit);
    for (; unit < NU; unit += G) {
        const int bh = unit >> 6, cc = unit & 63, b = bh >> 3, h = bh & 7, row0 = b * SEQ + cc * ML_L;
        if (tid < 64) {
            const float gs = wave_incl_scan(lf, lane); const float pm = wave_incl_max(li - gs, lane);
            const float mintra = gs + pm, minter = gs + mp, mc = fmaxf(minter, mintra);
            sc[tid] = gs - mc; sc[64 + tid] = li - gs; sc[128 + tid] = __expf(minter - mc); sc[192 + tid] = __expf(-mc); sc[256 + tid] = np;
        }
        *(LAS v4u*)(Qs + srow * QST + pc * 16) = qx; *(LAS v4u*)(Ks + srow * QST + pc * 16) = kx;
        *(LAS v4u*)(Vs + srow * VST + pc * 32) = vx0; *(LAS v4u*)(Vs + srow * VST + pc * 32 + 16) = vx1;
        *(LAS v4u*)(Os + srow * VST + pc * 32) = ox0; *(LAS v4u*)(Os + srow * VST + pc * 32 + 16) = ox1;
        { const int cv = tid >> 2, cp = (tid & 3) * 2; *(LAS v4u*)(Cs + cv * QST + cp * 16) = cx0; *(LAS v4u*)(Cs + cv * QST + cp * 16 + 16) = cx1; }
        __syncthreads();
        const int nxt = unit + G;
        if (nxt < NU) MLC_LOAD(nxt);
        const int j = 16 * jt + c;
        bf16x8 qf[2];
#pragma unroll
        for (int ks = 0; ks < 2; ++ks) qf[ks] = *(const LAS bf16x8*)(Qs + j * QST + (32 * ks + 8 * g) * 2);
        f32x4 p[4]; float rs = 0.f; const float uj = sc[j];
#pragma unroll
        for (int st = 0; st < 4; ++st) { f32x4 acc = (f32x4){0.f, 0.f, 0.f, 0.f};
#pragma unroll
            for (int ks = 0; ks < 2; ++ks) acc = __builtin_amdgcn_mfma_f32_16x16x32_bf16(*(const LAS bf16x8*)(Ks + (16 * st + c) * QST + (32 * ks + 8 * g) * 2), qf[ks], acc, 0, 0, 0);
            const f32x4 tt = *(const LAS f32x4*)(sc + 64 + 16 * st + 4 * g);
#pragma unroll
            for (int r = 0; r < 4; ++r) { const int s = 16 * st + 4 * g + r; const float v = (s <= j) ? acc[r] * __expf(uj + tt[r]) : 0.f; p[st][r] = v; rs += v; } }
        bf16x8 pb[2];
#pragma unroll
        for (int ks = 0; ks < 2; ++ks) { v4u w; w.x = pk2(p[2 * ks][0], p[2 * ks][1]); w.y = pk2(p[2 * ks][2], p[2 * ks][3]); w.z = pk2(p[2 * ks + 1][0], p[2 * ks + 1][1]); w.w = pk2(p[2 * ks + 1][2], p[2 * ks + 1][3]); pb[ks] = __builtin_bit_cast(bf16x8, w); }
        f32x4 hh[4]; const float wi = sc[128 + j];
#pragma unroll
        for (int vt = 0; vt < 4; ++vt) { f32x4 acc = (f32x4){0.f, 0.f, 0.f, 0.f};
#pragma unroll
            for (int ks = 0; ks < 2; ++ks) acc = __builtin_amdgcn_mfma_f32_16x16x32_bf16(*(const LAS bf16x8*)(Cs + (64 * vh + 16 * vt + c) * QST + (32 * ks + 8 * g) * 2), qf[ks], acc, 0, 0, 0);
            acc = acc * wi;
#pragma unroll
            for (int ks = 0; ks < 2; ++ks) acc = __builtin_amdgcn_mfma_f32_16x16x32_bf16(trfrag(Vs, VST, ks, 64 * vh + 16 * vt, c, g), pb[ks], acc, 0, 0, 0);
            hh[vt] = acc; }
        float qn = 0.f;
        { const v4u q0 = *(const LAS v4u*)(Qs + j * QST + 32 * g), q1 = *(const LAS v4u*)(Qs + j * QST + 32 * g + 16); const LAS f32x4* nv = (const LAS f32x4*)(sc + 256 + 16 * g);
          const f32x4 n0 = nv[0], n1 = nv[1], n2 = nv[2], n3 = nv[3];
          qn = (bf_lo(q0.x) * n0[0] + bf_hi(q0.x) * n0[1] + bf_lo(q0.y) * n0[2] + bf_hi(q0.y) * n0[3]) + (bf_lo(q0.z) * n1[0] + bf_hi(q0.z) * n1[1] + bf_lo(q0.w) * n1[2] + bf_hi(q0.w) * n1[3])
             + (bf_lo(q1.x) * n2[0] + bf_hi(q1.x) * n2[1] + bf_lo(q1.y) * n2[2] + bf_hi(q1.y) * n2[3]) + (bf_lo(q1.z) * n3[0] + bf_hi(q1.z) * n3[1] + bf_lo(q1.w) * n3[2] + bf_hi(q1.w) * n3[3]); }
        qn += shx(qn, 16, lane); qn += shx(qn, 32, lane); rs += shx(rs, 16, lane); rs += shx(rs, 32, lane);
        const float inv = 1.0f / fmaxf(fabsf(wi * qn + rs), sc[192 + j]);
        float ss = 0.f;
#pragma unroll
        for (int vt = 0; vt < 4; ++vt) { hh[vt] = hh[vt] * inv; ss += (hh[vt][0] * hh[vt][0] + hh[vt][1] * hh[vt][1]) + (hh[vt][2] * hh[vt][2] + hh[vt][3] * hh[vt][3]); }
        ss += shx(ss, 16, lane); ss += shx(ss, 32, lane);
        if (g == 0) sc[320 + 64 * vh + j] = ss;
        __syncthreads();
        const float rn = __builtin_amdgcn_rsqf((sc[320 + j] + sc[384 + j]) * (1.0f / ML_DV) + EPS);
#pragma unroll
        for (int vt = 0; vt < 4; ++vt) { const int v0 = 64 * vh + 16 * vt + 4 * g; const v2u ow = *(const LAS v2u*)(Os + j * VST + v0 * 2); const f32x4 gn = *(const f32x4*)(mh_gain + v0);
            st8(Vs + j * VST + v0 * 2, hh[vt][0] * rn * gn[0] * sigmoidf_(bf_lo(ow.x)), hh[vt][1] * rn * gn[1] * sigmoidf_(bf_hi(ow.x)), hh[vt][2] * rn * gn[2] * sigmoidf_(bf_lo(ow.y)), hh[vt][3] * rn * gn[3] * sigmoidf_(bf_hi(ow.y))); }
        __syncthreads();
        { const v4u o0 = *(const LAS v4u*)(Vs + srow * VST + pc * 32), o1 = *(const LAS v4u*)(Vs + srow * VST + pc * 32 + 16); bf16* op = HC + (size_t)(row0 + srow) * 1024 + h * 128 + pc * 16;
          *(v4u*)op = o0; *(v4u*)(op + 8) = o1; }
        __syncthreads();
    }
#undef MLC_LOAD
}
}

__device__ __forceinline__ void moba_fixup(CArgs* A, LAS unsigned char* lds, int G, const int bx, const int tid) {
    unsigned char* ws = A->ws;
    bf16* Q1 = (bf16*)(ws + WS_Q1); bf16* K1 = (bf16*)(ws + WS_K1); float* kmp = (float*)(ws + WS_KMP);
    const float* rc = (const float*)(ws + WS_ROPE); const float* rsn = rc + SEQ * 8;
    const float* qg = A->in[11]; const float* kg = A->in[9];
    LAS float* ks = (LAS float*)lds;
    for (int unit = bx; unit < M / 128; unit += G) {
        const int r0 = unit * 128;
        for (int it = tid; it < 128 * 20; it += NTHREADS) {
            const int rl = it / 20, hh = it % 20, row = r0 + rl, pos = row & (SEQ - 1);
            bf16* p = (hh < 16) ? Q1 + (size_t)row * 1024 + hh * 64 : K1 + (size_t)row * 256 + (hh - 16) * 64;
            const float* gn = (hh < 16) ? qg : kg;
            float v[64]; float ss = 0.f;
#pragma unroll
            for (int i = 0; i < 8; ++i) { const v4u w = *(const v4u*)(p + 8 * i); v[8 * i] = bf_lo(w.x); v[8 * i + 1] = bf_hi(w.x); v[8 * i + 2] = bf_lo(w.y); v[8 * i + 3] = bf_hi(w.y); v[8 * i + 4] = bf_lo(w.z); v[8 * i + 5] = bf_hi(w.z); v[8 * i + 6] = bf_lo(w.w); v[8 * i + 7] = bf_hi(w.w); }
#pragma unroll
            for (int i = 0; i < 64; ++i) ss += v[i] * v[i];
            const float rn = __builtin_amdgcn_rsqf(ss * (1.0f / 64.0f) + EPS);
#pragma unroll
            for (int i = 0; i < 64; ++i) v[i] = v[i] * rn * gn[i];
            if (hh < 16) {
#pragma unroll
                for (int i = 0; i < 64; ++i) v[i] *= 0.125f * 1.4426950408889634f; }
#pragma unroll
            for (int i = 0; i < 8; ++i) { const float cs = rc[pos * 8 + i], sn = rsn[pos * 8 + i]; const float x1 = v[i], x2 = v[8 + i]; v[i] = x1 * cs - x2 * sn; v[8 + i] = x2 * cs + x1 * sn; }
#pragma unroll
            for (int i = 0; i < 8; ++i) { v4u w; w.x = pk2(v[8 * i], v[8 * i + 1]); w.y = pk2(v[8 * i + 2], v[8 * i + 3]); w.z = pk2(v[8 * i + 4], v[8 * i + 5]); w.w = pk2(v[8 * i + 6], v[8 * i + 7]); *(v4u*)(p + 8 * i) = w; }
            if (hh >= 16) { LAS float* kd = ks + (rl * 4 + (hh - 16)) * 64;
#pragma unroll
                for (int i = 0; i < 64; ++i) kd[i] = v[i]; }
        }
        __syncthreads();
        if (tid < 256) { float s = 0.f; for (int r = 0; r < 128; ++r) s += ks[r * 256 + tid]; kmp[(size_t)unit * 256 + tid] = s; }
        __syncthreads();
    }
}
__device__ __forceinline__ void moba_attn(CArgs* A, LAS unsigned char* lds, int G, const int bx, const int tid) {
    unsigned char* ws = A->ws; const int lane = tid & 63, wave = tid >> 6;
    const bf16* Q1 = (const bf16*)(ws + WS_Q1); const bf16* K1 = (const bf16*)(ws + WS_K1); const bf16* V1 = (const bf16*)(ws + WS_V1); const float* kmp = (const float*)(ws + WS_KMP);
    bf16* AO = (bf16*)(ws + WS_AO);
    LAS float* qs = (LAS float*)lds + wave * 1088; LAS float* ps = qs + 64;
    const int nitems = M * MB_H / NWAVES;
    for (int it = bx; it < nitems; it += G) {
        const int item = it * NWAVES + wave, row = item >> 4, h = item & 15, kvh = h >> 2, b = row >> 12, t = row & (SEQ - 1), qb = t >> 8;
        { const bf16 qv = Q1[(size_t)row * 1024 + h * 64 + lane]; qs[lane] = __builtin_bit_cast(float, (unsigned)qv << 16); }
        asm volatile("s_waitcnt lgkmcnt(0)" ::: "memory");
        float q[64];
#pragma unroll
        for (int i = 0; i < 16; ++i) { const f32x4 t4 = *(const LAS f32x4*)(qs + 4 * i); q[4 * i] = t4[0]; q[4 * i + 1] = t4[1]; q[4 * i + 2] = t4[2]; q[4 * i + 3] = t4[3]; }
        float gv = -INFINITY;
        if (lane < qb) { const float* k0 = kmp + (size_t)((b * 32 + 2 * lane) * 4 + kvh) * 64; const float* k1 = k0 + 256; float s = 0.f;
#pragma unroll
            for (int i = 0; i < 16; ++i) { const f32x4 a = *(const f32x4*)(k0 + 4 * i) + *(const f32x4*)(k1 + 4 * i); s += (q[4 * i] * a[0] + q[4 * i + 1] * a[1]) + (q[4 * i + 2] * a[2] + q[4 * i + 3] * a[3]); }
            gv = s; }
        int sel0 = 0, sel1 = 0, sel2 = 0;
#pragma unroll
        for (int r = 0; r < 3; ++r) { float mv = gv; int mi = lane;
#pragma unroll
            for (int o = 32; o >= 1; o >>= 1) { const float ov = shx(mv, o, lane); const int oi = shxi(mi, o, lane); if (ov > mv || (ov == mv && oi < mi)) { mv = ov; mi = oi; } }
            const int sr = __builtin_amdgcn_readfirstlane(mi); if (lane == sr) gv = -INFINITY;
            if (r == 0) sel0 = sr; else if (r == 1) sel1 = sr; else sel2 = sr; }
        const int nvalid = qb < 3 ? qb : 3;
        float mx = -INFINITY;
#pragma unroll 1
        for (int jj = 0; jj < 16; ++jj) {
            const int j = jj >> 2, i = jj & 3; const bool active = (j == 3) || (j < nvalid); const int nblk = j == 0 ? sel0 : (j == 1 ? sel1 : (j == 2 ? sel2 : qb));
            float sv = -INFINITY;
            if (active) { const int pos = nblk * 256 + i * 64 + lane; const bf16* kp = K1 + (size_t)(b * SEQ + pos) * 256 + kvh * 64; float d = 0.f;
#pragma unroll
                for (int e = 0; e < 8; ++e) { const v4u w = *(const v4u*)(kp + 8 * e);
                    d += q[8 * e] * bf_lo(w.x) + q[8 * e + 1] * bf_hi(w.x) + q[8 * e + 2] * bf_lo(w.y) + q[8 * e + 3] * bf_hi(w.y) + q[8 * e + 4] * bf_lo(w.z) + q[8 * e + 5] * bf_hi(w.z) + q[8 * e + 6] * bf_lo(w.w) + q[8 * e + 7] * bf_hi(w.w); }
                sv = d * 0.6931471805599453f; if (j == 3 && pos > t) sv = -INFINITY; }
            ps[jj * 64 + lane] = sv; mx = fmaxf(mx, sv);
        }
        mx = wave_max(mx, lane);
        float l = 0.f;
        float o[64];
#pragma unroll
        for (int i = 0; i < 64; ++i) o[i] = 0.f;
#pragma unroll 1
        for (int jj = 0; jj < 16; ++jj) {
            const int j = jj >> 2, i = jj & 3; const bool active = (j == 3) || (j < nvalid); const int nblk = j == 0 ? sel0 : (j == 1 ? sel1 : (j == 2 ? sel2 : qb));
            if (active) { const int pos = nblk * 256 + i * 64 + lane; const bf16* vp = V1 + (size_t)(b * SEQ + pos) * 256 + kvh * 64; const float p = __expf(ps[jj * 64 + lane] - mx); l += p;
#pragma unroll
                for (int e = 0; e < 8; ++e) { const v4u w = *(const v4u*)(vp + 8 * e);
                    o[8 * e] += p * bf_lo(w.x); o[8 * e + 1] += p * bf_hi(w.x); o[8 * e + 2] += p * bf_lo(w.y); o[8 * e + 3] += p * bf_hi(w.y); o[8 * e + 4] += p * bf_lo(w.z); o[8 * e + 5] += p * bf_hi(w.z); o[8 * e + 6] += p * bf_lo(w.w); o[8 * e + 7] += p * bf_hi(w.w); } }
        }
        l = wave_sum(l, lane);
#define RED_STEP(OFF, N) _Pragma("unroll") for (int i = 0; i < (N) / 2; ++i) { const bool up = (lane & (OFF)) != 0; const float send = up ? o[i] : o[i + (N) / 2]; const float keep = up ? o[i + (N) / 2] : o[i]; o[i] = keep + shx(send, OFF, lane); }
        RED_STEP(32, 64) RED_STEP(16, 32) RED_STEP(8, 16) RED_STEP(4, 8) RED_STEP(2, 4) RED_STEP(1, 2)
#undef RED_STEP
        AO[(size_t)row * 1024 + h * 64 + lane] = (bf16)f2bf(o[0] / l);
        asm volatile("s_waitcnt lgkmcnt(0)" ::: "memory");
    }
}

namespace mattn {
using bf16=__hip_bfloat16;
using bf16x8=__attribute__((ext_vector_type(8)))short;
using s16x4=__attribute__((ext_vector_type(4)))short;
using f32x16=__attribute__((ext_vector_type(16)))float;
using u32x4=__attribute__((ext_vector_type(4)))unsigned;
constexpr int BATCH=8,NHEAD=16,SEQ=4096,D=64,DM=NHEAD*D,KP=256;
constexpr int NW=8,QBLK=32,QB=QBLK*NW,KVBLK=64,NQB=SEQ/QB;
constexpr int ATTN_PITCH=DM, ATTN_UNIT_ROWS=QB;
__device__ __forceinline__ int crow(int r,int hi){return (r&3)+8*(r>>2)+4*hi;}
#define SBAR() __builtin_amdgcn_sched_barrier(0)
__device__ __forceinline__ void cmask(f32x16&p0,f32x16&p1,int jb,int qrel,int hi){
  const float NEG=-INFINITY; int kb=64*jb+4*hi;
  #pragma unroll
  for(int r=0;r<16;++r){int kv=kb+(r&3)+8*(r>>2); if(kv>qrel)p0[r]=NEG; if(kv+32>qrel)p1[r]=NEG;}
}

constexpr int NSLOT=3, SLOTB=8192;
constexpr int LDS_K=0, LDS_V=NSLOT*SLOTB, LDS_WS=2*NSLOT*SLOTB, LDS_OST=LDS_WS+NW*64*4, LDS_KM=LDS_OST+NW*4096, LDS_BYTES=LDS_KM+4096;
constexpr float C2=0.125f*1.4426950408889634f;
__device__ __forceinline__ void glds16(const void*sbase,unsigned voff,unsigned lds_dst){unsigned keep;
  asm volatile("s_nop 4\n\ts_mov_b32 %0, m0\n\ts_mov_b32 m0, %3\n\ts_nop 0\n\tglobal_load_lds_dwordx4 %1, %2\n\ts_mov_b32 m0, %0":"=&s"(keep):"v"(voff),"s"(sbase),"s"(lds_dst):"memory");}
__device__ __forceinline__ float max3f(float a,float b,float c){float r;asm("v_max3_f32 %0, %1, %2, %3":"=v"(r):"v"(a),"v"(b),"v"(c));return r;}
__device__ __forceinline__ float max2f(float a,float b){float r;asm("v_max_f32_e32 %0, %1, %2":"=v"(r):"v"(a),"v"(b));return r;}
__device__ __forceinline__ float fadd_s(float a,float b){float r;asm("v_add_f32_e32 %0, %1, %2":"=v"(r):"v"(a),"v"(b));return r;}
__device__ __forceinline__ float fsub_s(float a,float b){float r;asm("v_sub_f32_e32 %0, %1, %2":"=v"(r):"v"(a),"v"(b));return r;}
typedef float f32x2_t __attribute__((ext_vector_type(2))); typedef __bf16 bf16x2_t __attribute__((ext_vector_type(2)));
__device__ __forceinline__ unsigned cvtpk_s(float lo,float hi){f32x2_t v={lo,hi};bf16x2_t b=__builtin_convertvector(v,bf16x2_t);return __builtin_bit_cast(unsigned,b);}
#define WAIT_BAR(N) asm volatile("s_waitcnt vmcnt(" #N ") lgkmcnt(0)\n\ts_barrier":::"memory")

__device__ __forceinline__ void qkt(f32x16&p0,f32x16&p1,const char*Kslot,const bf16x8*qr,const f32x16&negm,int r32,int hi){
  const char*kb=Kslot+hi*1024+r32*16;
  #pragma unroll
  for(int d0=0;d0<4;++d0){
    const bf16x8 b0=*reinterpret_cast<const bf16x8*>(kb+d0*2048);
    const bf16x8 b1=*reinterpret_cast<const bf16x8*>(kb+d0*2048+512);
    if(d0==0){p0=__builtin_amdgcn_mfma_f32_32x32x16_bf16(b0,qr[0],negm,0,0,0);p1=__builtin_amdgcn_mfma_f32_32x32x16_bf16(b1,qr[0],negm,0,0,0);}
    else{p0=__builtin_amdgcn_mfma_f32_32x32x16_bf16(b0,qr[d0],p0,0,0,0);p1=__builtin_amdgcn_mfma_f32_32x32x16_bf16(b1,qr[d0],p1,0,0,0);}}
}
typedef __attribute__((address_space(3))) const char* lds_cptr;
typedef short v4i16_t __attribute__((ext_vector_type(4)));
__device__ __forceinline__ void kload8(bf16x8*kf,lds_cptr kp){
  kf[0]=*(const __attribute__((address_space(3))) bf16x8*)(kp);      kf[1]=*(const __attribute__((address_space(3))) bf16x8*)(kp+512);
  kf[2]=*(const __attribute__((address_space(3))) bf16x8*)(kp+2048); kf[3]=*(const __attribute__((address_space(3))) bf16x8*)(kp+2560);
  kf[4]=*(const __attribute__((address_space(3))) bf16x8*)(kp+4096); kf[5]=*(const __attribute__((address_space(3))) bf16x8*)(kp+4608);
  kf[6]=*(const __attribute__((address_space(3))) bf16x8*)(kp+6144); kf[7]=*(const __attribute__((address_space(3))) bf16x8*)(kp+6656);
}
__device__ __forceinline__ void kload2(bf16x8*kf,lds_cptr kp,int j){ kf[2*j]=*(const __attribute__((address_space(3))) bf16x8*)(kp+j*2048); kf[2*j+1]=*(const __attribute__((address_space(3))) bf16x8*)(kp+j*2048+512); }
__device__ __forceinline__ s16x4 vtr(lds_cptr p){ return __builtin_bit_cast(s16x4,__builtin_amdgcn_ds_read_tr16_b64_v4i16((__attribute__((address_space(3))) v4i16_t*)p)); }
__device__ __forceinline__ float rowmax(const f32x16&p0,const f32x16&p1){
  float a=max3f(p0[0],p0[1],p1[0]),b=max3f(p0[2],p0[3],p1[1]);a=max3f(a,p1[2],p1[3]);
  #pragma unroll
  for(int r=4;r<16;r+=4){a=max3f(a,p0[r],p0[r+1]);b=max3f(b,p0[r+2],p0[r+3]);a=max3f(a,p1[r],p1[r+1]);b=max3f(b,p1[r+2],p1[r+3]);}
  const float m=max2f(a,b);
  auto rr=__builtin_amdgcn_permlane32_swap(__float_as_uint(m),__float_as_uint(m),false,false);
  return max2f(__uint_as_float(rr[0]),__uint_as_float(rr[1]));
}
__device__ __forceinline__ void pv(f32x16*o,int vb,bf16x8 pa0,bf16x8 pa1,bf16x8 pa2,bf16x8 pa3){
  #pragma unroll
  for(int d0=0;d0<2;++d0){s16x4 lo[4],hi[4];
    #pragma unroll
    for(int ks=0;ks<4;++ks){
      asm volatile("ds_read_b64_tr_b16 %0,%1 offset:%c2":"=&v"(lo[ks]):"v"(vb),"i"(d0*4096+ks*1024):"memory");
      asm volatile("ds_read_b64_tr_b16 %0,%1 offset:%c2":"=&v"(hi[ks]):"v"(vb),"i"(d0*4096+ks*1024+512):"memory");}
    asm volatile("s_waitcnt lgkmcnt(0)":::"memory");SBAR();
    #define PK(k) (bf16x8){lo[k][0],lo[k][1],lo[k][2],lo[k][3],hi[k][0],hi[k][1],hi[k][2],hi[k][3]}
    o[d0]=__builtin_amdgcn_mfma_f32_32x32x16_bf16(pa0,PK(0),o[d0],0,0,0);
    o[d0]=__builtin_amdgcn_mfma_f32_32x32x16_bf16(pa1,PK(1),o[d0],0,0,0);
    o[d0]=__builtin_amdgcn_mfma_f32_32x32x16_bf16(pa2,PK(2),o[d0],0,0,0);
    o[d0]=__builtin_amdgcn_mfma_f32_32x32x16_bf16(pa3,PK(3),o[d0],0,0,0);
    #undef PK
  }
}

#ifndef ATTN_STORE16
#define ATTN_STORE16(p,v) (*(u32x4*)(p)=(v))
#endif
__device__ __forceinline__ void attn_unit(int b,int h,int qb,const bf16*Q,const bf16*__restrict__ K,const bf16*__restrict__ V,bf16*O,char*shm,const float*kmsum,const float mref,const int tid){
  const int lane=tid&63,r32=lane&31,hi=lane>>5; const int wid=__builtin_amdgcn_readfirstlane(tid>>6);
  const long rowbase=(long)b*SEQ; const int q0=qb*QB;
  const bf16*Qw=Q+(rowbase+q0+wid*QBLK)*DM+h*D;
  const bf16*Kh=K+rowbase*KP+(h>>2)*D,*Vh=V+rowbase*KP+(h>>2)*D;
  const lds_cptr shm3=(lds_cptr)shm;
  const unsigned lds0=(unsigned)(uintptr_t)shm;
  float*wsf=(float*)(shm+LDS_WS)+wid*64;
  const unsigned kvoff=(unsigned)(lane*KP+wid*8)*2u;
  const unsigned vvoff=(unsigned)((16*(wid&3)+(lane>>2))*KP+(wid>>2)*32+(lane&3)*8)*2u;
  const unsigned kdst=lds0+LDS_K+wid*1024, vdst=lds0+LDS_V+wid*1024;
  #define DMA_K(t,slot) glds16(Kh+(long)(t)*KVBLK*KP,kvoff,(unsigned)__builtin_amdgcn_readfirstlane(kdst+(slot)))
  #define DMA_V(t,slot) glds16(Vh+(long)(t)*KVBLK*KP,vvoff,(unsigned)__builtin_amdgcn_readfirstlane(vdst+(slot)))
  const int vb0=(int)(lds0+LDS_V)+((lane>>4)&1)*32+(lane&3)*8+(4*hi+((lane&15)>>2))*64;
  const char*Kbase=shm+LDS_K; bf16x8 kf[8];
  const lds_cptr kp0=shm3+LDS_K+hi*1024+r32*16; const lds_cptr vp0=shm3+LDS_V+((lane>>4)&1)*32+(lane&3)*8+(4*hi+((lane&15)>>2))*64;
  const int NT=(q0+QB)/KVBLK;
  typedef __attribute__((address_space(3))) float ldsf;
  { ldsf*km=(ldsf*)(shm3+LDS_KM); const float*ks0=kmsum+((size_t)b*32*4+(h>>2))*64;
    #pragma unroll
    for(int i=0;i<2;++i){const int idx=tid+512*i,n=idx>>6,d=idx&63; km[idx]=ks0[(size_t)(2*n)*256+d]+ks0[(size_t)(2*n+1)*256+d];}
    asm volatile("s_waitcnt vmcnt(0) lgkmcnt(0)\n\ts_barrier":::"memory"); }
  DMA_K(0,0);DMA_V(0,0);DMA_K(1,SLOTB);
  bf16x8 qr[4];
  #pragma unroll
  for(int d0=0;d0<4;++d0)qr[d0]=*reinterpret_cast<const bf16x8*>(&Qw[(long)r32*DM+d0*16+hi*8]);
  unsigned selm=1u<<qb;
  if(qb>0){
    float qf[32];
    #pragma unroll
    for(int d0=0;d0<4;++d0)
      #pragma unroll
      for(int j=0;j<8;++j)qf[8*d0+j]=__uint_as_float(((unsigned)(unsigned short)qr[d0][j])<<16);
    float g[15];
    const ldsf*kmr=(const ldsf*)(shm3+LDS_KM)+8*hi;
    #pragma unroll
    for(int n=0;n<15;++n){ g[n]=-INFINITY;
      if(n<qb){ float a=0.f;
        #pragma unroll
        for(int d0=0;d0<4;++d0)
          #pragma unroll
          for(int j=0;j<8;++j)a+=qf[8*d0+j]*kmr[n*64+16*d0+j];
        auto rr=__builtin_amdgcn_permlane32_swap(__float_as_uint(a),__float_as_uint(a),false,false);
        g[n]=__uint_as_float(rr[0])+__uint_as_float(rr[1]); } }
    #pragma unroll
    for(int r=0;r<3;++r){ float best=-INFINITY; int bi=0;
      #pragma unroll
      for(int n=0;n<15;++n)if(g[n]>best){best=g[n];bi=n;}
      if(best>-INFINITY)selm|=1u<<bi;
      #pragma unroll
      for(int n=0;n<15;++n)g[n]=(n==bi)?-INFINITY:g[n]; }
  }
  float l_reg=0.f;f32x16 o[2];o[0]=f32x16{};o[1]=f32x16{};f32x16 negm;
  #define SETNEG(t) do{ const float v_=((selm>>((t)>>2))&1u)?-mref:-INFINITY; _Pragma("unroll") for(int r=0;r<16;++r)negm[r]=v_; asm volatile("":"+v"(negm)); }while(0)
  SETNEG(0);
  const int qrel=wid*QBLK+r32;
  #define CMASK(P0,P1,t) do{int jb_=(t)-(NT-4); if(jb_>=0)cmask(P0,P1,jb_,qrel,hi);}while(0)
  #define START(P0,P1) do{ _Pragma("unroll") for(int r=0;r<16;++r)P0[r]=__builtin_amdgcn_exp2f(P0[r]); }while(0)
  #define RESC() do{}while(0)
  f32x16 pA0,pA1,pB0,pB1;
  int sl_prev=0,sl_cur=0,sl_next=SLOTB;
  #define ROT() do{sl_prev=sl_cur;sl_cur=sl_next;sl_next=(sl_next==(NSLOT-1)*SLOTB)?0:sl_next+SLOTB;}while(0)
  DMA_K(2,2*SLOTB);
  WAIT_BAR(3);
  qkt(pA0,pA1,Kbase,qr,negm,r32,hi);asm volatile("s_nop 15\n\ts_nop 7":"+v"(pA0),"+v"(pA1));CMASK(pA0,pA1,0);
  START(pA0,pA1);
  _Pragma("unroll") for(int r=0;r<16;++r)pA1[r]=__builtin_amdgcn_exp2f(pA1[r]);
  WAIT_BAR(0);
  DMA_K(3,0);DMA_V(1,SLOTB);
  ROT();
  kload8(kf,kp0+sl_cur);
  WAIT_BAR(2);
  s16x4 vlo[8],vhi[8]; u32x4 pw0,pw1,pw2,pw3;
  #define PKW(P,B) cvtpk_s(P[B],P[B+1])
  #define PAF(k) __builtin_bit_cast(bf16x8,pw##k)
  #define VFR(i) (bf16x8){vlo[i][0],vlo[i][1],vlo[i][2],vlo[i][3],vhi[i][0],vhi[i][1],vhi[i][2],vhi[i][3]}
  #define PIN(x) asm volatile("":"+v"(x))
  #define MX3(a,b,c) __builtin_fmaxf(__builtin_fmaxf((a),(b)),(c))
  #define GAPA(MF,A0,A1,A2,A3,W0,W1,PW) do{ MF; sacc+=A0; sacc+=A1; sacc+=A2; sacc+=A3; PIN(sacc); W0; W1; PIN(PW); SBAR(); }while(0)
  #define EX(v) __builtin_amdgcn_exp2f(v)
  #define GAPB(MF,X,B) do{ MF; X[B]=EX(X[B]); X[B+1]=EX(X[B+1]); X[B+2]=EX(X[B+2]); X[B+3]=EX(X[B+3]); PIN(X); SBAR(); }while(0)
  #define VRD(i) do{ vlo[i]=vtr(vp_+(((i)>>2)*4096+((i)&3)*1024)); vhi[i]=vtr(vp_+(((i)>>2)*4096+((i)&3)*1024+512)); }while(0)
  #define KRD(G,j) do{ if(G){ kload2(kf,kp0+sl_next,j); SBAR(); } }while(0)
  #define STEP(C0,C1,P0,P1,t,GK,GV,GL) do{ if((((t))&3)==0){SETNEG(t);} SBAR(); \
    const lds_cptr vp_=vp0+sl_prev; \
    VRD(0); SBAR(); float sacc=(P0[0]+P0[1]); \
    GAPA(C0=__builtin_amdgcn_mfma_f32_32x32x16_bf16(kf[0],qr[0],negm,0,0,0), P0[2],P0[3],P0[4],P0[5],     pw0[0]=PKW(P0,0), pw0[1]=PKW(P0,2), pw0); \
    VRD(4); SBAR(); GAPA(C1=__builtin_amdgcn_mfma_f32_32x32x16_bf16(kf[1],qr[0],negm,0,0,0), P0[6],P0[7],P0[8],P0[9],     pw0[2]=PKW(P0,4), pw0[3]=PKW(P0,6), pw0); \
    VRD(1); SBAR(); GAPA(C0=__builtin_amdgcn_mfma_f32_32x32x16_bf16(kf[2],qr[1],C0,0,0,0),   P0[10],P0[11],P0[12],P0[13], pw1[0]=PKW(P0,8), pw1[1]=PKW(P0,10), pw1); \
    VRD(5); SBAR(); GAPA(C1=__builtin_amdgcn_mfma_f32_32x32x16_bf16(kf[3],qr[1],C1,0,0,0),   P0[14],P0[15],P1[0],P1[1],   pw1[2]=PKW(P0,12),pw1[3]=PKW(P0,14), pw1); \
    VRD(2); SBAR(); GAPA(C0=__builtin_amdgcn_mfma_f32_32x32x16_bf16(kf[4],qr[2],C0,0,0,0),   P1[2],P1[3],P1[4],P1[5],     pw2[0]=PKW(P1,0), pw2[1]=PKW(P1,2), pw2); \
    VRD(6); SBAR(); GAPA(C1=__builtin_amdgcn_mfma_f32_32x32x16_bf16(kf[5],qr[2],C1,0,0,0),   P1[6],P1[7],P1[8],P1[9],     pw2[2]=PKW(P1,4), pw2[3]=PKW(P1,6), pw2); \
    VRD(3); SBAR(); GAPA(C0=__builtin_amdgcn_mfma_f32_32x32x16_bf16(kf[6],qr[3],C0,0,0,0),   P1[10],P1[11],P1[12],P1[13], pw3[0]=PKW(P1,8), pw3[1]=PKW(P1,10), pw3); \
    VRD(7); SBAR(); GAPA(C1=__builtin_amdgcn_mfma_f32_32x32x16_bf16(kf[7],qr[3],C1,0,0,0),   P1[14],P1[15],0.f,0.f,       pw3[2]=PKW(P1,12),pw3[3]=PKW(P1,14), pw3); \
    l_reg+=sacc; \
    if(GK){DMA_K((t)+3,sl_cur);} if(GV){DMA_V((t)+1,sl_next);} \
    CMASK(C0,C1,t); \
    SBAR(); \
    GAPB(o[0]=__builtin_amdgcn_mfma_f32_32x32x16_bf16(PAF(0),VFR(0),o[0],0,0,0), C0,0); \
    GAPB(o[1]=__builtin_amdgcn_mfma_f32_32x32x16_bf16(PAF(0),VFR(4),o[1],0,0,0), C0,4); \
    KRD(GL,0); GAPB(o[0]=__builtin_amdgcn_mfma_f32_32x32x16_bf16(PAF(1),VFR(1),o[0],0,0,0), C0,8); \
    KRD(GL,1); GAPB(o[1]=__builtin_amdgcn_mfma_f32_32x32x16_bf16(PAF(1),VFR(5),o[1],0,0,0), C0,12); \
    KRD(GL,2); GAPB(o[0]=__builtin_amdgcn_mfma_f32_32x32x16_bf16(PAF(2),VFR(2),o[0],0,0,0), C1,0); \
    KRD(GL,3); GAPB(o[1]=__builtin_amdgcn_mfma_f32_32x32x16_bf16(PAF(2),VFR(6),o[1],0,0,0), C1,4); \
    GAPB(o[0]=__builtin_amdgcn_mfma_f32_32x32x16_bf16(PAF(3),VFR(3),o[0],0,0,0), C1,8); \
    GAPB(o[1]=__builtin_amdgcn_mfma_f32_32x32x16_bf16(PAF(3),VFR(7),o[1],0,0,0), C1,12); \
    }while(0)
  int t=1;
  #undef CMASK
  #define CMASK(P0,P1,t) do{}while(0)
  for(;t+5<NT;t+=2){
    STEP(pB0,pB1,pA0,pA1,t,true,true,true);     WAIT_BAR(2); RESC(); ROT();
    STEP(pA0,pA1,pB0,pB1,t+1,true,true,true);   WAIT_BAR(2); RESC(); ROT();
  }
  #undef CMASK
  #define CMASK(P0,P1,t) do{int jb_=(t)-(NT-4); if(jb_>=0)cmask(P0,P1,jb_,qrel,hi);}while(0)
  #define ENDW(tt) do{ if((tt)+3<NT){WAIT_BAR(2);} else if((tt)+2<NT){WAIT_BAR(1);} else {WAIT_BAR(0);} }while(0)
  for(;t+1<NT;t+=2){
    STEP(pB0,pB1,pA0,pA1,t,(t+3<NT),(t+1<NT),(t+1<NT));       ENDW(t);   RESC(); ROT();
    STEP(pA0,pA1,pB0,pB1,t+1,(t+4<NT),(t+2<NT),(t+2<NT));     ENDW(t+1); RESC(); ROT();
  }
  STEP(pB0,pB1,pA0,pA1,NT-1,false,false,false); RESC();
  { float sacc=pB0[0]+pB0[1]; _Pragma("unroll") for(int r=2;r<16;++r)sacc+=pB0[r]; _Pragma("unroll") for(int r=0;r<16;++r)sacc+=pB1[r]; l_reg+=sacc;
    pw0=(u32x4){PKW(pB0,0),PKW(pB0,2),PKW(pB0,4),PKW(pB0,6)};pw1=(u32x4){PKW(pB0,8),PKW(pB0,10),PKW(pB0,12),PKW(pB0,14)};pw2=(u32x4){PKW(pB1,0),PKW(pB1,2),PKW(pB1,4),PKW(pB1,6)};pw3=(u32x4){PKW(pB1,8),PKW(pB1,10),PKW(pB1,12),PKW(pB1,14)};
    SBAR(); pv(o,vb0+sl_cur,PAF(0),PAF(1),PAF(2),PAF(3)); }
  #undef PKW
  #undef PAF
  #undef VFR
  #undef PIN
  #undef MX3
  #undef GAPA
  #undef GAPB
  #undef EX
  #undef VRD
  #undef KRD
  #undef STEP
  #undef ENDW
  {auto rr=__builtin_amdgcn_permlane32_swap(__float_as_uint(l_reg),__float_as_uint(l_reg),false,false);l_reg=__uint_as_float(rr[0])+__uint_as_float(rr[1]);}
  if(hi==0)wsf[32+r32]=l_reg;asm volatile("s_waitcnt lgkmcnt(0)":::"memory");
  float rli[16];
  #pragma unroll
  for(int r=0;r<16;++r)rli[r]=__builtin_amdgcn_rcpf(wsf[32+crow(r,hi)]);
  bf16*Ow=O+(rowbase+q0+wid*QBLK)*DM+h*D;
  { bf16*stg=(bf16*)(shm+LDS_OST)+wid*2048;
    #pragma unroll
    for(int r=0;r<16;++r){const int orow=crow(r,hi);
      #pragma unroll
      for(int d0=0;d0<2;++d0)stg[orow*64+d0*32+r32]=__float2bfloat16(o[d0][r]*rli[r]);}
    asm volatile("s_waitcnt lgkmcnt(0)":::"memory");
    #pragma unroll
    for(int i=0;i<4;++i){const int row=i*8+(lane>>3),ch=lane&7; const u32x4 v=*(const u32x4*)(stg+row*64+ch*8); ATTN_STORE16(Ow+(long)row*DM+ch*8,v);} }
  asm volatile("s_waitcnt lgkmcnt(0)\n\ts_barrier":::"memory");
  #undef DMA_K
  #undef DMA_V
  #undef CMASK
  #undef START
  #undef SETNEG
  #undef RESC
  #undef ROT
}
constexpr int ATTN_LDS_BYTES=LDS_BYTES;
struct AttnTensors { const bf16* Q; const bf16* K; const bf16* V; bf16* O; const float* kmsum; };
struct AttnUnit { int bh; int qb; };
struct StaticOrder {
  int vcu, G;
  __device__ __forceinline__ StaticOrder(int grid,int vc):vcu(vc),G(grid){}
  __device__ __forceinline__ bool next(int i,AttnUnit&u)const{ const int uu=vcu+i*G; if(uu>=2048)return false; const int v=uu&255,ii=uu>>8,hf=v&1,j=ii>>1; u.bh=v>>1; u.qb=(ii&1)?15-2*j-hf:2*j+hf; return true; }
};
__device__ __forceinline__ void attn_phase(char*lds,const AttnTensors&T,const StaticOrder&S,const float mref,const int tid){
  AttnUnit u;
  for(int i=0;S.next(i,u);++i){ attn_unit(u.bh/NHEAD,u.bh%NHEAD,u.qb,T.Q,T.K,T.V,T.O,lds,T.kmsum,mref,tid); }
}
#undef SBAR
#undef WAIT_BAR
}

constexpr int N_PHASES = 18;
#define PHASE_TID() unsigned ones_ = ones; asm volatile("" : "+s"(ones_)); const int tid = (wave_s << 6) | (int)__builtin_amdgcn_mbcnt_hi(ones_, __builtin_amdgcn_mbcnt_lo(ones_, 0u));
__device__ __forceinline__ void run_phase(const int ph, CArgs* ap, LAS unsigned char* lds, const int G, const int bx, const int wave_s, const unsigned ones) {
    const int vcu = (G % 8 == 0) ? (bx % 8) * (G / 8) + bx / 8 : bx;
    CArgs* A = ap;
    unsigned char* ws = A->ws;
    const int l = ph >= 10 ? 1 : 0;
    bf16* HB0 = (bf16*)(ws + WS_HB); bf16* HB1 = (bf16*)(ws + WS_HB2); float* SSQ0 = (float*)(ws + WS_SSQ); float* SSQ1 = SSQ0 + (size_t)M * 16;
    bf16* HBl = l ? HB1 : HB0; bf16* HBo = l ? HB0 : HB1; float* SSQl = l ? SSQ1 : SSQ0; float* SSQo = l ? SSQ0 : SSQ1;
    float* OUT = A->out;
    switch (ph) {
    case 0: { PHASE_TID() p0_prologue(A, lds, G, vcu, wave_s, tid & 63); } break;
    case 1: { PHASE_TID() pg8::Gemm g{HB0, (const bf16*)(ws + WS_WIN), M, ML_INP, D}; pg8::StaticOrder S; S.init(M, ML_INP, G, bx);
        EpiMl E{ws, (float*)(ws + WS_GATES), SSQ0, A->in[4]};
        pg8::gemm_phase<EpiMl, pg8::StaticOrder, true, true>(lds, g, S, E, tid); } break;
    case 2: { PHASE_TID()
#if defined(ML_NAIVE_A)
        mlstm_a(A, lds, G, bx, tid);
#else
        ml::phase_a(A, lds, G, bx, tid);
#endif
        } break;
    case 3: { PHASE_TID() ml::phase_scan(A, G, bx, tid); } break;
    case 4: { PHASE_TID()
#if defined(ML_NAIVE_C)
        mlstm_c(A, lds, G, bx, tid);
#else
        ml::phase_c(A, lds, G, bx, tid);
#endif
        } break;
    case 5: { PHASE_TID() pg8::Gemm g{(const bf16*)(ws + WS_V0), (const bf16*)(ws + WS_WOUT), M, D, D}; pg8::StaticOrder S; S.init(M, D, G, bx);
        EpiRes E{A->in[0], OUT, HB0, SSQ0};
        pg8::gemm_phase<EpiRes, pg8::StaticOrder, true, true>(lds, g, S, E, tid); } break;
    case 10: { PHASE_TID() pg8::Gemm g{HB1, (const bf16*)(ws + WS_WQKV1), M, 1536, D}; pg8::StaticOrder S; S.init(M, 1536, G, bx);
        EpiQkv1 E{ws, SSQ1};
        pg8::gemm_phase<EpiQkv1, pg8::StaticOrder, true, true>(lds, g, S, E, tid); } break;
    case 11: { PHASE_TID() moba_fixup(A, lds, G, bx, tid); } break;
    case 12: { PHASE_TID()
#if defined(MOBA_NAIVE)
        moba_attn(A, lds, G, bx, tid);
#else
        const mattn::AttnTensors AT{(const mattn::bf16*)(ws + WS_Q1), (const mattn::bf16*)(ws + WS_K1), (const mattn::bf16*)(ws + WS_V1), (mattn::bf16*)(ws + WS_AO), (const float*)(ws + WS_KMP)};
        const mattn::StaticOrder S(G, vcu);
        float mref; { const int lane = tid & 63; const float gq = wave_max(fabsf(A->in[11][lane]), lane), gk = wave_max(fabsf(A->in[9][lane]), lane);
            mref = __builtin_bit_cast(float, __builtin_amdgcn_readfirstlane(__builtin_bit_cast(int, 64.0f * 0.125f * 1.4426950408889634f * gq * gk))); }
        mattn::attn_phase((char*)lds, AT, S, mref, tid);
#endif
        } break;
    case 13: case 7: case 15: {
        PHASE_TID() const bool dn = ph != 13;
        pg8::Gemm g{(const bf16*)(ws + (dn ? WS_ACT : WS_AO)), (const bf16*)(ws + (dn ? WS_WDN + l * 6 * MiB : WS_WO1)), M, D, dn ? FF : D}; pg8::StaticOrder S; S.init(M, D, G, bx);
        EpiRes E{OUT, OUT, HBl, SSQl};
        pg8::gemm_phase<EpiRes, pg8::StaticOrder, true, true>(lds, g, S, E, tid); } break;
    case 6: case 14: { PHASE_TID() pg8::Gemm g{HBl, (const bf16*)(ws + WS_WGU + l * 11 * MiB), M, 2 * FF, D}; pg8::StaticOrder S; S.init(M, 2 * FF, G, bx);
        EpiSwiglu E{(bf16*)(ws + WS_ACT), SSQl};
        pg8::gemm_phase<EpiSwiglu, pg8::StaticOrder, true, true>(lds, g, S, E, tid); } break;
    case 8: case 16: { PHASE_TID() pg8::Gemm g{(const bf16*)(ws + WS_PB) + (size_t)l * M * PLE, (const bf16*)(ws + WS_WPU + l * (MiB / 2)), M, D, PLE}; pg8::StaticOrder S; S.init(M, D, G, bx);
        EpiPlain E{(bf16*)(ws + WS_UP), D};
        pg8::gemm_phase<EpiPlain, pg8::StaticOrder, true, true>(lds, g, S, E, tid); } break;
    case 9: case 17: { PHASE_TID() pg8::Gemm g{HBl, (const bf16*)(ws + WS_WPG + l * 2 * MiB), M, D, D}; pg8::StaticOrder S; S.init(M, D, G, bx);
        EpiPle E{OUT, OUT, HBo, SSQo, SSQl, (const bf16*)(ws + WS_UP)};
        pg8::gemm_phase<EpiPle, pg8::StaticOrder, true, true>(lds, g, S, E, tid); } break;
    default: break;
    }
}
#ifndef PHASE_MASK
#define PHASE_MASK 0xFFFFFFFFu
#endif
__global__ void __launch_bounds__(NTHREADS, 2) yoco_fwd(Args args) {
    extern __shared__ __attribute__((aligned(16))) unsigned char lds_raw[];
    LAS unsigned char* lds = (LAS unsigned char*)lds_raw;
    volatile LAS unsigned* MISC = (volatile LAS unsigned*)(lds + LDSCTL_OFF);
    for (int u = threadIdx.x; u < (LDS_BYTES - LDSCTL_OFF) / 4; u += NTHREADS) ((LAS unsigned*)(lds + LDSCTL_OFF))[u] = 0u;
    __syncthreads();
    XcdBarrier bar; bar.bar = (unsigned*)(args.ws + WS_CTL) + 4096; bar.x = 0; bar.st = nullptr;
    if (MK_N_LAUNCHES == 1) bar = xcd_barrier_post((unsigned*)(args.ws + WS_CTL) + 4096, MISC + 8);
    const int lo = args.ph_lo, hi = args.ph_hi;
    const int wave_s = __builtin_amdgcn_readfirstlane(threadIdx.x >> 6);
#pragma unroll 1
    for (int ph = lo; ph < hi; ++ph) {
        CArgs* ap = (CArgs*)__builtin_amdgcn_kernarg_segment_ptr(); unsigned ones = ~0u; int G = gridDim.x, bx = blockIdx.x;
        asm volatile("" : "+s"(ap), "+s"(ones), "+s"(G), "+s"(bx));
        if ((PHASE_MASK >> ph) & 1u) run_phase(ph, ap, lds, G, bx, wave_s, ones);
        if (ph + 1 < hi) { XcdBarrier b2 = bar; asm volatile("" : "+s"(b2.bar)); xcd_barrier(b2); }
    }
}

extern "C" void kernel_launch(void* const* d_in, const int* in_sizes, int n_in, void* d_out, int out_size, void* d_ws, size_t ws_size, hipStream_t stream) {
    static int grid = 0;
    if (grid == 0) {
        if (n_in != 19 || in_sizes[0] != M * D || out_size != M * D || ws_size < WS_END) { fprintf(stderr, "kernel_launch: unexpected shapes (n_in %d, in0 %d, out %d, ws %zu); nothing launched\n", n_in, n_in > 0 ? in_sizes[0] : -1, out_size, ws_size); grid = -1; return; }
        int dev = 0, cus = 0, per_cu = 0;
        if (hipGetDevice(&dev) != hipSuccess || hipDeviceGetAttribute(&cus, hipDeviceAttributeMultiprocessorCount, dev) != hipSuccess) { grid = -1; return; }
        if (hipFuncSetAttribute((const void*)yoco_fwd, hipFuncAttributeMaxDynamicSharedMemorySize, LDS_BYTES) != hipSuccess) { fprintf(stderr, "kernel_launch: hipFuncSetAttribute failed\n"); grid = -1; return; }
        if (hipOccupancyMaxActiveBlocksPerMultiprocessor(&per_cu, (const void*)yoco_fwd, NTHREADS, LDS_BYTES) != hipSuccess || per_cu < 1) { fprintf(stderr, "kernel_launch: occupancy query says %d blocks per CU\n", per_cu); per_cu = 1; }
        (void)hipGetLastError();
        grid = cus;
    }
    if (grid < 0) return;
    (void)hipMemsetAsync((char*)d_ws + WS_CTL, 0, CTL_ZERO_BYTES, stream);
    Args a{};
    for (int i = 0; i < 19; ++i) a.in[i] = (const float*)d_in[i];
    a.out = (float*)d_out; a.ws = (unsigned char*)d_ws;
    if (MK_N_LAUNCHES == 1) {
        a.ph_lo = 0; a.ph_hi = N_PHASES;
        hipLaunchKernelGGL(yoco_fwd, dim3(grid), dim3(NTHREADS), LDS_BYTES, stream, a);
    } else {
        for (int p = 0; p < N_PHASES; ++p) { a.ph_lo = p; a.ph_hi = p + 1; hipLaunchKernelGGL(yoco_fwd, dim3(grid), dim3(NTHREADS), LDS_BYTES, stream, a); }
    }
}
```

```cpp
#include <hip/hip_runtime.h>
#include <hip/hip_bf16.h>
#include <cstdio>
#include <cstdint>

#ifndef SIDE_JOBS
#define SIDE_JOBS 1
#endif
#ifndef MK_N_LAUNCHES
#define MK_N_LAUNCHES 1
#endif

#define LAS __attribute__((address_space(3)))
#define GAS __attribute__((address_space(1)))

#ifndef SSQ_INLOOP
#define SSQ_INLOOP 0
#endif
namespace pg8 {
#define PG8_LAS __attribute__((address_space(3)))
typedef unsigned short bf16_t;
typedef short bf16x8 __attribute__((ext_vector_type(8)));
typedef float f32x4 __attribute__((ext_vector_type(4)));
typedef unsigned u32x4 __attribute__((ext_vector_type(4)));
typedef unsigned u32x2 __attribute__((ext_vector_type(2)));
constexpr int BM = 256, BK = 64, HALF = 128, HTB = HALF * BK * 2, STAGE_BYTES = 8 * HTB, NXCD = 8, WGM = 8;

__host__ __device__ __forceinline__ int lds_byte(int r, int c) { const int st = (r >> 4) * 2 + (c >> 5), rr = r & 15, cc = c & 31, ob = rr * 64 + cc * 2; return st * 1024 + (ob ^ (((ob >> 9) & 1) << 5)); }
__host__ __device__ __forceinline__ void stage_rc(int b, int& R, int& C) { const int st = b / 1024, sb = b % 1024, swz = sb ^ (((sb >> 9) & 1) << 5); R = (st >> 1) * 16 + swz / 64; C = (st & 1) * 32 + (swz % 64) / 2; }
__host__ __device__ __forceinline__ int perm32(int rho) { const int n = rho >> 4, i = rho & 15; return 8 * (i >> 2) + 4 * n + (i & 3); }

struct Unit { int pm, pn; };
struct Gemm { const bf16_t* A; const bf16_t* Bt; int M, N, K; const float* ssq; };

struct StaticOrder {
    int nM, nN, nwg, G, c;
    __host__ __device__ void init(int M, int N, int G_, int c_) { nM = M / BM; nN = N / BM; nwg = nM * nN; G = G_; c = c_; }
    __host__ __device__ bool next(int i, Unit& u) const {
        const long L = (long)i * G + c; if (L >= nwg) return false;
        int wgid = (int)L; { const int q = nwg / NXCD, r = nwg % NXCD, xcd = wgid % NXCD, off = wgid / NXCD; wgid = (xcd < r ? xcd * (q + 1) : r * (q + 1) + (xcd - r) * q) + off; }
        const int nig = WGM * nN, gid = wgid / nig, fm = gid * WGM, gsz = (nM % WGM == 0) ? WGM : ((nM - fm) < WGM ? (nM - fm) : WGM);
        u.pm = fm + ((wgid % nig) % gsz); u.pn = (wgid % nig) / gsz; return true;
    }
    __device__ __forceinline__ void a_ready(const Unit&) const {}
    __device__ __forceinline__ void done(const Unit&) const {}
};

typedef float f32x2_t __attribute__((ext_vector_type(2))); typedef __bf16 bf16x2_t __attribute__((ext_vector_type(2)));
__device__ __forceinline__ unsigned cvt_pk_bf16(float lo, float hi) { f32x2_t v = {lo, hi}; bf16x2_t b = __builtin_convertvector(v, bf16x2_t); return __builtin_bit_cast(unsigned, b); }

static_assert(true, "");
__device__ __forceinline__ float dot2sq(unsigned w, float acc) { typedef __bf16 bfx2 __attribute__((ext_vector_type(2))); const bfx2 v = __builtin_bit_cast(bfx2, w); return __builtin_amdgcn_fdot2_f32_bf16(v, v, acc, false); }
__device__ __forceinline__ float shx16(float v, int lane) { return __builtin_bit_cast(float, __builtin_amdgcn_ds_bpermute((lane ^ 16) << 2, __builtin_bit_cast(int, v))); }
__device__ __forceinline__ float shx32(float v, int lane) { return __builtin_bit_cast(float, __builtin_amdgcn_ds_bpermute((lane ^ 32) << 2, __builtin_bit_cast(int, v))); }
__device__ __forceinline__ float sum_x16(float v) { const unsigned u = __builtin_bit_cast(unsigned, v); auto r = __builtin_amdgcn_permlane16_swap(u, u, false, false); return __builtin_bit_cast(float, (unsigned)r[0]) + __builtin_bit_cast(float, (unsigned)r[1]); }
__device__ __forceinline__ float sum_x32(float v) { const unsigned u = __builtin_bit_cast(unsigned, v); auto r = __builtin_amdgcn_permlane32_swap(u, u, false, false); return __builtin_bit_cast(float, (unsigned)r[0]) + __builtin_bit_cast(float, (unsigned)r[1]); }
template <class Epi, class Sched, bool ALIGN_EPI = false, bool SP2 = false, bool ROWSSQ = false>
__device__ __forceinline__ void gemm_phase(PG8_LAS unsigned char* lds, const Gemm g, const Sched& S, const Epi& E, const int tid) {
    const int wid = __builtin_amdgcn_readfirstlane(tid >> 6), lane = tid & 63, wr = wid >> 2, wc = wid & 3, fr = lane & 15, fq = lane >> 4;
    int K_ = g.K; asm volatile("" : "+s"(K_));
    const int K = K_, nt = K / BK;
    unsigned voffA[2], voffB[2];
#pragma unroll
    for (int i = 0; i < 2; ++i) { int R, C; stage_rc(tid * 16 + i * 8192, R, C); const int Rb = Epi::PERM ? ((R & ~31) + perm32(R & 31)) : R;
        voffA[i] = (unsigned)(R * K + C) * 2u; voffB[i] = (unsigned)(Rb * K + C) * 2u; }
    const size_t kstep = (size_t)(BK * 2);
    const size_t hstep = (size_t)HALF * K * 2;
    const size_t tstep = 2 * hstep;
    const unsigned ldsw = (unsigned)wid * 1024u;
    const int aoff = lds_byte(wr * 64 + fr, fq * 8), boff = lds_byte(wc * 32 + fr, fq * 8);
#define PG8_SA(b, h) (((b) * 2 + (h)) * HTB)
#define PG8_SB(b, h) ((4 + (b) * 2 + (h)) * HTB)
    const unsigned lds_u = (unsigned)(uintptr_t)lds + ldsw;
#define PG8_STAGE(bufoff, gbase, voff) do { _Pragma("unroll") for (int _i = 0; _i < 2; ++_i) \
        asm volatile("s_mov_b32 m0, %2\n\ts_nop 0\n\tglobal_load_lds_dwordx4 %0, %1" :: "v"((voff)[_i]), "s"((const char*)(gbase)), "s"(lds_u + (unsigned)((bufoff) + _i * 8192)) : "memory", "m0"); } while (0)
#define PG8_LDA(dst, b, h) do { _Pragma("unroll") for (int m = 0; m < 4; ++m) _Pragma("unroll") for (int k = 0; k < 2; ++k) dst[m][k] = *(const PG8_LAS bf16x8*)(lds + PG8_SA(b, h) + aoff + m * 2048 + k * 1024); } while (0)
#define PG8_LDB(dst, b, h) do { _Pragma("unroll") for (int n = 0; n < 2; ++n) _Pragma("unroll") for (int k = 0; k < 2; ++k) dst[n][k] = *(const PG8_LAS bf16x8*)(lds + PG8_SB(b, h) + boff + n * 2048 + k * 1024); } while (0)
#define PG8_MMA(ai, bj, At, Bt) do { __builtin_amdgcn_s_setprio(1); _Pragma("unroll") for (int m = 0; m < 4; ++m) _Pragma("unroll") for (int n = 0; n < 2; ++n) _Pragma("unroll") for (int k = 0; k < 2; ++k) \
        acc[ai][bj][m][n] = __builtin_amdgcn_mfma_f32_16x16x32_bf16(Bt[n][k], At[m][k], acc[ai][bj][m][n], 0, 0, 0); __builtin_amdgcn_s_setprio(0); } while (0)
#define PG8_SSQ(ai, At) do { if constexpr (ROWSSQ && SSQ_INLOOP) { _Pragma("unroll") for (int m = 0; m < 4; ++m) _Pragma("unroll") for (int k = 0; k < 2; ++k) { const u32x4 w_ = __builtin_bit_cast(u32x4, At[m][k]); \
        ssq[ai][m] = dot2sq(w_.x, ssq[ai][m]); ssq[ai][m] = dot2sq(w_.y, ssq[ai][m]); ssq[ai][m] = dot2sq(w_.z, ssq[ai][m]); ssq[ai][m] = dot2sq(w_.w, ssq[ai][m]); } } } while (0)
#define PG8_WAIT_V(n) asm volatile("s_waitcnt vmcnt(" #n ")" ::: "memory")
#define PG8_WAIT_L(n) asm volatile("s_waitcnt lgkmcnt(" #n ")" ::: "memory")
#define PG8_BAR __builtin_amdgcn_s_barrier()
#define PG8_SCHED __builtin_amdgcn_sched_barrier(0)
    Unit cur, nxt; int ui = 0;
    if (!S.next(0, cur)) return;
    f32x4 acc[2][2][4][2];
#pragma unroll
    for (int a = 0; a < 2; ++a)
#pragma unroll
        for (int b = 0; b < 2; ++b)
#pragma unroll
            for (int m = 0; m < 4; ++m)
#pragma unroll
                for (int n = 0; n < 2; ++n) acc[a][b][m][n] = (f32x4){0.f, 0.f, 0.f, 0.f};
    bf16x8 At[4][2], B0[2][2], B1[2][2];
    float ssq[2][4];
#pragma unroll
    for (int a = 0; a < 2; ++a)
#pragma unroll
        for (int m = 0; m < 4; ++m) ssq[a][m] = 0.f;
    const char* cA = (const char*)g.A + (size_t)cur.pm * tstep; const char* cB = (const char*)g.Bt + (size_t)cur.pn * tstep;
#define PG8_SSQ_LOAD(u_) do { if constexpr (ROWSSQ && !SSQ_INLOOP) { const float* sp_ = g.ssq + ((size_t)(u_).pm * BM + wr * 64 + fr) * 4 + fq; \
        _Pragma("unroll") for (int a = 0; a < 2; ++a) _Pragma("unroll") for (int m = 0; m < 4; ++m) ssq[a][m] = sp_[(a * HALF + m * 16) * 4]; } } while (0)
    float rs[2][4];
#define PG8_RS_FROM_SSQ() do { _Pragma("unroll") for (int a = 0; a < 2; ++a) _Pragma("unroll") for (int m = 0; m < 4; ++m) { float q_ = ssq[a][m]; \
        if constexpr (ROWSSQ) { q_ = sum_x16(q_); q_ = sum_x32(q_); q_ = __builtin_amdgcn_rsqf(q_ * (1.0f / (float)K) + 1e-6f); } rs[a][m] = q_; ssq[a][m] = 0.f; } } while (0)
    PG8_SSQ_LOAD(cur);
    S.a_ready(cur);
    if constexpr (SP2) {
        PG8_STAGE(PG8_SB(0, 0), cB, voffB); PG8_STAGE(PG8_SB(0, 1), cB + hstep, voffB); PG8_STAGE(PG8_SA(0, 0), cA, voffA); PG8_STAGE(PG8_SA(0, 1), cA + hstep, voffA);
        if (wr == 1) PG8_BAR;
        PG8_WAIT_V(2); PG8_RS_FROM_SSQ(); PG8_BAR;
        PG8_STAGE(PG8_SB(1, 0), cB + kstep, voffB); PG8_STAGE(PG8_SA(1, 0), cA + kstep, voffA); PG8_STAGE(PG8_SB(1, 1), cB + hstep + kstep, voffB);
        PG8_WAIT_V(6); PG8_BAR;
    } else {
        PG8_STAGE(PG8_SB(0, 0), cB, voffB); PG8_STAGE(PG8_SA(0, 0), cA, voffA); PG8_STAGE(PG8_SB(0, 1), cB + hstep, voffB); PG8_STAGE(PG8_SA(0, 1), cA + hstep, voffA);
        if (wr == 1) PG8_BAR;
        PG8_WAIT_V(4); PG8_RS_FROM_SSQ(); PG8_BAR;
        PG8_STAGE(PG8_SB(1, 0), cB + kstep, voffB); PG8_STAGE(PG8_SA(1, 0), cA + kstep, voffA); PG8_STAGE(PG8_SB(1, 1), cB + hstep + kstep, voffB);
        PG8_WAIT_V(6); PG8_BAR;
    }
    for (;;) {
        const bool has_next = S.next(ui + 1, nxt);
        const char* nA = has_next ? (const char*)g.A + (size_t)nxt.pm * tstep : cA; const char* nB = has_next ? (const char*)g.Bt + (size_t)nxt.pn * tstep : cB;
        for (int t = 0; t < nt; t += 2) {
            const bool last = (t == nt - 2);
            const char* a1 = cA + (size_t)(t + 1) * kstep;
            const char* a2 = last ? nA : cA + (size_t)(t + 2) * kstep; const char* b2 = last ? nB : cB + (size_t)(t + 2) * kstep;
            const char* a3 = a2 + kstep; const char* b3 = b2 + kstep;
            if (last && has_next) S.a_ready(nxt);
            if constexpr (SP2) {
            PG8_LDB(B0, 0, 0); PG8_LDB(B1, 0, 1); PG8_SCHED; PG8_LDA(At, 0, 0); PG8_STAGE(PG8_SA(1, 1), a1 + hstep, voffA);
            PG8_WAIT_V(8); PG8_WAIT_L(0); PG8_BAR; PG8_MMA(0, 0, At, B0); PG8_SSQ(0, At); PG8_MMA(0, 1, At, B1); PG8_BAR; PG8_SCHED;
            PG8_LDA(At, 0, 1); PG8_STAGE(PG8_SB(0, 0), b2, voffB); PG8_STAGE(PG8_SB(0, 1), b2 + hstep, voffB); PG8_STAGE(PG8_SA(0, 0), a2, voffA);
            PG8_WAIT_V(8); PG8_WAIT_L(0); PG8_BAR; PG8_MMA(1, 0, At, B0); PG8_SSQ(1, At); PG8_MMA(1, 1, At, B1); PG8_BAR; PG8_SCHED;
            PG8_LDB(B0, 1, 0); PG8_LDB(B1, 1, 1); PG8_SCHED; PG8_LDA(At, 1, 0); PG8_STAGE(PG8_SA(0, 1), a2 + hstep, voffA);
            PG8_WAIT_V(8); PG8_WAIT_L(0); PG8_BAR; PG8_MMA(0, 0, At, B0); PG8_SSQ(0, At); PG8_MMA(0, 1, At, B1); PG8_BAR; PG8_SCHED;
            PG8_LDA(At, 1, 1); PG8_STAGE(PG8_SB(1, 0), b3, voffB); PG8_STAGE(PG8_SB(1, 1), b3 + hstep, voffB); PG8_STAGE(PG8_SA(1, 0), a3, voffA);
            PG8_WAIT_V(8); PG8_WAIT_L(0); PG8_BAR; PG8_MMA(1, 0, At, B0); PG8_SSQ(1, At); PG8_MMA(1, 1, At, B1); PG8_BAR; PG8_SCHED;
            } else {
            PG8_LDB(B0, 0, 0); PG8_SCHED; PG8_LDA(At, 0, 0); PG8_STAGE(PG8_SA(1, 1), a1 + hstep, voffA);
            PG8_WAIT_L(8); PG8_BAR; PG8_WAIT_L(0); PG8_MMA(0, 0, At, B0); PG8_BAR; PG8_SCHED;
            PG8_LDB(B1, 0, 1); PG8_STAGE(PG8_SB(0, 0), b2, voffB);
            PG8_BAR; PG8_WAIT_L(0); PG8_MMA(0, 1, At, B1); PG8_BAR;
            PG8_LDA(At, 0, 1); PG8_STAGE(PG8_SA(0, 0), a2, voffA);
            PG8_BAR; PG8_WAIT_L(0); PG8_MMA(1, 0, At, B0); PG8_BAR; PG8_SCHED;
            PG8_STAGE(PG8_SB(0, 1), b2 + hstep, voffB);
            PG8_WAIT_V(6); PG8_BAR; PG8_MMA(1, 1, At, B1); PG8_BAR;
            PG8_LDB(B0, 1, 0); PG8_SCHED; PG8_LDA(At, 1, 0); PG8_STAGE(PG8_SA(0, 1), a2 + hstep, voffA);
            PG8_WAIT_L(8); PG8_BAR; PG8_WAIT_L(0); PG8_MMA(0, 0, At, B0); PG8_BAR; PG8_SCHED;
            PG8_LDB(B1, 1, 1); PG8_STAGE(PG8_SB(1, 0), b3, voffB);
            PG8_BAR; PG8_WAIT_L(0); PG8_MMA(0, 1, At, B1); PG8_BAR;
            PG8_LDA(At, 1, 1); PG8_STAGE(PG8_SA(1, 0), a3, voffA);
            PG8_BAR; PG8_WAIT_L(0); PG8_MMA(1, 0, At, B0); PG8_BAR; PG8_SCHED;
            PG8_STAGE(PG8_SB(1, 1), b3 + hstep, voffB);
            PG8_WAIT_V(6); PG8_BAR; PG8_MMA(1, 1, At, B1); PG8_BAR;
            }
        }
        if constexpr (ALIGN_EPI) { if (wr == 0) PG8_BAR; }
        if constexpr (ROWSSQ && SSQ_INLOOP) PG8_RS_FROM_SSQ();
        if (has_next) PG8_SSQ_LOAD(nxt);
        E(acc, cur, wr, wc, fr, fq, rs); S.done(cur);
        if (!has_next) break;
        if constexpr (!(ROWSSQ && SSQ_INLOOP)) PG8_RS_FROM_SSQ();
        { typedef unsigned long long u64x2_ __attribute__((ext_vector_type(2)));
          unsigned long long z64 = 0ull; asm volatile("" : "+v"(z64));
#pragma unroll
        for (int a = 0; a < 2; ++a)
#pragma unroll
            for (int b = 0; b < 2; ++b)
#pragma unroll
                for (int m = 0; m < 4; ++m)
#pragma unroll
                    for (int n = 0; n < 2; ++n) acc[a][b][m][n] = __builtin_bit_cast(f32x4, (u64x2_){z64, z64}); }
        cur = nxt; cA = nA; cB = nB; ++ui;
        if constexpr (ALIGN_EPI) { if (wr == 1) PG8_BAR; }
    }
    PG8_WAIT_V(0);
    if constexpr (!ALIGN_EPI) { if (wr == 0) PG8_BAR; }
    PG8_BAR;
#undef PG8_SA
#undef PG8_SB
#undef PG8_STAGE
#undef PG8_LDA
#undef PG8_LDB
#undef PG8_MMA
#undef PG8_SSQ
#undef PG8_SSQ_LOAD
#undef PG8_RS_FROM_SSQ
#undef PG8_WAIT_V
#undef PG8_WAIT_L
#undef PG8_BAR
#undef PG8_SCHED
}
}

typedef unsigned short bf16;
typedef float f32x4 __attribute__((ext_vector_type(4)));
typedef unsigned v4u __attribute__((ext_vector_type(4)));
typedef unsigned v2u __attribute__((ext_vector_type(2)));
constexpr int NB_ = 8, SEQ = 4096, D = 1024, M = NB_ * SEQ;
constexpr int ML_H = 8, ML_DV = 128, ML_DQK = 64, ML_L = 64, ML_NC = SEQ / ML_L, ML_IN = 3088, ML_INP = 3072;
constexpr int MB_H = 16, MB_KVH = 4, MB_HD = 64, MB_BLK = 256, MB_NB = SEQ / MB_BLK;
constexpr int FF = 2816, PLE = 256;
constexpr float EPS = 1e-6f, GATE_CAP = 15.0f;
constexpr int NWAVES = 8, NTHREADS = 512;

constexpr size_t MiB = 1u << 20;
constexpr size_t WS_CTL = 0, CTL_ZERO_BYTES = 64 * 1024;
constexpr size_t WS_ROPE = 1 * MiB;
constexpr size_t WS_KMP = 1 * MiB + 512 * 1024;
constexpr size_t WS_SSQ0 = 2 * MiB, WS_SSQ1 = 3 * MiB;
constexpr size_t WS_GATES = 6 * MiB;
constexpr size_t WS_MLOC = 8 * MiB, WS_GLAST = WS_MLOC + 16384, WS_MPREV = WS_GLAST + 16384;
constexpr size_t WS_NLOC = 9 * MiB;
constexpr size_t WS_WIN = 10 * MiB, WS_WOUT = 17 * MiB, WS_WQKV1 = 19 * MiB, WS_WO1 = 22 * MiB, WS_WGU = 24 * MiB  , WS_WDN = 46 * MiB  , WS_WPG = 58 * MiB  , WS_WPU = 62 * MiB  ;
constexpr size_t WS_HB = 64 * MiB, WS_HB2 = 448 * MiB;
constexpr size_t WS_PB = 128 * MiB;
constexpr size_t WS_UP = 160 * MiB;
constexpr size_t WS_OG = 160 * MiB;
constexpr size_t WS_Q0 = 224 * MiB, WS_K0 = 256 * MiB, WS_V0 = 288 * MiB  , WS_CLOC = 384 * MiB  ;
constexpr size_t WS_ACT = 224 * MiB;
constexpr size_t WS_Q1 = 224 * MiB, WS_K1 = 288 * MiB, WS_V1 = 304 * MiB, WS_AO = 320 * MiB;
constexpr size_t WS_END = 512 * MiB;

constexpr int LDS_BYTES = 147456;
constexpr int RING_BYTES = 131072;
constexpr int LDSCTL_OFF = RING_BYTES;

__device__ __forceinline__ unsigned f2bf(float f) { unsigned u = __builtin_bit_cast(unsigned, f); return (u + 0x7fffu + ((u >> 16) & 1u)) >> 16; }
__device__ __forceinline__ unsigned pk2(float lo, float hi) { return pg8::cvt_pk_bf16(lo, hi); }
__device__ __forceinline__ float bf_lo(unsigned u) { return __builtin_bit_cast(float, u << 16); }
__device__ __forceinline__ float bf_hi(unsigned u) { return __builtin_bit_cast(float, u & 0xffff0000u); }
__device__ __forceinline__ float sigmoidf_(float x) { return __builtin_amdgcn_rcpf(1.0f + __builtin_amdgcn_exp2f(-1.4426950408889634f * x)); }
__device__ __forceinline__ float shx(float v, int mask, int lane) { return __builtin_bit_cast(float, __builtin_amdgcn_ds_bpermute((lane ^ mask) << 2, __builtin_bit_cast(int, v))); }
__device__ __forceinline__ int shxi(int v, int mask, int lane) { return __builtin_amdgcn_ds_bpermute((lane ^ mask) << 2, v); }
__device__ __forceinline__ float shup(float v, int o, int lane) { return __builtin_bit_cast(float, __builtin_amdgcn_ds_bpermute((lane >= o ? lane - o : lane) << 2, __builtin_bit_cast(int, v))); }
__device__ __forceinline__ float shidx(float v, int src) { return __builtin_bit_cast(float, __builtin_amdgcn_ds_bpermute(src << 2, __builtin_bit_cast(int, v))); }
__device__ __forceinline__ float wave_sum(float v, int lane) {
#pragma unroll
    for (int o = 1; o < 64; o <<= 1) v += shx(v, o, lane);
    return v;
}
__device__ __forceinline__ float wave_max(float v, int lane) {
#pragma unroll
    for (int o = 1; o < 64; o <<= 1) v = fmaxf(v, shx(v, o, lane));
    return v;
}

using pg8::Unit; using pg8::HALF; using pg8::BM;
#define ROWS8 _Pragma("unroll") for (int ai = 0; ai < 2; ++ai) _Pragma("unroll") for (int m = 0; m < 4; ++m)

#define EPI_ARGS const f32x4 (&acc)[2][2][4][2], const Unit& u, int wr, int wc, int fr, int fq, const float (&rs)[2][4]
#ifndef EPI_WT
#define EPI_WT 0
#endif
__device__ __forceinline__ void st16(void* base, size_t byte_off, v4u v) {
    if (EPI_WT) { const __amdgpu_buffer_rsrc_t r = __builtin_amdgcn_make_buffer_rsrc(base, (short)0, 0x7fffffff, 0x00020000); __builtin_amdgcn_raw_buffer_store_b128(v, r, (unsigned)byte_off, 0, 16); }
    else *(v4u*)((char*)base + byte_off) = v;
}
__device__ __forceinline__ v4u pack8(const f32x4 a, const f32x4 b) { v4u w; w.x = pk2(a[0], a[1]); w.y = pk2(a[2], a[3]); w.z = pk2(b[0], b[1]); w.w = pk2(b[2], b[3]); return w; }
__device__ __forceinline__ void unpack8(const v4u w, f32x4& a, f32x4& b) { a = (f32x4){bf_lo(w.x), bf_hi(w.x), bf_lo(w.y), bf_hi(w.y)}; b = (f32x4){bf_lo(w.z), bf_hi(w.z), bf_lo(w.w), bf_hi(w.w)}; }
struct EpiMl {
    static constexpr bool PERM = true, AFTER_DRAIN = false;
    unsigned char* ws;
    __device__ __forceinline__ void operator()(EPI_ARGS) const {
        const int row0 = u.pm * BM + wr * 64 + fr;
        const int t = u.pn < 2 ? 0 : (u.pn < 4 ? 1 : (u.pn < 8 ? 2 : 3));
        const size_t boff = t == 0 ? WS_Q0 : (t == 1 ? WS_K0 : (t == 2 ? WS_V0 : WS_OG));
        const int ld = t < 2 ? 512 : 1024, colt = (u.pn - (t == 0 ? 0 : (t == 1 ? 2 : (t == 2 ? 4 : 8)))) * 256; const float sc = t == 0 ? 0.125f : 1.f;
        bf16* base = (bf16*)(ws + boff);
        const int col0 = colt + wc * 32 + 8 * fq;
        ROWS8 { const size_t ro = ((size_t)(row0 + ai * HALF + m * 16) * ld + col0) * 2; const float r = rs[ai][m] * sc;
#pragma unroll
            for (int bj = 0; bj < 2; ++bj) st16(base, ro + bj * HALF * 2, pack8(acc[ai][bj][m][0] * r, acc[ai][bj][m][1] * r)); }
    }
};
struct EpiQkv1 {
    static constexpr bool PERM = true, AFTER_DRAIN = false;
    unsigned char* ws; LAS unsigned char* xl; const float* qg; const float* kg;
    __device__ __forceinline__ void operator()(const f32x4 (&acc)[2][2][4][2], const Unit& u, int wr, int wc, int fr_, int fq_, const float (&rs)[2][4]) const {
        int fr = fr_, fq = fq_; asm volatile("" : "+v"(fr), "+v"(fq));
        const int lane = fr + 16 * fq, rowl0 = wr * 64 + fr, row0 = u.pm * BM + rowl0;
        if (u.pn == 5) {
            bf16* base = (bf16*)(ws + WS_V1); const int col0 = wc * 32 + 8 * fq;
            ROWS8 { const float r = rs[ai][m]; const size_t ro = ((size_t)(row0 + ai * HALF + m * 16) * 256 + col0) * 2;
#pragma unroll
                for (int bj = 0; bj < 2; ++bj) st16(base, ro + bj * HALF * 2, pack8(acc[ai][bj][m][0] * r, acc[ai][bj][m][1] * r)); }
            return;
        }
        const bool isq = u.pn < 4;
        LAS float* ex = (LAS float*)xl;
        ROWS8 { const float r = rs[ai][m];
#pragma unroll
            for (int bj = 0; bj < 2; ++bj) { const f32x4 a = acc[ai][bj][m][0] * r, b = acc[ai][bj][m][1] * r; float q = ((a[0] * a[0] + a[1] * a[1]) + (a[2] * a[2] + a[3] * a[3])) + ((b[0] * b[0] + b[1] * b[1]) + (b[2] * b[2] + b[3] * b[3]));
                q = pg8::sum_x16(q); q = pg8::sum_x32(q);
                if (fq == 0) ex[(ai * HALF + rowl0 + m * 16) * 8 + bj * 4 + wc] = q; } }
        asm volatile("s_waitcnt lgkmcnt(0)\n\ts_barrier" ::: "memory");
        float gn[8];
        { const float* gp = (isq ? qg : kg) + 32 * (wc & 1) + 8 * fq; const float sc = isq ? 0.125f * 1.4426950408889634f : 1.0f;
#pragma unroll
          for (int e = 0; e < 8; ++e) gn[e] = gp[e] * sc; }
        const bool rot = (wc & 1) == 0;
        const float* rc = (const float*)(ws + WS_ROPE); const float* rsn = rc + SEQ * 8;
        bf16* base = (bf16*)(ws + (isq ? WS_Q1 : WS_K1)); const int ld = isq ? 1024 : 256, col0 = (isq ? u.pn * 256 : 0) + wc * 32 + 8 * fq;
        float ks[2][8];
#pragma unroll
        for (int bj = 0; bj < 2; ++bj)
#pragma unroll
            for (int e = 0; e < 8; ++e) ks[bj][e] = 0.f;
        ROWS8 { const int rowl = ai * HALF + rowl0 + m * 16, row = u.pm * BM + rowl; const float r = rs[ai][m];
            float cs[8], sn[8];
            if (rot) { const int pos = row & (SEQ - 1); const f32x4 c0 = *(const f32x4*)(rc + pos * 8), c1 = *(const f32x4*)(rc + pos * 8 + 4), s0 = *(const f32x4*)(rsn + pos * 8), s1 = *(const f32x4*)(rsn + pos * 8 + 4);
#pragma unroll
                for (int e = 0; e < 4; ++e) { cs[e] = c0[e]; cs[4 + e] = c1[e]; sn[e] = s0[e]; sn[4 + e] = s1[e]; } }
#pragma unroll
            for (int bj = 0; bj < 2; ++bj) {
                const float q = ex[rowl * 8 + bj * 4 + (wc & 2)] + ex[rowl * 8 + bj * 4 + (wc | 1)]; const float rn = r * __builtin_amdgcn_rsqf(q * (1.0f / 64.0f) + EPS);
                float v[8];
#pragma unroll
                for (int e = 0; e < 8; ++e) v[e] = acc[ai][bj][m][e >> 2][e & 3] * rn * gn[e];
                if (rot) {
#pragma unroll
                    for (int e = 0; e < 8; ++e) { const float p = pg8::shx16(v[e], lane); if (fq == 0) v[e] = v[e] * cs[e] - p * sn[e]; else if (fq == 1) v[e] = v[e] * cs[e] + p * sn[e]; } }
                st16(base, ((size_t)row * ld + col0 + bj * HALF) * 2, pack8((f32x4){v[0], v[1], v[2], v[3]}, (f32x4){v[4], v[5], v[6], v[7]}));
                if (!isq) {
#pragma unroll
                    for (int e = 0; e < 8; ++e) ks[bj][e] += v[e]; } }
            asm volatile("" ::: "memory"); }
        if (!isq) {
            LAS float* kx = ex + 2048;
#pragma unroll
            for (int bj = 0; bj < 2; ++bj)
#pragma unroll
                for (int e = 0; e < 8; ++e) { float t = ks[bj][e]; t += shx(t, 1, lane); t += shx(t, 2, lane); t += shx(t, 4, lane); t += shx(t, 8, lane); ks[bj][e] = t; }
            if (fr == 0) {
#pragma unroll
                for (int bj = 0; bj < 2; ++bj) { LAS float* kp = kx + wr * 256 + bj * HALF + wc * 32 + 8 * fq; *(LAS f32x4*)kp = (f32x4){ks[bj][0], ks[bj][1], ks[bj][2], ks[bj][3]}; *(LAS f32x4*)(kp + 4) = (f32x4){ks[bj][4], ks[bj][5], ks[bj][6], ks[bj][7]}; } }
            asm volatile("s_waitcnt lgkmcnt(0)\n\ts_barrier" ::: "memory");
            const int t = (wr * 4 + wc) * 64 + lane;
            if (t < 256) ((float*)(ws + WS_KMP))[(size_t)u.pm * 256 + t] = kx[t] + kx[256 + t];
        }
    }
};
struct EpiPlain {
    static constexpr bool PERM = true, AFTER_DRAIN = false;
    bf16* O; int ld;
    __device__ __forceinline__ void operator()(EPI_ARGS) const {
        const int row0 = u.pm * BM + wr * 64 + fr, col0 = u.pn * BM + wc * 32 + 8 * fq;
        ROWS8 { const size_t ro = ((size_t)(row0 + ai * HALF + m * 16) * ld + col0) * 2;
#pragma unroll
            for (int bj = 0; bj < 2; ++bj) st16(O, ro + bj * HALF * 2, pack8(acc[ai][bj][m][0], acc[ai][bj][m][1])); }
    }
};
struct EpiSwiglu {
    static constexpr bool PERM = true, AFTER_DRAIN = false;
    bf16* act;
    __device__ __forceinline__ void operator()(EPI_ARGS) const {
        const int row0 = u.pm * BM + wr * 64 + fr, col0 = u.pn * HALF + wc * 32 + 8 * fq;
        ROWS8 { const float r = rs[ai][m], rn = r * -1.4426950408889634f, r2 = r * r; const size_t ro = ((size_t)(row0 + ai * HALF + m * 16) * FF + col0) * 2; f32x4 o[2];
#pragma unroll
            for (int n = 0; n < 2; ++n)
#pragma unroll
                for (int e = 0; e < 4; ++e) { const float g_ = acc[ai][0][m][n][e]; o[n][e] = (g_ * acc[ai][1][m][n][e]) * (r2 * __builtin_amdgcn_rcpf(1.0f + __builtin_amdgcn_exp2f(g_ * rn))); }
            st16(act, ro, pack8(o[0], o[1])); }
    }
};
__device__ __forceinline__ void publish_rowssq(float (&q)[2][4], LAS float* xq, float* ssq, const Unit& u, int wr, int wc, int fr, int fq) {
    const int lane = fr + 16 * fq;
    ROWS8 { float t = q[ai][m]; t = pg8::sum_x16(t); t = pg8::sum_x32(t); if (fq == 0) xq[wc * 256 + ai * HALF + wr * 64 + m * 16 + fr] = t; }
    asm volatile("s_waitcnt lgkmcnt(0)\n\ts_barrier" ::: "memory");
    const int t = (wr * 4 + wc) * 64 + lane;
    if (t < 256) ssq[((size_t)u.pm * BM + t) * 4 + u.pn] = (xq[t] + xq[256 + t]) + (xq[512 + t] + xq[768 + t]);
}
__device__ __forceinline__ float sq8(const v4u w, float q) { q = pg8::dot2sq(w.x, q); q = pg8::dot2sq(w.y, q); q = pg8::dot2sq(w.z, q); return pg8::dot2sq(w.w, q); }
#define ER_OFF(ai, m, bj) ((size_t)((ai) * HALF + (m) * 16) * D + (bj) * HALF)
struct EpiRes {
    static constexpr bool PERM = true, AFTER_DRAIN = false;
    bf16* hb; float* ssq; LAS float* xq;
    __device__ __forceinline__ void operator()(EPI_ARGS) const {
        const int row0 = u.pm * BM + wr * 64 + fr, col0 = u.pn * BM + wc * 32 + 8 * fq;
        const size_t o0 = (size_t)row0 * D + col0; bf16* p0 = hb + o0;
        v4u hv[2][4][2];
#pragma unroll
        for (int ai = 0; ai < 2; ++ai)
#pragma unroll
            for (int m = 0; m < 4; ++m)
#pragma unroll
                for (int bj = 0; bj < 2; ++bj) hv[ai][m][bj] = *(const v4u*)(p0 + ER_OFF(ai, m, bj));
        asm volatile("" ::: "memory");
        float q[2][4];
#pragma unroll
        for (int ai = 0; ai < 2; ++ai)
#pragma unroll
            for (int m = 0; m < 4; ++m) q[ai][m] = 0.f;
#pragma unroll
        for (int ai = 0; ai < 2; ++ai)
#pragma unroll
            for (int m = 0; m < 4; ++m)
#pragma unroll
                for (int bj = 0; bj < 2; ++bj) { f32x4 a, b; unpack8(hv[ai][m][bj], a, b); const v4u w = pack8(a + acc[ai][bj][m][0], b + acc[ai][bj][m][1]); q[ai][m] = sq8(w, q[ai][m]); st16(hb, (o0 + ER_OFF(ai, m, bj)) * 2, w); }
        publish_rowssq(q, xq, ssq, u, wr, wc, fr, fq);
    }
};
template <bool LAST> struct EpiPle {
    static constexpr bool PERM = true, AFTER_DRAIN = false;
    const bf16* hin; bf16* hout; float* out; const bf16* up; float* ssq; LAS float* xq;
    __device__ __forceinline__ void operator()(const f32x4 (&acc)[2][2][4][2], const Unit& u, int wr, int wc, int fr_, int fq_, const float (&rs)[2][4]) const {
        int fr = fr_, fq = fq_; asm volatile("" : "+v"(fr), "+v"(fq));
        const int row0 = u.pm * BM + wr * 64 + fr, col0 = u.pn * BM + wc * 32 + 8 * fq;
        const size_t o0 = (size_t)row0 * D + col0;
        v4u hv[4][2], uv[4][2];
        float q[2][4];
#pragma unroll
        for (int ai = 0; ai < 2; ++ai)
#pragma unroll
            for (int m = 0; m < 4; ++m) q[ai][m] = 0.f;
#pragma unroll
        for (int ai = 0; ai < 2; ++ai) {
#pragma unroll
            for (int m = 0; m < 4; ++m)
#pragma unroll
                for (int bj = 0; bj < 2; ++bj) { hv[m][bj] = *(const v4u*)(hin + o0 + ER_OFF(ai, m, bj)); uv[m][bj] = *(const v4u*)(up + o0 + ER_OFF(ai, m, bj)); }
            asm volatile("" ::: "memory");
#pragma unroll
            for (int m = 0; m < 4; ++m) { const float rn = rs[ai][m] * -1.4426950408889634f;
#pragma unroll
                for (int bj = 0; bj < 2; ++bj) { f32x4 a, b, x0_, x1_; unpack8(hv[m][bj], a, b); unpack8(uv[m][bj], x0_, x1_); const f32x4 g0 = acc[ai][bj][m][0] * rn, g1 = acc[ai][bj][m][1] * rn;
#pragma unroll
                    for (int e = 0; e < 4; ++e) { a[e] += x0_[e] * __builtin_amdgcn_rcpf(1.0f + __builtin_amdgcn_exp2f(g0[e])); b[e] += x1_[e] * __builtin_amdgcn_rcpf(1.0f + __builtin_amdgcn_exp2f(g1[e])); }
                    const size_t off = o0 + ER_OFF(ai, m, bj);
                    if (LAST) { st16(out, off * 4, __builtin_bit_cast(v4u, a)); st16(out, off * 4 + 16, __builtin_bit_cast(v4u, b)); } else { const v4u w = pack8(a, b); q[ai][m] = sq8(w, q[ai][m]); st16(hout, off * 2, w); } } }
            asm volatile("" ::: "memory");
        }
        if (!LAST) publish_rowssq(q, xq, ssq, u, wr, wc, fr, fq);
    }
};
#undef ER_OFF

typedef GAS unsigned gu32;
#define RLX_AGENT __ATOMIC_RELAXED, __HIP_MEMORY_SCOPE_AGENT
#define XB_TMO      128
#define XB_XCNT(j)  (256  + 64 * (j))
#define XB_XSUB(j)  (1280 + 64 * (j))
#define XB_XGEN(j)  (2304 + 64 * (j))
#define XB_FLAG(j)  (3328 + (j))
#define XCD_BAR_WORDS 3456
#define XB_SPIN_CAP (1u << 22)
__device__ __forceinline__ unsigned xb_ld(unsigned* p)              { return __hip_atomic_load(p, __ATOMIC_RELAXED, __HIP_MEMORY_SCOPE_AGENT); }
__device__ __forceinline__ unsigned xb_add(unsigned* p, unsigned v) { return __hip_atomic_fetch_add(p, v, __ATOMIC_RELAXED, __HIP_MEMORY_SCOPE_AGENT); }
__device__ __forceinline__ unsigned xb_xcc_id() { return (unsigned)__builtin_amdgcn_s_getreg((3 << 11) | 20) & 0xFu; }
#define XB_SPIN(cond, bar) do { unsigned _sp = 0; while (cond) { __builtin_amdgcn_s_sleep(1); \
    if ((++_sp & 255u) == 0u) { if (xb_ld(&(bar)[XB_TMO])) break; if (_sp > XB_SPIN_CAP) { atomicAdd(&(bar)[XB_TMO], 1u); break; } } } } while (0)
struct XcdBarrier { unsigned* bar; unsigned x; volatile LAS unsigned* st; };
__device__ __forceinline__ XcdBarrier xcd_barrier_post(unsigned* bar, volatile LAS unsigned* st) {
    XcdBarrier b; b.bar = bar; b.x = xb_xcc_id(); b.st = st;
    if (threadIdx.x == 0) st[2] = xb_add(&bar[XB_XCNT(b.x)], 1u);
    return b;
}
__device__ __forceinline__ void xcd_barrier_complete(unsigned* bar, unsigned x, unsigned& nloc, unsigned& amask, unsigned& even) {
    const unsigned G = gridDim.x * gridDim.y * gridDim.z;
    unsigned sum, msk, mine, sp = 0u;
    for (;;) {
        sum = 0u; msk = 0u; mine = 0u; even = 1u;
#pragma unroll
        for (unsigned j = 0; j < 16; ++j) { const unsigned c = xb_ld(&bar[XB_XCNT(j)]); sum += c; msk |= (c > 0u) ? (1u << j) : 0u; mine = (j == x) ? c : mine; even &= (c == (j < 8u ? 32u : 0u)) ? 1u : 0u; }
        if (sum == G) break;
        __builtin_amdgcn_s_sleep(1);
        if ((++sp & 255u) == 0u) { if (xb_ld(&bar[XB_TMO])) break; if (sp > XB_SPIN_CAP) { atomicAdd(&bar[XB_TMO], 1u); break; } }
    }
    nloc = mine > 0u ? mine : 1u; amask = msk ? msk : 1u; even = (even != 0u && G == 256u && sum == G) ? 1u : 0u;
}
template <int MODE>
__device__ __forceinline__ void p0_transpose_item(const float* W, int K, int N, int ldw, const float* gain, bf16* WT, int row_off, LAS float* scr, int item, int lane) {
    const int nblk = (N + 31) / 32, kb = item / nblk, nb = item % nblk, k0 = 64 * kb, n0 = 32 * nb;
    const int ncol = n0 + (lane & 31); const bool nok = ncol < N;
    float tv[32];
#pragma unroll
    for (int i = 0; i < 32; ++i) { const int kk = 2 * i + (lane >> 5); tv[i] = nok ? W[(size_t)(k0 + kk) * ldw + ncol] : 0.f; }
#pragma unroll
    for (int i = 0; i < 32; ++i) { const int kk = 2 * i + (lane >> 5); float v = tv[i]; if (gain) v *= gain[k0 + kk]; scr[kk * 33 + (lane & 31)] = v; }
    asm volatile("s_waitcnt lgkmcnt(0)" ::: "memory");
    const int c = lane & 7;
    int drow0;
    if (MODE == 0) drow0 = row_off + n0; else { const int isu = n0 >= FF ? 1 : 0, j0 = n0 - isu * FF; drow0 = 256 * (j0 / 128) + 128 * isu + (j0 % 128); }
#pragma unroll
    for (int j = 0; j < 4; ++j) { const int n = (lane >> 3) + 8 * j; const LAS float* s = scr + (8 * c) * 33 + n;
        v4u o; o.x = pk2(s[0 * 33], s[1 * 33]); o.y = pk2(s[2 * 33], s[3 * 33]); o.z = pk2(s[4 * 33], s[5 * 33]); o.w = pk2(s[6 * 33], s[7 * 33]);
        if (n0 + n < N) *(v4u*)(WT + (size_t)(drow0 + n) * K + k0 + 8 * c) = o; }
    asm volatile("s_waitcnt lgkmcnt(0)" ::: "memory");
}

struct Args { const float* in[19]; float* out; unsigned char* ws; int ph_lo, ph_hi; };
typedef const Args __attribute__((address_space(4))) CArgs;

constexpr int WI_IN = 16 * 96, WI_SQ = 16 * 32, WI_KV = 16 * 16, WI_GU = 16 * 176, WI_DN = 44 * 32, WI_PU = 4 * 32;
constexpr int WI_N0 = WI_IN + WI_SQ + WI_GU + WI_DN + WI_SQ + WI_PU, WI_N1 = WI_SQ + WI_KV + WI_SQ + WI_GU + WI_DN + WI_SQ + WI_PU;
__device__ __forceinline__ void weight_item(CArgs* A, unsigned char* ws, LAS float* scr, const int layer, int r, const int lane) {
    if (layer == 0) {
        if (r < WI_IN) { p0_transpose_item<0>(A->in[3], D, 3072, ML_IN, A->in[2], (bf16*)(ws + WS_WIN), 0, scr, r, lane); return; } r -= WI_IN;
        if (r < WI_SQ) { p0_transpose_item<0>(A->in[6], D, D, D, nullptr, (bf16*)(ws + WS_WOUT), 0, scr, r, lane); return; } r -= WI_SQ;
    } else {
        if (r < WI_SQ) { p0_transpose_item<0>(A->in[10], D, D, D, A->in[2] + D, (bf16*)(ws + WS_WQKV1), 0, scr, r, lane); return; } r -= WI_SQ;
        if (r < WI_KV) { p0_transpose_item<0>(A->in[8], D, 512, 512, A->in[7], (bf16*)(ws + WS_WQKV1), D, scr, r, lane); return; } r -= WI_KV;
        if (r < WI_SQ) { p0_transpose_item<0>(A->in[12], D, D, D, nullptr, (bf16*)(ws + WS_WO1), 0, scr, r, lane); return; } r -= WI_SQ;
    }
    const int l = layer;
    if (r < WI_GU) { p0_transpose_item<1>(A->in[14] + (size_t)l * D * 2 * FF, D, 2 * FF, 2 * FF, A->in[13] + l * D, (bf16*)(ws + WS_WGU + l * 11 * MiB), 0, scr, r, lane); return; } r -= WI_GU;
    if (r < WI_DN) { p0_transpose_item<0>(A->in[15] + (size_t)l * FF * D, FF, D, D, nullptr, (bf16*)(ws + WS_WDN + l * 6 * MiB), 0, scr, r, lane); return; } r -= WI_DN;
    if (r < WI_SQ) { p0_transpose_item<0>(A->in[17] + (size_t)l * D * D, D, D, D, A->in[16] + l * D, (bf16*)(ws + WS_WPG + l * 2 * MiB), 0, scr, r, lane); return; } r -= WI_SQ;
    p0_transpose_item<0>(A->in[18] + (size_t)l * PLE * D, PLE, D, D, nullptr, (bf16*)(ws + WS_WPU + l * (MiB / 2)), 0, scr, r, lane);
}
__device__ __forceinline__ void p_chunk(CArgs* A, unsigned char* ws, const size_t g0, const int lane) {
    const float* p = A->in[1]; bf16* pb = (bf16*)(ws + WS_PB); f32x4 a[4], b[4];
#pragma unroll
    for (int q = 0; q < 4; ++q) { const size_t ii = g0 + q * 64 + lane; a[q] = *(const f32x4*)(p + ii * 8); b[q] = *(const f32x4*)(p + ii * 8 + 4); }
#pragma unroll
    for (int q = 0; q < 4; ++q) { const size_t ii = g0 + q * 64 + lane; v4u w; w.x = pk2(a[q][0], a[q][1]); w.y = pk2(a[q][2], a[q][3]); w.z = pk2(b[q][0], b[q][1]); w.w = pk2(b[q][2], b[q][3]); *(v4u*)(pb + ii * 8) = w; }
}
__device__ __forceinline__ void xcd_barrier(const XcdBarrier& b, CArgs* ap = nullptr, LAS unsigned char* lds = nullptr, const int job = -1, const int G = 0, const int bx = 0, const int wave_s = 0, const unsigned ones = 0u, const bool xlocal = false) {
    asm volatile("s_waitcnt vmcnt(0)" ::: "memory");
    __syncthreads();
    if (job >= 0 && wave_s >= 1) {
        unsigned o_ = ones; asm volatile("" : "+s"(o_)); const int lane = (int)__builtin_amdgcn_mbcnt_hi(o_, __builtin_amdgcn_mbcnt_lo(o_, 0u));
        const int slot = (job & 3) * (G * 7) + bx * 7 + (wave_s - 1);
        if (job < 4) { if (slot < WI_N1) weight_item(ap, ap->ws, (LAS float*)(lds + wave_s * 16384), 1, slot, lane); }
        else if (slot < 4096) p_chunk(ap, ap->ws, (size_t)M * PLE / 8 + (size_t)slot * 256, lane);
        asm volatile("s_waitcnt vmcnt(0) lgkmcnt(0)" ::: "memory");
    }
    if (threadIdx.x == 0) {
        unsigned* bar = b.bar;
        __builtin_amdgcn_s_waitcnt(0);
        unsigned nloc = b.st[0], amask = b.st[1];
        if (nloc == 0u) { unsigned even; xcd_barrier_complete(bar, b.x, nloc, amask, even); b.st[0] = nloc; b.st[1] = amask; b.st[3] = even; }
        if (xlocal) amask = 1u << b.x;
        const unsigned old = xb_add(&bar[XB_XSUB(b.x)], 1u);
        const unsigned target = old / nloc + 1u;
        if (old + 1u == target * nloc) {
            if (!xlocal) { __builtin_amdgcn_fence(__ATOMIC_RELEASE, "agent"); asm volatile("s_waitcnt vmcnt(0)" ::: "memory"); }
            __hip_atomic_store(&bar[XB_FLAG(b.x)], target, __ATOMIC_RELAXED, __HIP_MEMORY_SCOPE_AGENT);
        }
        __builtin_amdgcn_fence(__ATOMIC_ACQUIRE, "agent");
        unsigned sp = 0u;
        for (;;) {
            unsigned f[16];
#pragma unroll
            for (unsigned j = 0; j < 16; ++j) f[j] = xb_ld(&bar[XB_FLAG(j)]);
            unsigned mn = target;
#pragma unroll
            for (unsigned j = 0; j < 16; ++j) { const unsigned v = ((amask >> j) & 1u) ? f[j] : target; mn = v < mn ? v : mn; }
            if (mn >= target) break;
            __builtin_amdgcn_s_sleep(1);
            if ((++sp & 255u) == 0u) { if (xb_ld(&bar[XB_TMO])) break; if (sp > XB_SPIN_CAP) { atomicAdd(&bar[XB_TMO], 1u); break; } }
        }
        asm volatile("s_waitcnt vmcnt(0)" ::: "memory");
    }
    __syncthreads();
}

__device__ __forceinline__ void p0_prologue(CArgs* A, LAS unsigned char* lds, int G, int vcu, int wave, int lane) {
    unsigned char* ws = A->ws;
    LAS float* scr = (LAS float*)(lds + wave * 16384);
    const int gw = vcu * NWAVES + wave, NGW = G * NWAVES;
    {
        const int tid = wave * 64 + lane;
        LAS f32x4* T = (LAS f32x4*)lds;
        { const float* W = A->in[3]; const float* gn = A->in[2];
          for (int idx = tid; idx < 4096; idx += NTHREADS) { const int k = idx >> 2, nq = idx & 3, j = k >> 8, lk = (k & 255) >> 2, e = k & 3;
              T[((j * 4 + e) * 4 + nq) * 64 + lk] = *(const f32x4*)(W + (size_t)k * ML_IN + 3072 + 4 * nq) * gn[k]; } }
        __syncthreads();
        const float* x = A->in[0]; bf16* hb = (bf16*)(ws + WS_HB); float* gates = (float*)(ws + WS_GATES); float* ssq0 = (float*)(ws + WS_SSQ0);
        const float bg = A->in[4][lane & 15];
        for (int m0 = gw * 4; m0 < M; m0 += NGW * 4) {
            f32x4 v[4][4]; float rstd[4];
#pragma unroll
            for (int r = 0; r < 4; ++r) { const f32x4* xr = (const f32x4*)(x + (size_t)(m0 + r) * D) + lane; float q = 0.f;
#pragma unroll
                for (int j = 0; j < 4; ++j) { v[r][j] = xr[64 * j]; q += (v[r][j][0] * v[r][j][0] + v[r][j][1] * v[r][j][1]) + (v[r][j][2] * v[r][j][2] + v[r][j][3] * v[r][j][3]); }
                const float qs = wave_sum(q, lane); rstd[r] = __builtin_amdgcn_rsqf(qs * (1.0f / D) + EPS);
                if (lane == 0) *(f32x4*)(ssq0 + (size_t)(m0 + r) * 4) = (f32x4){qs, 0.f, 0.f, 0.f};
                unsigned long long* o8 = (unsigned long long*)(hb + (size_t)(m0 + r) * D) + lane;
#pragma unroll
                for (int j = 0; j < 4; ++j) o8[64 * j] = (unsigned long long)pk2(v[r][j][0], v[r][j][1]) | ((unsigned long long)pk2(v[r][j][2], v[r][j][3]) << 32); }
            float o[64];
#pragma unroll
            for (int i = 0; i < 64; ++i) o[i] = 0.f;
#pragma unroll
            for (int j = 0; j < 4; ++j)
#pragma unroll
                for (int e = 0; e < 4; ++e)
#pragma unroll
                    for (int nq = 0; nq < 4; ++nq) { const f32x4 w = T[((j * 4 + e) * 4 + nq) * 64 + lane];
#pragma unroll
                        for (int r = 0; r < 4; ++r)
#pragma unroll
                            for (int i = 0; i < 4; ++i) o[r * 16 + nq * 4 + i] += v[r][j][e] * w[i];
                        if (nq == 3) asm volatile("" ::: "memory"); }
#define RED_STEP(OFF, N) _Pragma("unroll") for (int i = 0; i < (N) / 2; ++i) { const bool up = (lane & (OFF)) != 0; const float send = up ? o[i] : o[i + (N) / 2]; const float keep = up ? o[i + (N) / 2] : o[i]; o[i] = keep + shx(send, OFF, lane); }
            RED_STEP(32, 64) RED_STEP(16, 32) RED_STEP(8, 16) RED_STEP(4, 8) RED_STEP(2, 4) RED_STEP(1, 2)
#undef RED_STEP
            const int rr = lane >> 4; const float rsel = rr == 0 ? rstd[0] : (rr == 1 ? rstd[1] : (rr == 2 ? rstd[2] : rstd[3]));
            const float pre = o[0] * rsel + bg; const float t2 = __expf(pre * (2.0f / GATE_CAP)); const float cp = GATE_CAP * (t2 - 1.0f) * __builtin_amdgcn_rcpf(t2 + 1.0f);
            gates[(size_t)m0 * 16 + lane] = ((lane & 15) < 8) ? cp : -__logf(1.0f + __expf(-cp));
        }
        __syncthreads();
    }
    const bool all_here = !(SIDE_JOBS && MK_N_LAUNCHES == 1 && G == 256);
    for (int it = gw; it < WI_N0; it += NGW) weight_item(A, ws, scr, 0, it, lane);
    if (all_here) for (int it = gw; it < WI_N1; it += NGW) weight_item(A, ws, scr, 1, it, lane);
    { const size_t n8h = (size_t)M * PLE / 8 * (all_here ? 2 : 1);
      for (size_t g0 = (size_t)gw * 256; g0 < n8h; g0 += (size_t)NGW * 256) p_chunk(A, ws, g0, lane); }
    {
        float* rc = (float*)(ws + WS_ROPE); float* rsn = rc + SEQ * 8;
        const int gt = gw * 64 + lane;
        if (gt < SEQ * 8) { const int pos = gt >> 3, i = gt & 7;
            const float inv = (i == 0 ? 1.000000000e+00f : i == 1 ? 1.939227432e-01f : i == 2 ? 3.760603070e-02f : i == 3 ? 7.292664610e-03f : i == 4 ? 1.414213562e-03f : i == 5 ? 2.742481884e-04f : i == 6 ? 5.318295734e-05f : 1.031338525e-05f);
            const float angf = (float)pos * inv;
            const double rev = (double)angf * 0.15915494309189535; const double fr = rev - rint(rev);
            rc[gt] = __builtin_amdgcn_cosf((float)fr); rsn[gt] = __builtin_amdgcn_sinf((float)fr); }
    }
}

namespace ml {
template <int CTRL, int RMASK> __device__ __forceinline__ float dpp_f(float old, float v) { return __builtin_bit_cast(float, __builtin_amdgcn_update_dpp(__builtin_bit_cast(int, old), __builtin_bit_cast(int, v), CTRL, RMASK, 0xF, false)); }
__device__ __forceinline__ float scan_add64(float v) {
    v += dpp_f<0x111, 0xF>(0.f, v); v += dpp_f<0x112, 0xF>(0.f, v); v += dpp_f<0x114, 0xF>(0.f, v); v += dpp_f<0x118, 0xF>(0.f, v);
    v += dpp_f<0x142, 0xA>(0.f, v); v += dpp_f<0x143, 0xC>(0.f, v); return v; }
__device__ __forceinline__ float scan_max64(float v) {
    v = fmaxf(v, dpp_f<0x111, 0xF>(-INFINITY, v)); v = fmaxf(v, dpp_f<0x112, 0xF>(-INFINITY, v)); v = fmaxf(v, dpp_f<0x114, 0xF>(-INFINITY, v)); v = fmaxf(v, dpp_f<0x118, 0xF>(-INFINITY, v));
    v = fmaxf(v, dpp_f<0x142, 0xA>(-INFINITY, v)); v = fmaxf(v, dpp_f<0x143, 0xC>(-INFINITY, v)); return v; }
__device__ __forceinline__ float last64(float v) { return __builtin_bit_cast(float, __builtin_amdgcn_readlane(__builtin_bit_cast(int, v), 63)); }
typedef short bf16x8 __attribute__((ext_vector_type(8)));
typedef short s16x4 __attribute__((ext_vector_type(4)));
typedef short v4i16_t __attribute__((ext_vector_type(4)));
constexpr int KST = 160, VST = 288, QST = 144;
__device__ __forceinline__ s16x4 tr16(const LAS unsigned char* p) { return __builtin_bit_cast(s16x4, __builtin_amdgcn_ds_read_tr16_b64_v4i16((LAS v4i16_t*)p)); }
__device__ __forceinline__ bf16x8 cat8(s16x4 a, s16x4 b) { return (bf16x8){a[0], a[1], a[2], a[3], b[0], b[1], b[2], b[3]}; }
__device__ __forceinline__ bf16x8 trfrag(const LAS unsigned char* img, int stride, int ks, int col0, int c, int g) {
    const LAS unsigned char* p = img + (32 * ks + 4 * g + (c >> 2)) * stride + (col0 + 4 * (c & 3)) * 2;
    return cat8(tr16(p), tr16(p + 16 * stride));
}
__device__ __forceinline__ void st8(LAS unsigned char* d, float a, float b, float c, float e) { v2u w; w.x = pk2(a, b); w.y = pk2(c, e); *(LAS v2u*)d = w; }

__device__ __forceinline__ void phase_a(CArgs* A, LAS unsigned char* lds, int G, const int bx, const int tid) {
    unsigned char* ws = A->ws; const int lane = tid & 63, wid = __builtin_amdgcn_readfirstlane(tid >> 6), c = lane & 15, g = lane >> 4;
    LAS unsigned char* Ks = lds; LAS unsigned char* Vs = lds + 64 * KST; LAS float* wl = (LAS float*)(Vs + 64 * VST);
    const float* gates = (const float*)(ws + WS_GATES); const bf16* K0 = (const bf16*)(ws + WS_K0); const bf16* V0 = (const bf16*)(ws + WS_V0);
    bf16* cloc = (bf16*)(ws + WS_CLOC); float* nloc = (float*)(ws + WS_NLOC); float* mloc = (float*)(ws + WS_MLOC); float* glast = (float*)(ws + WS_GLAST);
    const int NU = NB_ * ML_H * ML_NC, srow = tid >> 3, pc = tid & 7;
    v4u kxA, vx0A, vx1A, kxB, vx0B, vx1B; float liA = 0.f, lfA = 0.f, liB = 0.f, lfB = 0.f;
    unsigned zz = 0u; asm volatile("" : "+v"(zz));
#define MLA_LOAD(S, unit) do { const int bh_ = (unit) >> 6, c_ = (unit) & 63, b_ = bh_ >> 3, h_ = bh_ & 7, r_ = b_ * SEQ + c_ * ML_L + srow; \
        kx##S = *(const v4u*)(K0 + (size_t)r_ * 512 + h_ * 64 + pc * 8); vx0##S = *(const v4u*)(V0 + (size_t)r_ * 1024 + h_ * 128 + pc * 16); vx1##S = *(const v4u*)(V0 + (size_t)r_ * 1024 + h_ * 128 + pc * 16 + 8); \
        if (tid < 64) { const size_t gr_ = (size_t)(b_ * SEQ + c_ * ML_L + tid) * 16; li##S = gates[gr_ + h_]; lf##S = gates[gr_ + 8 + h_]; } } while (0)
#define MLA_UNIT(S, unit) do { \
        if (tid < 64) { \
            const float gs = scan_add64(lf##S); const float gl = last64(gs); \
            const float a = gl - gs + li##S; const float ml = last64(scan_max64(a)); const float w_ = __expf(a - ml); \
            wl[tid] = w_; *(LAS v4u*)(Vs + tid * VST + 256) = (v4u){f2bf(w_), zz, zz, zz}; *(LAS v4u*)(Vs + tid * VST + 272) = (v4u){zz, zz, zz, zz};     \
            if (tid == 0) { mloc[unit] = ml; glast[unit] = gl; } \
        } \
        *(LAS v4u*)(Ks + srow * KST + pc * 16) = kx##S; \
        __syncthreads(); \
        { const float w = wl[srow]; v4u o0, o1; \
          o0.x = pk2(w * bf_lo(vx0##S.x), w * bf_hi(vx0##S.x)); o0.y = pk2(w * bf_lo(vx0##S.y), w * bf_hi(vx0##S.y)); o0.z = pk2(w * bf_lo(vx0##S.z), w * bf_hi(vx0##S.z)); o0.w = pk2(w * bf_lo(vx0##S.w), w * bf_hi(vx0##S.w)); \
          o1.x = pk2(w * bf_lo(vx1##S.x), w * bf_hi(vx1##S.x)); o1.y = pk2(w * bf_lo(vx1##S.y), w * bf_hi(vx1##S.y)); o1.z = pk2(w * bf_lo(vx1##S.z), w * bf_hi(vx1##S.z)); o1.w = pk2(w * bf_lo(vx1##S.w), w * bf_hi(vx1##S.w)); \
          *(LAS v4u*)(Vs + srow * VST + pc * 32) = o0; *(LAS v4u*)(Vs + srow * VST + pc * 32 + 16) = o1; } \
        __syncthreads(); \
        { const int nx2 = (unit) + 2 * ust; if (nx2 < NUE) MLA_LOAD(S, nx2); }                       \
        { bf16x8 bfr[2]; \
          _Pragma("unroll") for (int ks = 0; ks < 2; ++ks) bfr[ks] = trfrag(Vs, VST, ks, 16 * wid, c, g); \
          bf16* orow = cloc + ((size_t)(unit) * 128 + 16 * wid + c) * 64 + 4 * g; \
          _Pragma("unroll") for (int kt = 0; kt < 4; ++kt) { f32x4 acc = (f32x4){0.f, 0.f, 0.f, 0.f}; \
              _Pragma("unroll") for (int ks = 0; ks < 2; ++ks) acc = __builtin_amdgcn_mfma_f32_16x16x32_bf16(trfrag(Ks, KST, ks, 16 * kt, c, g), bfr[ks], acc, 0, 0, 0); \
              v2u w; w.x = pk2(acc[0], acc[1]); w.y = pk2(acc[2], acc[3]); *(v2u*)(orow + 16 * kt) = w; } \
          if (wid == 0) { _Pragma("unroll") for (int ks = 0; ks < 2; ++ks) bfr[ks] = trfrag(Vs, VST, ks, 128, c, g); \
              _Pragma("unroll") for (int kt = 0; kt < 4; ++kt) { f32x4 acc = (f32x4){0.f, 0.f, 0.f, 0.f}; \
                  _Pragma("unroll") for (int ks = 0; ks < 2; ++ks) acc = __builtin_amdgcn_mfma_f32_16x16x32_bf16(trfrag(Ks, KST, ks, 16 * kt, c, g), bfr[ks], acc, 0, 0, 0); \
                  if (c == 0) *(f32x4*)(nloc + (size_t)(unit) * 64 + 16 * kt + 4 * g) = acc; } } } \
        __syncthreads(); } while (0)
    const bool bl = (G == 256); const int ust = bl ? 32 : G, NUE = bl ? 512 * (bx & 7) + 512 : NU;
    int unit = bl ? 512 * (bx & 7) + (bx >> 3) : bx;
    if (unit < NUE) MLA_LOAD(A, unit);
    if (unit + ust < NUE) MLA_LOAD(B, unit + ust);
    for (;;) {
        if (unit >= NUE) break;
        MLA_UNIT(A, unit); unit += ust;
        if (unit >= NUE) break;
        MLA_UNIT(B, unit); unit += ust;
    }
#undef MLA_LOAD
#undef MLA_UNIT
}
__device__ __forceinline__ void phase_scan(CArgs* A, int G, const int bx, const int tid) {
    unsigned char* ws = A->ws;
    bf16* cloc = (bf16*)(ws + WS_CLOC); float* nloc = (float*)(ws + WS_NLOC); const float* mloc = (const float*)(ws + WS_MLOC); const float* glast = (const float*)(ws + WS_GLAST); float* mprev = (float*)(ws + WS_MPREV);
    for (int su = (G == 256) ? 32 * (bx & 7) + (bx >> 3) : bx; su < 64 * 4; su += G) {
        const int bh = su >> 2, qt = su & 3;
        bf16* cp = cloc + (size_t)bh * 64 * 8192 + qt * 2048 + tid * 4;
        float C0 = 0.f, C1 = 0.f, C2 = 0.f, C3 = 0.f, n = 0.f, m = 0.f;
#pragma unroll 1
        for (int c0 = 0; c0 < 64; c0 += 8) {
            v2u cl[8]; float ml[8], gl[8], nl[8];
#pragma unroll
            for (int i = 0; i < 8; ++i) { cl[i] = *(const v2u*)(cp + (size_t)(c0 + i) * 8192); ml[i] = mloc[bh * 64 + c0 + i]; gl[i] = glast[bh * 64 + c0 + i];
                nl[i] = (qt == 0 && tid < 64) ? nloc[(size_t)(bh * 64 + c0 + i) * 64 + tid] : 0.f; }
#pragma unroll
            for (int i = 0; i < 8; ++i) {
                const float mn = fmaxf(gl[i] + m, ml[i]), sp = __expf(gl[i] + m - mn), sl = __expf(ml[i] - mn);
                v2u o; o.x = pk2(C0, C1); o.y = pk2(C2, C3); *(v2u*)(cp + (size_t)(c0 + i) * 8192) = o;
                C0 = sp * C0 + sl * bf_lo(cl[i].x); C1 = sp * C1 + sl * bf_hi(cl[i].x); C2 = sp * C2 + sl * bf_lo(cl[i].y); C3 = sp * C3 + sl * bf_hi(cl[i].y);
                if (qt == 0 && tid < 64) { nloc[(size_t)(bh * 64 + c0 + i) * 64 + tid] = n; n = sp * n + sl * nl[i]; }
                if (qt == 0 && tid == 0) mprev[bh * 64 + c0 + i] = m;
                m = mn;
            }
        }
    }
}
__device__ __forceinline__ void phase_c(CArgs* A, LAS unsigned char* lds, int G, const int bx, const int tid) {
    unsigned char* ws = A->ws; const int lane = tid & 63, wid = __builtin_amdgcn_readfirstlane(tid >> 6), c = lane & 15, g = lane >> 4, jt = wid & 3, vh = wid >> 2;
    LAS unsigned char* Qs = lds; LAS unsigned char* Ks = Qs + 64 * QST; LAS unsigned char* Cs = Ks + 64 * QST; LAS unsigned char* Vs = Cs + 128 * QST; LAS unsigned char* Os = Vs + 64 * VST;
    LAS float* sc = (LAS float*)(Os + 64 * VST);
    const float* gates = (const float*)(ws + WS_GATES); const bf16* Q0 = (const bf16*)(ws + WS_Q0); const bf16* K0 = (const bf16*)(ws + WS_K0); const bf16* V0 = (const bf16*)(ws + WS_V0);
    const bf16* OG = (const bf16*)(ws + WS_OG); bf16* HC = (bf16*)(ws + WS_V0);
    const bf16* cprev = (const bf16*)(ws + WS_CLOC); const float* nprev = (const float*)(ws + WS_NLOC); const float* mprev = (const float*)(ws + WS_MPREV);
    const float* mh_gain = A->in[5];
    const int NU = NB_ * ML_H * ML_NC, srow = tid >> 3, pc = tid & 7;
    v4u qx, kx, vx0, vx1, cx0, cx1, ox0, ox1; float li = 0.f, lf = 0.f, mp = 0.f, np = 0.f;
#define MLC_LOAD(unit) do { const int bh_ = (unit) >> 6, c_ = (unit) & 63, b_ = bh_ >> 3, h_ = bh_ & 7, r_ = b_ * SEQ + c_ * ML_L + srow; \
        qx = *(const v4u*)(Q0 + (size_t)r_ * 512 + h_ * 64 + pc * 8); kx = *(const v4u*)(K0 + (size_t)r_ * 512 + h_ * 64 + pc * 8); \
        vx0 = *(const v4u*)(V0 + (size_t)r_ * 1024 + h_ * 128 + pc * 16); vx1 = *(const v4u*)(V0 + (size_t)r_ * 1024 + h_ * 128 + pc * 16 + 8); \
        ox0 = *(const v4u*)(OG + (size_t)r_ * 1024 + h_ * 128 + pc * 16); ox1 = *(const v4u*)(OG + (size_t)r_ * 1024 + h_ * 128 + pc * 16 + 8); \
        cx0 = *(const v4u*)(cprev + (size_t)(unit) * 8192 + tid * 16); cx1 = *(const v4u*)(cprev + (size_t)(unit) * 8192 + tid * 16 + 8); \
        if (tid < 64) { const size_t gr_ = (size_t)(b_ * SEQ + c_ * ML_L + tid) * 16; li = gates[gr_ + h_]; lf = gates[gr_ + 8 + h_]; mp = mprev[unit]; np = nprev[(size_t)(unit) * 64 + tid]; } } while (0)
    const bool bl = (G == 256); const int ust = bl ? 32 : G, NUE = bl ? 512 * (bx & 7) + 512 : NU;
    int unit = bl ? 512 * (bx & 7) + (bx >> 3) : bx;
    if (unit < NUE) MLC_LOAD(unit);
    for (; unit < NUE; unit += ust) {
        const int bh = unit >> 6, cc = unit & 63, b = bh >> 3, h = bh & 7, row0 = b * SEQ + cc * ML_L;
        if (tid < 64) {
            const float gs = scan_add64(lf); const float pm = scan_max64(li - gs);
            const float mintra = gs + pm, minter = gs + mp, mc = fmaxf(minter, mintra);
            sc[tid] = gs - mc; sc[64 + tid] = li - gs; sc[128 + tid] = __expf(minter - mc); sc[192 + tid] = __expf(-mc); sc[256 + tid] = np;
        }
        *(LAS v4u*)(Qs + srow * QST + pc * 16) = qx; *(LAS v4u*)(Ks + srow * QST + pc * 16) = kx;
        *(LAS v4u*)(Vs + srow * VST + pc * 32) = vx0; *(LAS v4u*)(Vs + srow * VST + pc * 32 + 16) = vx1;
        *(LAS v4u*)(Os + srow * VST + pc * 32) = ox0; *(LAS v4u*)(Os + srow * VST + pc * 32 + 16) = ox1;
        { const int cv = tid >> 2, cp = (tid & 3) * 2; *(LAS v4u*)(Cs + cv * QST + cp * 16) = cx0; *(LAS v4u*)(Cs + cv * QST + cp * 16 + 16) = cx1; }
        __syncthreads();
        const int nxt = unit + ust;
        if (nxt < NUE) MLC_LOAD(nxt);
        const int j = 16 * jt + c;
        bf16x8 qf[2];
#pragma unroll
        for (int ks = 0; ks < 2; ++ks) qf[ks] = *(const LAS bf16x8*)(Qs + j * QST + (32 * ks + 8 * g) * 2);
        f32x4 p[4]; float rs = 0.f; const float uj = sc[j];
#pragma unroll
        for (int st = 0; st < 4; ++st) { f32x4 acc = (f32x4){0.f, 0.f, 0.f, 0.f};
#pragma unroll
            for (int ks = 0; ks < 2; ++ks) acc = __builtin_amdgcn_mfma_f32_16x16x32_bf16(*(const LAS bf16x8*)(Ks + (16 * st + c) * QST + (32 * ks + 8 * g) * 2), qf[ks], acc, 0, 0, 0);
            const f32x4 tt = *(const LAS f32x4*)(sc + 64 + 16 * st + 4 * g);
#pragma unroll
            for (int r = 0; r < 4; ++r) { const int s = 16 * st + 4 * g + r; const float v = (s <= j) ? acc[r] * __expf(uj + tt[r]) : 0.f; p[st][r] = v; rs += v; } }
        bf16x8 pb[2];
#pragma unroll
        for (int ks = 0; ks < 2; ++ks) { v4u w; w.x = pk2(p[2 * ks][0], p[2 * ks][1]); w.y = pk2(p[2 * ks][2], p[2 * ks][3]); w.z = pk2(p[2 * ks + 1][0], p[2 * ks + 1][1]); w.w = pk2(p[2 * ks + 1][2], p[2 * ks + 1][3]); pb[ks] = __builtin_bit_cast(bf16x8, w); }
        f32x4 hh[4]; const float wi = sc[128 + j];
#pragma unroll
        for (int vt = 0; vt < 4; ++vt) { f32x4 acc = (f32x4){0.f, 0.f, 0.f, 0.f};
#pragma unroll
            for (int ks = 0; ks < 2; ++ks) acc = __builtin_amdgcn_mfma_f32_16x16x32_bf16(*(const LAS bf16x8*)(Cs + (64 * vh + 16 * vt + c) * QST + (32 * ks + 8 * g) * 2), qf[ks], acc, 0, 0, 0);
            acc = acc * wi;
#pragma unroll
            for (int ks = 0; ks < 2; ++ks) acc = __builtin_amdgcn_mfma_f32_16x16x32_bf16(trfrag(Vs, VST, ks, 64 * vh + 16 * vt, c, g), pb[ks], acc, 0, 0, 0);
            hh[vt] = acc; }
        float qn = 0.f;
        { const v4u q0 = *(const LAS v4u*)(Qs + j * QST + 32 * g), q1 = *(const LAS v4u*)(Qs + j * QST + 32 * g + 16); const LAS f32x4* nv = (const LAS f32x4*)(sc + 256 + 16 * g);
          const f32x4 n0 = nv[0], n1 = nv[1], n2 = nv[2], n3 = nv[3];
          qn = (bf_lo(q0.x) * n0[0] + bf_hi(q0.x) * n0[1] + bf_lo(q0.y) * n0[2] + bf_hi(q0.y) * n0[3]) + (bf_lo(q0.z) * n1[0] + bf_hi(q0.z) * n1[1] + bf_lo(q0.w) * n1[2] + bf_hi(q0.w) * n1[3])
             + (bf_lo(q1.x) * n2[0] + bf_hi(q1.x) * n2[1] + bf_lo(q1.y) * n2[2] + bf_hi(q1.y) * n2[3]) + (bf_lo(q1.z) * n3[0] + bf_hi(q1.z) * n3[1] + bf_lo(q1.w) * n3[2] + bf_hi(q1.w) * n3[3]); }
        qn += shx(qn, 16, lane); qn += shx(qn, 32, lane); rs += shx(rs, 16, lane); rs += shx(rs, 32, lane);
        const float inv = 1.0f / fmaxf(fabsf(wi * qn + rs), sc[192 + j]);
        float ss = 0.f;
#pragma unroll
        for (int vt = 0; vt < 4; ++vt) { hh[vt] = hh[vt] * inv; ss += (hh[vt][0] * hh[vt][0] + hh[vt][1] * hh[vt][1]) + (hh[vt][2] * hh[vt][2] + hh[vt][3] * hh[vt][3]); }
        ss += shx(ss, 16, lane); ss += shx(ss, 32, lane);
        if (g == 0) sc[320 + 64 * vh + j] = ss;
        __syncthreads();
        const float rn = __builtin_amdgcn_rsqf((sc[320 + j] + sc[384 + j]) * (1.0f / ML_DV) + EPS);
#pragma unroll
        for (int vt = 0; vt < 4; ++vt) { const int v0 = 64 * vh + 16 * vt + 4 * g; const v2u ow = *(const LAS v2u*)(Os + j * VST + v0 * 2); const f32x4 gn = *(const f32x4*)(mh_gain + v0);
            st8(Vs + j * VST + v0 * 2, hh[vt][0] * rn * gn[0] * sigmoidf_(bf_lo(ow.x)), hh[vt][1] * rn * gn[1] * sigmoidf_(bf_hi(ow.x)), hh[vt][2] * rn * gn[2] * sigmoidf_(bf_lo(ow.y)), hh[vt][3] * rn * gn[3] * sigmoidf_(bf_hi(ow.y))); }
        __syncthreads();
        { const v4u o0 = *(const LAS v4u*)(Vs + srow * VST + pc * 32), o1 = *(const LAS v4u*)(Vs + srow * VST + pc * 32 + 16); bf16* op = HC + (size_t)(row0 + srow) * 1024 + h * 128 + pc * 16;
          *(v4u*)op = o0; *(v4u*)(op + 8) = o1; }
        __syncthreads();
    }
#undef MLC_LOAD
}
}

namespace mattn {
using bf16=__hip_bfloat16;
using bf16x8=__attribute__((ext_vector_type(8)))short;
using s16x4=__attribute__((ext_vector_type(4)))short;
using f32x16=__attribute__((ext_vector_type(16)))float;
using u32x4=__attribute__((ext_vector_type(4)))unsigned;
constexpr int BATCH=8,NHEAD=16,SEQ=4096,D=64,DM=NHEAD*D,KP=256;
constexpr int NW=8,QBLK=32,QB=QBLK*NW,KVBLK=64,NQB=SEQ/QB;
constexpr int ATTN_PITCH=DM, ATTN_UNIT_ROWS=QB;
__device__ __forceinline__ int crow(int r,int hi){return (r&3)+8*(r>>2)+4*hi;}
#define SBAR() __builtin_amdgcn_sched_barrier(0)
__device__ __forceinline__ void cmask(f32x16&p0,f32x16&p1,int jb,int qrel,int hi){
  asm volatile("":"+v"(hi),"+v"(qrel));
  const float NEG=-INFINITY; int kb=64*jb+4*hi;
  #pragma unroll
  for(int r=0;r<16;++r){int kv=kb+(r&3)+8*(r>>2); if(kv>qrel)p0[r]=NEG; if(kv+32>qrel)p1[r]=NEG;}
}

constexpr int NSLOT=3, SLOTB=8192;
constexpr int LDS_K=0, LDS_V=NSLOT*SLOTB, LDS_WS=2*NSLOT*SLOTB, LDS_OST=LDS_WS+NW*64*4, LDS_KM=LDS_OST+NW*4096, LDS_BYTES=LDS_KM+4096;
constexpr float C2=0.125f*1.4426950408889634f;
__device__ __forceinline__ void glds16(const void*sbase,unsigned voff,unsigned lds_dst){unsigned keep;
  asm volatile("s_nop 4\n\ts_mov_b32 %0, m0\n\ts_mov_b32 m0, %3\n\ts_nop 0\n\tglobal_load_lds_dwordx4 %1, %2\n\ts_mov_b32 m0, %0":"=&s"(keep):"v"(voff),"s"(sbase),"s"(lds_dst):"memory");}
__device__ __forceinline__ float max3f(float a,float b,float c){float r;asm("v_max3_f32 %0, %1, %2, %3":"=v"(r):"v"(a),"v"(b),"v"(c));return r;}
__device__ __forceinline__ float max2f(float a,float b){float r;asm("v_max_f32_e32 %0, %1, %2":"=v"(r):"v"(a),"v"(b));return r;}
__device__ __forceinline__ float fadd_s(float a,float b){float r;asm("v_add_f32_e32 %0, %1, %2":"=v"(r):"v"(a),"v"(b));return r;}
__device__ __forceinline__ float fsub_s(float a,float b){float r;asm("v_sub_f32_e32 %0, %1, %2":"=v"(r):"v"(a),"v"(b));return r;}
typedef float f32x2_t __attribute__((ext_vector_type(2))); typedef __bf16 bf16x2_t __attribute__((ext_vector_type(2)));
__device__ __forceinline__ unsigned cvtpk_s(float lo,float hi){f32x2_t v={lo,hi};bf16x2_t b=__builtin_convertvector(v,bf16x2_t);return __builtin_bit_cast(unsigned,b);}
#define WAIT_BAR(N) asm volatile("s_waitcnt vmcnt(" #N ") lgkmcnt(0)\n\ts_barrier":::"memory")

__device__ __forceinline__ void qkt(f32x16&p0,f32x16&p1,const char*Kslot,const bf16x8*qr,const f32x16&negm,int r32,int hi){
  const char*kb=Kslot+hi*1024+r32*16;
  #pragma unroll
  for(int d0=0;d0<4;++d0){
    const bf16x8 b0=*reinterpret_cast<const bf16x8*>(kb+d0*2048);
    const bf16x8 b1=*reinterpret_cast<const bf16x8*>(kb+d0*2048+512);
    if(d0==0){p0=__builtin_amdgcn_mfma_f32_32x32x16_bf16(b0,qr[0],negm,0,0,0);p1=__builtin_amdgcn_mfma_f32_32x32x16_bf16(b1,qr[0],negm,0,0,0);}
    else{p0=__builtin_amdgcn_mfma_f32_32x32x16_bf16(b0,qr[d0],p0,0,0,0);p1=__builtin_amdgcn_mfma_f32_32x32x16_bf16(b1,qr[d0],p1,0,0,0);}}
}
typedef __attribute__((address_space(3))) const char* lds_cptr;
typedef short v4i16_t __attribute__((ext_vector_type(4)));
__device__ __forceinline__ void kload8(bf16x8*kf,lds_cptr kp){
  kf[0]=*(const __attribute__((address_space(3))) bf16x8*)(kp);      kf[1]=*(const __attribute__((address_space(3))) bf16x8*)(kp+512);
  kf[2]=*(const __attribute__((address_space(3))) bf16x8*)(kp+2048); kf[3]=*(const __attribute__((address_space(3))) bf16x8*)(kp+2560);
  kf[4]=*(const __attribute__((address_space(3))) bf16x8*)(kp+4096); kf[5]=*(const __attribute__((address_space(3))) bf16x8*)(kp+4608);
  kf[6]=*(const __attribute__((address_space(3))) bf16x8*)(kp+6144); kf[7]=*(const __attribute__((address_space(3))) bf16x8*)(kp+6656);
}
__device__ __forceinline__ void kload2(bf16x8*kf,lds_cptr kp,int j){ kf[2*j]=*(const __attribute__((address_space(3))) bf16x8*)(kp+j*2048); kf[2*j+1]=*(const __attribute__((address_space(3))) bf16x8*)(kp+j*2048+512); }
__device__ __forceinline__ s16x4 vtr(lds_cptr p){ return __builtin_bit_cast(s16x4,__builtin_amdgcn_ds_read_tr16_b64_v4i16((__attribute__((address_space(3))) v4i16_t*)p)); }
__device__ __forceinline__ float rowmax(const f32x16&p0,const f32x16&p1){
  float a=max3f(p0[0],p0[1],p1[0]),b=max3f(p0[2],p0[3],p1[1]);a=max3f(a,p1[2],p1[3]);
  #pragma unroll
  for(int r=4;r<16;r+=4){a=max3f(a,p0[r],p0[r+1]);b=max3f(b,p0[r+2],p0[r+3]);a=max3f(a,p1[r],p1[r+1]);b=max3f(b,p1[r+2],p1[r+3]);}
  const float m=max2f(a,b);
  auto rr=__builtin_amdgcn_permlane32_swap(__float_as_uint(m),__float_as_uint(m),false,false);
  return max2f(__uint_as_float(rr[0]),__uint_as_float(rr[1]));
}
__device__ __forceinline__ void pv(f32x16*o,int vb,bf16x8 pa0,bf16x8 pa1,bf16x8 pa2,bf16x8 pa3){
  #pragma unroll
  for(int d0=0;d0<2;++d0){s16x4 lo[4],hi[4];
    #pragma unroll
    for(int ks=0;ks<4;++ks){
      asm volatile("ds_read_b64_tr_b16 %0,%1 offset:%c2":"=&v"(lo[ks]):"v"(vb),"i"(d0*4096+ks*1024):"memory");
      asm volatile("ds_read_b64_tr_b16 %0,%1 offset:%c2":"=&v"(hi[ks]):"v"(vb),"i"(d0*4096+ks*1024+512):"memory");}
    asm volatile("s_waitcnt lgkmcnt(0)":::"memory");SBAR();
    #define PK(k) (bf16x8){lo[k][0],lo[k][1],lo[k][2],lo[k][3],hi[k][0],hi[k][1],hi[k][2],hi[k][3]}
    o[d0]=__builtin_amdgcn_mfma_f32_32x32x16_bf16(pa0,PK(0),o[d0],0,0,0);
    o[d0]=__builtin_amdgcn_mfma_f32_32x32x16_bf16(pa1,PK(1),o[d0],0,0,0);
    o[d0]=__builtin_amdgcn_mfma_f32_32x32x16_bf16(pa2,PK(2),o[d0],0,0,0);
    o[d0]=__builtin_amdgcn_mfma_f32_32x32x16_bf16(pa3,PK(3),o[d0],0,0,0);
    #undef PK
  }
}

#ifndef ATTN_STORE16
#define ATTN_STORE16(p,v) (*(u32x4*)(p)=(v))
#endif
__device__ __forceinline__ void attn_unit(int b,int h,int qb,const bf16*Q,const bf16*__restrict__ K,const bf16*__restrict__ V,bf16*O,char*shm,const float*kmsum,const float mref,const bool fill_km,const int tid){
  const int lane=tid&63,r32=lane&31,hi=lane>>5; const int wid=__builtin_amdgcn_readfirstlane(tid>>6);
  const long rowbase=(long)b*SEQ; const int q0=qb*QB;
  const bf16*Qw=Q+(rowbase+q0+wid*QBLK)*DM+h*D;
  const bf16*Kh=K+rowbase*KP+(h>>2)*D,*Vh=V+rowbase*KP+(h>>2)*D;
  const lds_cptr shm3=(lds_cptr)shm;
  const unsigned lds0=(unsigned)(uintptr_t)shm;
  float*wsf=(float*)(shm+LDS_WS)+wid*64;
  const unsigned kvoff=(unsigned)(lane*KP+wid*8)*2u;
  const unsigned vvoff=(unsigned)((16*(wid&3)+(lane>>2))*KP+(wid>>2)*32+(lane&3)*8)*2u;
  const unsigned kdst=lds0+LDS_K+wid*1024, vdst=lds0+LDS_V+wid*1024;
  #define DMA_K(t,slot) glds16(Kh+(long)(t)*KVBLK*KP,kvoff,(unsigned)__builtin_amdgcn_readfirstlane(kdst+(slot)))
  #define DMA_V(t,slot) glds16(Vh+(long)(t)*KVBLK*KP,vvoff,(unsigned)__builtin_amdgcn_readfirstlane(vdst+(slot)))
  const int vb0=(int)(lds0+LDS_V)+((lane>>4)&1)*32+(lane&3)*8+(4*hi+((lane&15)>>2))*64;
  const char*Kbase=shm+LDS_K; bf16x8 kf[8];
  const lds_cptr kp0=shm3+LDS_K+hi*1024+r32*16; const lds_cptr vp0=shm3+LDS_V+((lane>>4)&1)*32+(lane&3)*8+(4*hi+((lane&15)>>2))*64;
  const int NT=(q0+QB)/KVBLK;
  typedef __attribute__((address_space(3))) float ldsf;
  if(fill_km){ const float*ks0=kmsum+((size_t)b*16*4+(h>>2))*64;
    typedef __attribute__((address_space(3))) unsigned short ldsh;
    #pragma unroll
    for(int i=0;i<2;++i){const int idx=tid+512*i,n=idx>>6,d=idx&63; const float v=ks0[(size_t)n*256+d];
      const unsigned hb=cvtpk_s(v,0.f)&0xffffu; const unsigned lb=cvtpk_s(v-__uint_as_float(hb<<16),0.f)&0xffffu;
      ldsh*kp_=(ldsh*)(shm3+LDS_KM+(d>>3)*512+(d&7)*2); kp_[n*8]=(unsigned short)hb; kp_[(16+n)*8]=(unsigned short)lb;}
    asm volatile("s_waitcnt vmcnt(0) lgkmcnt(0)\n\ts_barrier":::"memory"); }
  DMA_K(0,0);DMA_V(0,0);DMA_K(1,SLOTB);
  bf16x8 qr[4];
  #pragma unroll
  for(int d0=0;d0<4;++d0)qr[d0]=*reinterpret_cast<const bf16x8*>(&Qw[(long)r32*DM+d0*16+hi*8]);
  unsigned selm=1u<<qb;
  if(qb>0){
    f32x16 gp;
    const lds_cptr kmp=shm3+LDS_KM+hi*512+r32*16;
    #pragma unroll
    for(int d0=0;d0<4;++d0){ const bf16x8 a=*(const __attribute__((address_space(3))) bf16x8*)(kmp+d0*1024);
      if(d0==0)gp=__builtin_amdgcn_mfma_f32_32x32x16_bf16(a,qr[0],f32x16{},0,0,0); else gp=__builtin_amdgcn_mfma_f32_32x32x16_bf16(a,qr[d0],gp,0,0,0); }
    float g[16];
    #pragma unroll
    for(int j=0;j<8;++j){ const float sg=gp[j]+gp[j+8]; const int n0=(j&3)+8*(j>>2);
      auto rr=__builtin_amdgcn_permlane32_swap(__float_as_uint(sg),__float_as_uint(sg),false,false);
      g[n0]=(n0<qb)?__uint_as_float(rr[0]):-INFINITY; g[n0+4]=(n0+4<qb)?__uint_as_float(rr[1]):-INFINITY; }
    #pragma unroll
    for(int r=0;r<3;++r){ float best=-INFINITY; int bi=0;
      #pragma unroll
      for(int n=0;n<15;++n)if(g[n]>best){best=g[n];bi=n;}
      if(best>-INFINITY)selm|=1u<<bi;
      #pragma unroll
      for(int n=0;n<15;++n)g[n]=(n==bi)?-INFINITY:g[n]; }
  }
  float l_reg=0.f;f32x16 o[2];o[0]=f32x16{};o[1]=f32x16{};f32x16 negm;
  #define SETNEG(t) do{ const float v_=((selm>>((t)>>2))&1u)?-mref:-INFINITY; _Pragma("unroll") for(int r=0;r<16;++r)negm[r]=v_; asm volatile("":"+v"(negm)); }while(0)
  SETNEG(0);
  const int qrel=wid*QBLK+r32;
  #define CMASK(P0,P1,t) do{int jb_=(t)-(NT-4); if(jb_>=0)cmask(P0,P1,jb_,qrel,hi);}while(0)
  #define START(P0,P1) do{ _Pragma("unroll") for(int r=0;r<16;++r)P0[r]=__builtin_amdgcn_exp2f(P0[r]); }while(0)
  #define RESC() do{}while(0)
  f32x16 pA0,pA1,pB0,pB1;
  int sl_prev=0,sl_cur=0,sl_next=SLOTB;
  #define ROT() do{sl_prev=sl_cur;sl_cur=sl_next;sl_next=(sl_next==(NSLOT-1)*SLOTB)?0:sl_next+SLOTB;}while(0)
  DMA_K(2,2*SLOTB);
  WAIT_BAR(3);
  qkt(pA0,pA1,Kbase,qr,negm,r32,hi);asm volatile("s_nop 15\n\ts_nop 7":"+v"(pA0),"+v"(pA1));CMASK(pA0,pA1,0);
  START(pA0,pA1);
  _Pragma("unroll") for(int r=0;r<16;++r)pA1[r]=__builtin_amdgcn_exp2f(pA1[r]);
  WAIT_BAR(0);
  DMA_K(3,0);DMA_V(1,SLOTB);
  ROT();
  kload8(kf,kp0+sl_cur);
  WAIT_BAR(2);
  s16x4 vlo[8],vhi[8]; u32x4 pw0,pw1,pw2,pw3;
  #define PKW(P,B) cvtpk_s(P[B],P[B+1])
  #define PAF(k) __builtin_bit_cast(bf16x8,pw##k)
  #define VFR(i) (bf16x8){vlo[i][0],vlo[i][1],vlo[i][2],vlo[i][3],vhi[i][0],vhi[i][1],vhi[i][2],vhi[i][3]}
  #define PIN(x) asm volatile("":"+v"(x))
  #define MX3(a,b,c) __builtin_fmaxf(__builtin_fmaxf((a),(b)),(c))
  #define GAPA(MF,A0,A1,A2,A3,W0,W1,PW) do{ MF; sacc+=A0; sacc+=A1; sacc+=A2; sacc+=A3; PIN(sacc); W0; W1; PIN(PW); SBAR(); }while(0)
  #define EX(v) __builtin_amdgcn_exp2f(v)
  #define GAPB(MF,X,B) do{ MF; X[B]=EX(X[B]); X[B+1]=EX(X[B+1]); X[B+2]=EX(X[B+2]); X[B+3]=EX(X[B+3]); PIN(X); SBAR(); }while(0)
  #define VRD(i) do{ vlo[i]=vtr(vp_+(((i)>>2)*4096+((i)&3)*1024)); vhi[i]=vtr(vp_+(((i)>>2)*4096+((i)&3)*1024+512)); }while(0)
  #define KRD(G,j) do{ if(G){ kload2(kf,kp0+sl_next,j); SBAR(); } }while(0)
  #define STEP(C0,C1,P0,P1,t,GK,GV,GL) do{ if((((t))&3)==0){SETNEG(t);} SBAR(); \
    const lds_cptr vp_=vp0+sl_prev; \
    VRD(0); SBAR(); float sacc=(P0[0]+P0[1]); \
    GAPA(C0=__builtin_amdgcn_mfma_f32_32x32x16_bf16(kf[0],qr[0],negm,0,0,0), P0[2],P0[3],P0[4],P0[5],     pw0[0]=PKW(P0,0), pw0[1]=PKW(P0,2), pw0); \
    VRD(4); SBAR(); GAPA(C1=__builtin_amdgcn_mfma_f32_32x32x16_bf16(kf[1],qr[0],negm,0,0,0), P0[6],P0[7],P0[8],P0[9],     pw0[2]=PKW(P0,4), pw0[3]=PKW(P0,6), pw0); \
    VRD(1); SBAR(); GAPA(C0=__builtin_amdgcn_mfma_f32_32x32x16_bf16(kf[2],qr[1],C0,0,0,0),   P0[10],P0[11],P0[12],P0[13], pw1[0]=PKW(P0,8), pw1[1]=PKW(P0,10), pw1); \
    VRD(5); SBAR(); GAPA(C1=__builtin_amdgcn_mfma_f32_32x32x16_bf16(kf[3],qr[1],C1,0,0,0),   P0[14],P0[15],P1[0],P1[1],   pw1[2]=PKW(P0,12),pw1[3]=PKW(P0,14), pw1); \
    VRD(2); SBAR(); GAPA(C0=__builtin_amdgcn_mfma_f32_32x32x16_bf16(kf[4],qr[2],C0,0,0,0),   P1[2],P1[3],P1[4],P1[5],     pw2[0]=PKW(P1,0), pw2[1]=PKW(P1,2), pw2); \
    VRD(6); SBAR(); GAPA(C1=__builtin_amdgcn_mfma_f32_32x32x16_bf16(kf[5],qr[2],C1,0,0,0),   P1[6],P1[7],P1[8],P1[9],     pw2[2]=PKW(P1,4), pw2[3]=PKW(P1,6), pw2); \
    VRD(3); SBAR(); GAPA(C0=__builtin_amdgcn_mfma_f32_32x32x16_bf16(kf[6],qr[3],C0,0,0,0),   P1[10],P1[11],P1[12],P1[13], pw3[0]=PKW(P1,8), pw3[1]=PKW(P1,10), pw3); \
    VRD(7); SBAR(); GAPA(C1=__builtin_amdgcn_mfma_f32_32x32x16_bf16(kf[7],qr[3],C1,0,0,0),   P1[14],P1[15],0.f,0.f,       pw3[2]=PKW(P1,12),pw3[3]=PKW(P1,14), pw3); \
    l_reg+=sacc; \
    if(GK){DMA_K((t)+3,sl_cur);} if(GV){DMA_V((t)+1,sl_next);} \
    CMASK(C0,C1,t); \
    SBAR(); \
    GAPB(o[0]=__builtin_amdgcn_mfma_f32_32x32x16_bf16(PAF(0),VFR(0),o[0],0,0,0), C0,0); \
    GAPB(o[1]=__builtin_amdgcn_mfma_f32_32x32x16_bf16(PAF(0),VFR(4),o[1],0,0,0), C0,4); \
    KRD(GL,0); GAPB(o[0]=__builtin_amdgcn_mfma_f32_32x32x16_bf16(PAF(1),VFR(1),o[0],0,0,0), C0,8); \
    KRD(GL,1); GAPB(o[1]=__builtin_amdgcn_mfma_f32_32x32x16_bf16(PAF(1),VFR(5),o[1],0,0,0), C0,12); \
    KRD(GL,2); GAPB(o[0]=__builtin_amdgcn_mfma_f32_32x32x16_bf16(PAF(2),VFR(2),o[0],0,0,0), C1,0); \
    KRD(GL,3); GAPB(o[1]=__builtin_amdgcn_mfma_f32_32x32x16_bf16(PAF(2),VFR(6),o[1],0,0,0), C1,4); \
    GAPB(o[0]=__builtin_amdgcn_mfma_f32_32x32x16_bf16(PAF(3),VFR(3),o[0],0,0,0), C1,8); \
    GAPB(o[1]=__builtin_amdgcn_mfma_f32_32x32x16_bf16(PAF(3),VFR(7),o[1],0,0,0), C1,12); \
    }while(0)
  int t=1;
  #undef CMASK
  #define CMASK(P0,P1,t) do{}while(0)
  for(;t+5<NT;t+=2){
    STEP(pB0,pB1,pA0,pA1,t,true,true,true);     WAIT_BAR(2); RESC(); ROT();
    STEP(pA0,pA1,pB0,pB1,t+1,true,true,true);   WAIT_BAR(2); RESC(); ROT();
  }
  #undef CMASK
  #define CMASK(P0,P1,t) do{int jb_=(t)-(NT-4); if(jb_>=0)cmask(P0,P1,jb_,qrel,hi);}while(0)
  #define ENDW(tt) do{ if((tt)+3<NT){WAIT_BAR(2);} else if((tt)+2<NT){WAIT_BAR(1);} else {WAIT_BAR(0);} }while(0)
  for(;t+1<NT;t+=2){
    STEP(pB0,pB1,pA0,pA1,t,(t+3<NT),(t+1<NT),(t+1<NT));       ENDW(t);   RESC(); ROT();
    STEP(pA0,pA1,pB0,pB1,t+1,(t+4<NT),(t+2<NT),(t+2<NT));     ENDW(t+1); RESC(); ROT();
  }
  STEP(pB0,pB1,pA0,pA1,NT-1,false,false,false); RESC();
  { float sacc=pB0[0]+pB0[1]; _Pragma("unroll") for(int r=2;r<16;++r)sacc+=pB0[r]; _Pragma("unroll") for(int r=0;r<16;++r)sacc+=pB1[r]; l_reg+=sacc;
    pw0=(u32x4){PKW(pB0,0),PKW(pB0,2),PKW(pB0,4),PKW(pB0,6)};pw1=(u32x4){PKW(pB0,8),PKW(pB0,10),PKW(pB0,12),PKW(pB0,14)};pw2=(u32x4){PKW(pB1,0),PKW(pB1,2),PKW(pB1,4),PKW(pB1,6)};pw3=(u32x4){PKW(pB1,8),PKW(pB1,10),PKW(pB1,12),PKW(pB1,14)};
    SBAR(); pv(o,vb0+sl_cur,PAF(0),PAF(1),PAF(2),PAF(3)); }
  #undef PKW
  #undef PAF
  #undef VFR
  #undef PIN
  #undef MX3
  #undef GAPA
  #undef GAPB
  #undef EX
  #undef VRD
  #undef KRD
  #undef STEP
  #undef ENDW
  {auto rr=__builtin_amdgcn_permlane32_swap(__float_as_uint(l_reg),__float_as_uint(l_reg),false,false);l_reg=__uint_as_float(rr[0])+__uint_as_float(rr[1]);}
  if(hi==0)wsf[32+r32]=l_reg;asm volatile("s_waitcnt lgkmcnt(0)":::"memory");
  float rli[16];
  #pragma unroll
  for(int r=0;r<16;++r)rli[r]=__builtin_amdgcn_rcpf(wsf[32+crow(r,hi)]);
  bf16*Ow=O+(rowbase+q0+wid*QBLK)*DM+h*D;
  { bf16*stg=(bf16*)(shm+LDS_OST)+wid*2048;
    #pragma unroll
    for(int r=0;r<16;++r){const int orow=crow(r,hi);
      #pragma unroll
      for(int d0=0;d0<2;++d0)stg[orow*64+d0*32+r32]=__float2bfloat16(o[d0][r]*rli[r]);}
    asm volatile("s_waitcnt lgkmcnt(0)":::"memory");
    #pragma unroll
    for(int i=0;i<4;++i){const int row=i*8+(lane>>3),ch=lane&7; const u32x4 v=*(const u32x4*)(stg+row*64+ch*8); ATTN_STORE16(Ow+(long)row*DM+ch*8,v);} }
  asm volatile("s_waitcnt lgkmcnt(0)\n\ts_barrier":::"memory");
  #undef DMA_K
  #undef DMA_V
  #undef CMASK
  #undef START
  #undef SETNEG
  #undef RESC
  #undef ROT
}
constexpr int ATTN_LDS_BYTES=LDS_BYTES;
struct AttnTensors { const bf16* Q; const bf16* K; const bf16* V; bf16* O; const float* kmsum; };
struct AttnUnit { int bh; int qb; };
struct StaticOrder {
  int vcu, G;
  __device__ __forceinline__ StaticOrder(int grid,int vc):vcu(vc),G(grid){}
  __device__ __forceinline__ bool next(int i,AttnUnit&u)const{ const int uu=vcu+i*G; if(uu>=2048)return false; const int v=uu&255,ii=uu>>8,hf=v&1,j=ii>>1; u.bh=v>>1; u.qb=(ii&1)?15-2*j-hf:2*j+hf; return true; }
};
__device__ __forceinline__ void attn_phase(char*lds,const AttnTensors&T,const StaticOrder&S,const float mref,const int tid){
  AttnUnit u;
  int last=-1;
  for(int i=0;S.next(i,u);++i){ const int key=(u.bh/NHEAD)*4+((u.bh%NHEAD)>>2); attn_unit(u.bh/NHEAD,u.bh%NHEAD,u.qb,T.Q,T.K,T.V,T.O,lds,T.kmsum,mref,key!=last,tid); last=key; }
}
#undef SBAR
#undef WAIT_BAR
}

constexpr int N_PHASES = 18;
#define PHASE_TID() unsigned ones_ = ones; asm volatile("" : "+s"(ones_)); const int tid = (wave_s << 6) | (int)__builtin_amdgcn_mbcnt_hi(ones_, __builtin_amdgcn_mbcnt_lo(ones_, 0u));
__device__ __forceinline__ void run_phase(const int ph, CArgs* ap, LAS unsigned char* lds, const int G, const int bx, const int wave_s, const unsigned ones) {
    const int vcu = (G % 8 == 0) ? (bx % 8) * (G / 8) + bx / 8 : bx;
    CArgs* A = ap;
    unsigned char* ws = A->ws;
    const int l = ph >= 10 ? 1 : 0;
    bf16* HB0 = (bf16*)(ws + WS_HB); bf16* HB1 = (bf16*)(ws + WS_HB2);
    bf16* HBl = l ? HB1 : HB0; bf16* HBo = l ? HB0 : HB1;
    float* SSQ0 = (float*)(ws + WS_SSQ0); float* SSQ1 = (float*)(ws + WS_SSQ1); LAS float* XQ = (LAS float*)(lds + LDSCTL_OFF + 12288);
    switch (ph) {
    case 0: { PHASE_TID() p0_prologue(A, lds, G, vcu, wave_s, tid & 63); } break;
    case 1: { PHASE_TID() pg8::Gemm g{HB0, (const bf16*)(ws + WS_WIN), M, ML_INP, D, SSQ0}; pg8::StaticOrder S; S.init(M, ML_INP, G, bx);
        EpiMl E{ws};
        pg8::gemm_phase<EpiMl, pg8::StaticOrder, true, true, true>(lds, g, S, E, tid); } break;
    case 2: { PHASE_TID() ml::phase_a(A, lds, G, bx, tid); } break;
    case 3: { PHASE_TID() ml::phase_scan(A, G, bx, tid); } break;
    case 4: { PHASE_TID() ml::phase_c(A, lds, G, bx, tid); } break;
    case 10: { PHASE_TID() pg8::Gemm g{HB1, (const bf16*)(ws + WS_WQKV1), M, 1536, D, SSQ1}; pg8::StaticOrder S; S.init(M, 1536, G, bx);
        EpiQkv1 E{ws, lds + LDSCTL_OFF + 1024, A->in[11], A->in[9]};
        pg8::gemm_phase<EpiQkv1, pg8::StaticOrder, true, true, true>(lds, g, S, E, tid); } break;
    case 11: break;
    case 12: { PHASE_TID()
        const mattn::AttnTensors AT{(const mattn::bf16*)(ws + WS_Q1), (const mattn::bf16*)(ws + WS_K1), (const mattn::bf16*)(ws + WS_V1), (mattn::bf16*)(ws + WS_AO), (const float*)(ws + WS_KMP)};
        const mattn::StaticOrder S(G, vcu);
        float mref; { const int lane = tid & 63; const float gq = wave_max(fabsf(A->in[11][lane]), lane), gk = wave_max(fabsf(A->in[9][lane]), lane);
            mref = __builtin_bit_cast(float, __builtin_amdgcn_readfirstlane(__builtin_bit_cast(int, 64.0f * 0.125f * 1.4426950408889634f * gq * gk))); }
        mattn::attn_phase((char*)lds, AT, S, mref, tid);
        } break;
    case 5: case 13: case 7: case 15: {
        PHASE_TID() const bool dn = (ph == 7 || ph == 15);
        const size_t aoff = dn ? WS_ACT : (ph == 5 ? WS_V0 : WS_AO), boff = dn ? WS_WDN + l * 6 * MiB : (ph == 5 ? WS_WOUT : WS_WO1);
        pg8::Gemm g{(const bf16*)(ws + aoff), (const bf16*)(ws + boff), M, D, dn ? FF : D, nullptr}; pg8::StaticOrder S; S.init(M, D, G, bx);
        EpiRes E{HBl, l ? SSQ1 : SSQ0, XQ};
        pg8::gemm_phase<EpiRes, pg8::StaticOrder, true, true, false>(lds, g, S, E, tid); } break;
    case 6: case 14: { PHASE_TID() pg8::Gemm g{HBl, (const bf16*)(ws + WS_WGU + l * 11 * MiB), M, 2 * FF, D, l ? SSQ1 : SSQ0}; pg8::StaticOrder S; S.init(M, 2 * FF, G, bx);
        EpiSwiglu E{(bf16*)(ws + WS_ACT)};
        pg8::gemm_phase<EpiSwiglu, pg8::StaticOrder, true, true, true>(lds, g, S, E, tid); } break;
    case 8: case 16: { PHASE_TID() pg8::Gemm g{(const bf16*)(ws + WS_PB) + (size_t)l * M * PLE, (const bf16*)(ws + WS_WPU + l * (MiB / 2)), M, D, PLE, nullptr}; pg8::StaticOrder S; S.init(M, D, G, bx);
        EpiPlain E{(bf16*)(ws + WS_UP), D};
        pg8::gemm_phase<EpiPlain, pg8::StaticOrder, true, true, false>(lds, g, S, E, tid); } break;
    case 9: { PHASE_TID() pg8::Gemm g{HB0, (const bf16*)(ws + WS_WPG), M, D, D, SSQ0}; pg8::StaticOrder S; S.init(M, D, G, bx);
        EpiPle<false> E{HB0, HB1, nullptr, (const bf16*)(ws + WS_UP), SSQ1, XQ};
        pg8::gemm_phase<EpiPle<false>, pg8::StaticOrder, true, true, true>(lds, g, S, E, tid); } break;
    case 17: { PHASE_TID() pg8::Gemm g{HB1, (const bf16*)(ws + WS_WPG + 2 * MiB), M, D, D, SSQ1}; pg8::StaticOrder S; S.init(M, D, G, bx);
        EpiPle<true> E{HB1, nullptr, A->out, (const bf16*)(ws + WS_UP), nullptr, XQ};
        pg8::gemm_phase<EpiPle<true>, pg8::StaticOrder, true, true, true>(lds, g, S, E, tid); } break;
    default: break;
    }
}
#ifndef PHASE_MASK
#define PHASE_MASK 0xFFFFFFFFu
#endif
#ifndef LOCAL_MODE
#define LOCAL_MODE 1
#endif

__global__ void __launch_bounds__(NTHREADS, 2) yoco_fwd(Args args) {
    extern __shared__ __attribute__((aligned(16))) unsigned char lds_raw[];
    LAS unsigned char* lds = (LAS unsigned char*)lds_raw;
    volatile LAS unsigned* MISC = (volatile LAS unsigned*)(lds + LDSCTL_OFF);
    for (int u = threadIdx.x; u < (LDS_BYTES - LDSCTL_OFF) / 4; u += NTHREADS) ((LAS unsigned*)(lds + LDSCTL_OFF))[u] = 0u;
    __syncthreads();
    XcdBarrier bar; bar.bar = (unsigned*)(args.ws + WS_CTL) + 4096; bar.x = 0; bar.st = nullptr;
    if (MK_N_LAUNCHES == 1) bar = xcd_barrier_post((unsigned*)(args.ws + WS_CTL) + 4096, MISC + 8);
    const int lo = args.ph_lo, hi = args.ph_hi;
    const int wave_s = __builtin_amdgcn_readfirstlane(threadIdx.x >> 6);
#pragma unroll 1
    for (int ph = lo; ph < hi; ++ph) {
        CArgs* ap = (CArgs*)__builtin_amdgcn_kernarg_segment_ptr(); unsigned ones = ~0u; int G = gridDim.x, bx = blockIdx.x;
        bool local = false;
        if (LOCAL_MODE && MK_N_LAUNCHES == 1 && ph > 0) { const unsigned ev = (unsigned)__builtin_amdgcn_readfirstlane((int)MISC[11]), rk = (unsigned)__builtin_amdgcn_readfirstlane((int)MISC[10]);
            if (ev != 0u && rk < 32u && bar.x < 8u) { local = true; bx = (int)(rk * 8u + bar.x); } }
        asm volatile("" : "+s"(ap), "+s"(ones), "+s"(G), "+s"(bx));
#if defined(TS_MASK)
        if (wave_s == 0) MISC[17] = (unsigned)__builtin_amdgcn_s_memrealtime();
#endif
        if ((PHASE_MASK >> ph) & 1u) run_phase(ph, ap, lds, G, bx, wave_s, ones);
#if defined(TS_MASK)
        { XcdBarrier b2 = bar; asm volatile("" : "+s"(b2.bar)); xcd_barrier(b2); }
        if (((TS_MASK >> ph) & 1u) && wave_s == 0) MISC[16] = MISC[16] + ((unsigned)__builtin_amdgcn_s_memrealtime() - MISC[17]);
#else
        if (ph + 1 < hi && ph != 7 && ph != 15 && ph != 10) { XcdBarrier b2 = bar; asm volatile("" : "+s"(b2.bar));
            const int job = (SIDE_JOBS && G == 256) ? ((ph >= 1 && ph <= 4) ? ph - 1 : (ph == 5 ? 4 : (ph == 6 ? 5 : (ph == 8 ? 6 : -1)))) : -1;
            xcd_barrier(b2, ap, lds, job, G, bx, wave_s, ones, local && !(ph == 5 || ph == 9 || ph == 13)); }
#endif
    }
#if defined(TS_MASK)
    if (blockIdx.x == 0 && wave_s == 0) args.out[0] += (float)MISC[16] * 0.001f;
#endif
}

extern "C" void kernel_launch(void* const* d_in, const int* in_sizes, int n_in, void* d_out, int out_size, void* d_ws, size_t ws_size, hipStream_t stream) {
    static int grid = 0;
    if (grid == 0) {
        if (n_in != 19 || in_sizes[0] != M * D || out_size != M * D || ws_size < WS_END) { fprintf(stderr, "kernel_launch: unexpected shapes (n_in %d, in0 %d, out %d, ws %zu); nothing launched\n", n_in, n_in > 0 ? in_sizes[0] : -1, out_size, ws_size); grid = -1; return; }
        int dev = 0, cus = 0, per_cu = 0;
        if (hipGetDevice(&dev) != hipSuccess || hipDeviceGetAttribute(&cus, hipDeviceAttributeMultiprocessorCount, dev) != hipSuccess) { grid = -1; return; }
        if (hipFuncSetAttribute((const void*)yoco_fwd, hipFuncAttributeMaxDynamicSharedMemorySize, LDS_BYTES) != hipSuccess) { fprintf(stderr, "kernel_launch: hipFuncSetAttribute failed\n"); grid = -1; return; }
        if (hipOccupancyMaxActiveBlocksPerMultiprocessor(&per_cu, (const void*)yoco_fwd, NTHREADS, LDS_BYTES) != hipSuccess || per_cu < 1) { fprintf(stderr, "kernel_launch: occupancy query says %d blocks per CU\n", per_cu); per_cu = 1; }
        (void)hipGetLastError();
        grid = cus;
    }
    if (grid < 0) return;
    (void)hipMemsetAsync((char*)d_ws + WS_CTL, 0, CTL_ZERO_BYTES, stream);
    Args a{};
    for (int i = 0; i < 19; ++i) a.in[i] = (const float*)d_in[i];
    a.out = (float*)d_out; a.ws = (unsigned char*)d_ws;
    if (MK_N_LAUNCHES == 1) {
        a.ph_lo = 0; a.ph_hi = N_PHASES;
        hipLaunchKernelGGL(yoco_fwd, dim3(grid), dim3(NTHREADS), LDS_BYTES, stream, a);
    } else {
        for (int p = 0; p < N_PHASES; ++p) { a.ph_lo = p; a.ph_hi = p + 1; hipLaunchKernelGGL(yoco_fwd, dim3(grid), dim3(NTHREADS), LDS_BYTES, stream, a); }
    }
}
```

```cpp
#include <hip/hip_runtime.h>
#include <hip/hip_bf16.h>
#include <cstdio>
#include <cstdint>

#ifndef SIDE_JOBS
#define SIDE_JOBS 1
#endif
#ifndef MK_N_LAUNCHES
#define MK_N_LAUNCHES 1
#endif

#define LAS __attribute__((address_space(3)))
#define GAS __attribute__((address_space(1)))

#ifndef SSQ_INLOOP
#define SSQ_INLOOP 0
#endif
namespace pg8 {
#define PG8_LAS __attribute__((address_space(3)))
typedef unsigned short bf16_t;
typedef short bf16x8 __attribute__((ext_vector_type(8)));
typedef float f32x4 __attribute__((ext_vector_type(4)));
typedef unsigned u32x4 __attribute__((ext_vector_type(4)));
typedef unsigned u32x2 __attribute__((ext_vector_type(2)));
constexpr int BM = 256, BK = 64, HALF = 128, HTB = HALF * BK * 2, STAGE_BYTES = 8 * HTB, NXCD = 8, WGM = 8;

__host__ __device__ __forceinline__ int lds_byte(int r, int c) { const int st = (r >> 4) * 2 + (c >> 5), rr = r & 15, cc = c & 31, ob = rr * 64 + cc * 2; return st * 1024 + (ob ^ (((ob >> 9) & 1) << 5)); }
__host__ __device__ __forceinline__ void stage_rc(int b, int& R, int& C) { const int st = b / 1024, sb = b % 1024, swz = sb ^ (((sb >> 9) & 1) << 5); R = (st >> 1) * 16 + swz / 64; C = (st & 1) * 32 + (swz % 64) / 2; }
__host__ __device__ __forceinline__ int perm32(int rho) { const int n = rho >> 4, i = rho & 15; return 8 * (i >> 2) + 4 * n + (i & 3); }

struct Unit { int pm, pn; };
struct Gemm { const bf16_t* A; const bf16_t* Bt; int M, N, K; const float* ssq; };

struct StaticOrder {
    int nM, nN, nwg, G, c;
    __host__ __device__ void init(int M, int N, int G_, int c_) { nM = M / BM; nN = N / BM; nwg = nM * nN; G = G_; c = c_; }
    __host__ __device__ bool next(int i, Unit& u) const {
        const long L = (long)i * G + c; if (L >= nwg) return false;
        int wgid = (int)L; { const int q = nwg / NXCD, r = nwg % NXCD, xcd = wgid % NXCD, off = wgid / NXCD; wgid = (xcd < r ? xcd * (q + 1) : r * (q + 1) + (xcd - r) * q) + off; }
        const int nig = WGM * nN, gid = wgid / nig, fm = gid * WGM, gsz = (nM % WGM == 0) ? WGM : ((nM - fm) < WGM ? (nM - fm) : WGM);
        u.pm = fm + ((wgid % nig) % gsz); u.pn = (wgid % nig) / gsz; return true;
    }
    __device__ __forceinline__ void a_ready(const Unit&) const {}
    __device__ __forceinline__ void done(const Unit&) const {}
};

typedef float f32x2_t __attribute__((ext_vector_type(2))); typedef __bf16 bf16x2_t __attribute__((ext_vector_type(2)));
__device__ __forceinline__ unsigned cvt_pk_bf16(float lo, float hi) { f32x2_t v = {lo, hi}; bf16x2_t b = __builtin_convertvector(v, bf16x2_t); return __builtin_bit_cast(unsigned, b); }

static_assert(true, "");
__device__ __forceinline__ float dot2sq(unsigned w, float acc) { typedef __bf16 bfx2 __attribute__((ext_vector_type(2))); const bfx2 v = __builtin_bit_cast(bfx2, w); return __builtin_amdgcn_fdot2_f32_bf16(v, v, acc, false); }
__device__ __forceinline__ float shx16(float v, int lane) { return __builtin_bit_cast(float, __builtin_amdgcn_ds_bpermute((lane ^ 16) << 2, __builtin_bit_cast(int, v))); }
__device__ __forceinline__ float shx32(float v, int lane) { return __builtin_bit_cast(float, __builtin_amdgcn_ds_bpermute((lane ^ 32) << 2, __builtin_bit_cast(int, v))); }
__device__ __forceinline__ float sum_x16(float v) { const unsigned u = __builtin_bit_cast(unsigned, v); auto r = __builtin_amdgcn_permlane16_swap(u, u, false, false); return __builtin_bit_cast(float, (unsigned)r[0]) + __builtin_bit_cast(float, (unsigned)r[1]); }
__device__ __forceinline__ float sum_x32(float v) { const unsigned u = __builtin_bit_cast(unsigned, v); auto r = __builtin_amdgcn_permlane32_swap(u, u, false, false); return __builtin_bit_cast(float, (unsigned)r[0]) + __builtin_bit_cast(float, (unsigned)r[1]); }
template <class Epi, class Sched, bool ALIGN_EPI = false, bool SP2 = false, bool ROWSSQ = false>
__device__ __forceinline__ void gemm_phase(PG8_LAS unsigned char* lds, const Gemm g, const Sched& S, const Epi& E, const int tid) {
    const int wid = __builtin_amdgcn_readfirstlane(tid >> 6), lane = tid & 63, wr = wid >> 2, wc = wid & 3, fr = lane & 15, fq = lane >> 4;
    int K_ = g.K; asm volatile("" : "+s"(K_));
    const int K = K_, nt = K / BK;
    unsigned voffA[2], voffB[2];
#pragma unroll
    for (int i = 0; i < 2; ++i) { int R, C; stage_rc(tid * 16 + i * 8192, R, C); const int Rb = Epi::PERM ? ((R & ~31) + perm32(R & 31)) : R;
        voffA[i] = (unsigned)(R * K + C) * 2u; voffB[i] = (unsigned)(Rb * K + C) * 2u; }
    const size_t kstep = (size_t)(BK * 2);
    const size_t hstep = (size_t)HALF * K * 2;
    const size_t tstep = 2 * hstep;
    const unsigned ldsw = (unsigned)wid * 1024u;
    const int aoff = lds_byte(wr * 64 + fr, fq * 8), boff = lds_byte(wc * 32 + fr, fq * 8);
#define PG8_SA(b, h) (((b) * 2 + (h)) * HTB)
#define PG8_SB(b, h) ((4 + (b) * 2 + (h)) * HTB)
    const unsigned lds_u = (unsigned)(uintptr_t)lds + ldsw;
#define PG8_STAGE(bufoff, gbase, voff) do { _Pragma("unroll") for (int _i = 0; _i < 2; ++_i) \
        asm volatile("s_mov_b32 m0, %2\n\ts_nop 0\n\tglobal_load_lds_dwordx4 %0, %1" :: "v"((voff)[_i]), "s"((const char*)(gbase)), "s"(lds_u + (unsigned)((bufoff) + _i * 8192)) : "memory", "m0"); } while (0)
#define PG8_LDA(dst, b, h) do { _Pragma("unroll") for (int m = 0; m < 4; ++m) _Pragma("unroll") for (int k = 0; k < 2; ++k) dst[m][k] = *(const PG8_LAS bf16x8*)(lds + PG8_SA(b, h) + aoff + m * 2048 + k * 1024); } while (0)
#define PG8_LDB(dst, b, h) do { _Pragma("unroll") for (int n = 0; n < 2; ++n) _Pragma("unroll") for (int k = 0; k < 2; ++k) dst[n][k] = *(const PG8_LAS bf16x8*)(lds + PG8_SB(b, h) + boff + n * 2048 + k * 1024); } while (0)
#define PG8_MMA(ai, bj, At, Bt) do { __builtin_amdgcn_s_setprio(1); _Pragma("unroll") for (int m = 0; m < 4; ++m) _Pragma("unroll") for (int n = 0; n < 2; ++n) _Pragma("unroll") for (int k = 0; k < 2; ++k) \
        acc[ai][bj][m][n] = __builtin_amdgcn_mfma_f32_16x16x32_bf16(Bt[n][k], At[m][k], acc[ai][bj][m][n], 0, 0, 0); __builtin_amdgcn_s_setprio(0); } while (0)
#define PG8_SSQ(ai, At) do { if constexpr (ROWSSQ && SSQ_INLOOP) { _Pragma("unroll") for (int m = 0; m < 4; ++m) _Pragma("unroll") for (int k = 0; k < 2; ++k) { const u32x4 w_ = __builtin_bit_cast(u32x4, At[m][k]); \
        ssq[ai][m] = dot2sq(w_.x, ssq[ai][m]); ssq[ai][m] = dot2sq(w_.y, ssq[ai][m]); ssq[ai][m] = dot2sq(w_.z, ssq[ai][m]); ssq[ai][m] = dot2sq(w_.w, ssq[ai][m]); } } } while (0)
#define PG8_WAIT_V(n) asm volatile("s_waitcnt vmcnt(" #n ")" ::: "memory")
#define PG8_WAIT_L(n) asm volatile("s_waitcnt lgkmcnt(" #n ")" ::: "memory")
#define PG8_BAR __builtin_amdgcn_s_barrier()
#define PG8_SCHED __builtin_amdgcn_sched_barrier(0)
    Unit cur, nxt; int ui = 0;
    if (!S.next(0, cur)) return;
    f32x4 acc[2][2][4][2];
#pragma unroll
    for (int a = 0; a < 2; ++a)
#pragma unroll
        for (int b = 0; b < 2; ++b)
#pragma unroll
            for (int m = 0; m < 4; ++m)
#pragma unroll
                for (int n = 0; n < 2; ++n) acc[a][b][m][n] = (f32x4){0.f, 0.f, 0.f, 0.f};
    bf16x8 At[4][2], B0[2][2], B1[2][2];
    float ssq[2][4];
#pragma unroll
    for (int a = 0; a < 2; ++a)
#pragma unroll
        for (int m = 0; m < 4; ++m) ssq[a][m] = 0.f;
    const char* cA = (const char*)g.A + (size_t)cur.pm * tstep; const char* cB = (const char*)g.Bt + (size_t)cur.pn * tstep;
#define PG8_SSQ_LOAD(u_) do { if constexpr (ROWSSQ && !SSQ_INLOOP) { const float* sp_ = g.ssq + ((size_t)(u_).pm * BM + wr * 64 + fr) * 4 + fq; \
        _Pragma("unroll") for (int a = 0; a < 2; ++a) _Pragma("unroll") for (int m = 0; m < 4; ++m) ssq[a][m] = sp_[(a * HALF + m * 16) * 4]; } } while (0)
    PG8_SSQ_LOAD(cur);
    S.a_ready(cur);
    if constexpr (SP2) {
        PG8_STAGE(PG8_SB(0, 0), cB, voffB); PG8_STAGE(PG8_SB(0, 1), cB + hstep, voffB); PG8_STAGE(PG8_SA(0, 0), cA, voffA); PG8_STAGE(PG8_SA(0, 1), cA + hstep, voffA);
        if (wr == 1) PG8_BAR;
        PG8_WAIT_V(2); PG8_BAR;
        PG8_STAGE(PG8_SB(1, 0), cB + kstep, voffB); PG8_STAGE(PG8_SA(1, 0), cA + kstep, voffA); PG8_STAGE(PG8_SB(1, 1), cB + hstep + kstep, voffB);
        PG8_WAIT_V(6); PG8_BAR;
    } else {
        PG8_STAGE(PG8_SB(0, 0), cB, voffB); PG8_STAGE(PG8_SA(0, 0), cA, voffA); PG8_STAGE(PG8_SB(0, 1), cB + hstep, voffB); PG8_STAGE(PG8_SA(0, 1), cA + hstep, voffA);
        if (wr == 1) PG8_BAR;
        PG8_WAIT_V(4); PG8_BAR;
        PG8_STAGE(PG8_SB(1, 0), cB + kstep, voffB); PG8_STAGE(PG8_SA(1, 0), cA + kstep, voffA); PG8_STAGE(PG8_SB(1, 1), cB + hstep + kstep, voffB);
        PG8_WAIT_V(6); PG8_BAR;
    }
    for (;;) {
        const bool has_next = S.next(ui + 1, nxt);
        const char* nA = has_next ? (const char*)g.A + (size_t)nxt.pm * tstep : cA; const char* nB = has_next ? (const char*)g.Bt + (size_t)nxt.pn * tstep : cB;
        for (int t = 0; t < nt; t += 2) {
            const bool last = (t == nt - 2);
            const char* a1 = cA + (size_t)(t + 1) * kstep;
            const char* a2 = last ? nA : cA + (size_t)(t + 2) * kstep; const char* b2 = last ? nB : cB + (size_t)(t + 2) * kstep;
            const char* a3 = a2 + kstep; const char* b3 = b2 + kstep;
            if (last && has_next) S.a_ready(nxt);
            if constexpr (SP2) {
            PG8_LDB(B0, 0, 0); PG8_LDB(B1, 0, 1); PG8_SCHED; PG8_LDA(At, 0, 0); PG8_STAGE(PG8_SA(1, 1), a1 + hstep, voffA);
            PG8_WAIT_V(8); PG8_WAIT_L(0); PG8_BAR; PG8_MMA(0, 0, At, B0); PG8_SSQ(0, At); PG8_MMA(0, 1, At, B1); PG8_BAR; PG8_SCHED;
            PG8_LDA(At, 0, 1); PG8_STAGE(PG8_SB(0, 0), b2, voffB); PG8_STAGE(PG8_SB(0, 1), b2 + hstep, voffB); PG8_STAGE(PG8_SA(0, 0), a2, voffA);
            PG8_WAIT_V(8); PG8_WAIT_L(0); PG8_BAR; PG8_MMA(1, 0, At, B0); PG8_SSQ(1, At); PG8_MMA(1, 1, At, B1); PG8_BAR; PG8_SCHED;
            PG8_LDB(B0, 1, 0); PG8_LDB(B1, 1, 1); PG8_SCHED; PG8_LDA(At, 1, 0); PG8_STAGE(PG8_SA(0, 1), a2 + hstep, voffA);
            PG8_WAIT_V(8); PG8_WAIT_L(0); PG8_BAR; PG8_MMA(0, 0, At, B0); PG8_SSQ(0, At); PG8_MMA(0, 1, At, B1); PG8_BAR; PG8_SCHED;
            PG8_LDA(At, 1, 1); PG8_STAGE(PG8_SB(1, 0), b3, voffB); PG8_STAGE(PG8_SB(1, 1), b3 + hstep, voffB); PG8_STAGE(PG8_SA(1, 0), a3, voffA);
            PG8_WAIT_V(8); PG8_WAIT_L(0); PG8_BAR; PG8_MMA(1, 0, At, B0); PG8_SSQ(1, At); PG8_MMA(1, 1, At, B1); PG8_BAR; PG8_SCHED;
            } else {
            PG8_LDB(B0, 0, 0); PG8_SCHED; PG8_LDA(At, 0, 0); PG8_STAGE(PG8_SA(1, 1), a1 + hstep, voffA);
            PG8_WAIT_L(8); PG8_BAR; PG8_WAIT_L(0); PG8_MMA(0, 0, At, B0); PG8_BAR; PG8_SCHED;
            PG8_LDB(B1, 0, 1); PG8_STAGE(PG8_SB(0, 0), b2, voffB);
            PG8_BAR; PG8_WAIT_L(0); PG8_MMA(0, 1, At, B1); PG8_BAR;
            PG8_LDA(At, 0, 1); PG8_STAGE(PG8_SA(0, 0), a2, voffA);
            PG8_BAR; PG8_WAIT_L(0); PG8_MMA(1, 0, At, B0); PG8_BAR; PG8_SCHED;
            PG8_STAGE(PG8_SB(0, 1), b2 + hstep, voffB);
            PG8_WAIT_V(6); PG8_BAR; PG8_MMA(1, 1, At, B1); PG8_BAR;
            PG8_LDB(B0, 1, 0); PG8_SCHED; PG8_LDA(At, 1, 0); PG8_STAGE(PG8_SA(0, 1), a2 + hstep, voffA);
            PG8_WAIT_L(8); PG8_BAR; PG8_WAIT_L(0); PG8_MMA(0, 0, At, B0); PG8_BAR; PG8_SCHED;
            PG8_LDB(B1, 1, 1); PG8_STAGE(PG8_SB(1, 0), b3, voffB);
            PG8_BAR; PG8_WAIT_L(0); PG8_MMA(0, 1, At, B1); PG8_BAR;
            PG8_LDA(At, 1, 1); PG8_STAGE(PG8_SA(1, 0), a3, voffA);
            PG8_BAR; PG8_WAIT_L(0); PG8_MMA(1, 0, At, B0); PG8_BAR; PG8_SCHED;
            PG8_STAGE(PG8_SB(1, 1), b3 + hstep, voffB);
            PG8_WAIT_V(6); PG8_BAR; PG8_MMA(1, 1, At, B1); PG8_BAR;
            }
        }
        if constexpr (ALIGN_EPI) { if (wr == 0) PG8_BAR; }
        float rs[2][4];
#pragma unroll
        for (int a = 0; a < 2; ++a)
#pragma unroll
            for (int m = 0; m < 4; ++m) { float q_ = ssq[a][m]; if constexpr (ROWSSQ) { q_ = sum_x16(q_); q_ = sum_x32(q_); q_ = __builtin_amdgcn_rsqf(q_ * (1.0f / (float)K) + 1e-6f); } rs[a][m] = q_; ssq[a][m] = 0.f; }
        E(acc, cur, wr, wc, fr, fq, rs); S.done(cur);
        if (!has_next) break;
        PG8_SSQ_LOAD(nxt);
        { typedef float f32x16_ __attribute__((ext_vector_type(16)));
          u32x4 zq = {0u, 0u, 0u, 0u};
#pragma unroll
          for (int a = 0; a < 2; ++a)
#pragma unroll
              for (int b = 0; b < 2; ++b)
#pragma unroll
                  for (int mh = 0; mh < 2; ++mh) { asm volatile("" : "+v"(zq)); const bf16x8 zf = __builtin_bit_cast(bf16x8, zq); const f32x16_ z = __builtin_amdgcn_mfma_f32_32x32x16_bf16(zf, zf, (f32x16_){0.f, 0.f, 0.f, 0.f, 0.f, 0.f, 0.f, 0.f, 0.f, 0.f, 0.f, 0.f, 0.f, 0.f, 0.f, 0.f}, 0, 0, 0);
                      acc[a][b][2 * mh][0] = (f32x4){z[0], z[1], z[2], z[3]}; acc[a][b][2 * mh][1] = (f32x4){z[4], z[5], z[6], z[7]};
                      acc[a][b][2 * mh + 1][0] = (f32x4){z[8], z[9], z[10], z[11]}; acc[a][b][2 * mh + 1][1] = (f32x4){z[12], z[13], z[14], z[15]}; } }
        cur = nxt; cA = nA; cB = nB; ++ui;
        if constexpr (ALIGN_EPI) { if (wr == 1) PG8_BAR; }
    }
    PG8_WAIT_V(0);
    if constexpr (!ALIGN_EPI) { if (wr == 0) PG8_BAR; }
    PG8_BAR;
#undef PG8_SA
#undef PG8_SB
#undef PG8_STAGE
#undef PG8_LDA
#undef PG8_LDB
#undef PG8_MMA
#undef PG8_SSQ
#undef PG8_SSQ_LOAD
#undef PG8_WAIT_V
#undef PG8_WAIT_L
#undef PG8_BAR
#undef PG8_SCHED
}
}

typedef unsigned short bf16;
typedef float f32x4 __attribute__((ext_vector_type(4)));
typedef unsigned v4u __attribute__((ext_vector_type(4)));
typedef unsigned v2u __attribute__((ext_vector_type(2)));
constexpr int NB_ = 8, SEQ = 4096, D = 1024, M = NB_ * SEQ;
constexpr int ML_H = 8, ML_DV = 128, ML_DQK = 64, ML_L = 64, ML_NC = SEQ / ML_L, ML_IN = 3088, ML_INP = 3072;
constexpr int MB_H = 16, MB_KVH = 4, MB_HD = 64, MB_BLK = 256, MB_NB = SEQ / MB_BLK;
constexpr int FF = 2816, PLE = 256;
constexpr float EPS = 1e-6f, GATE_CAP = 15.0f;
constexpr int NWAVES = 8, NTHREADS = 512;

constexpr size_t MiB = 1u << 20;
constexpr size_t WS_CTL = 0, CTL_ZERO_BYTES = 64 * 1024;
constexpr size_t WS_ROPE = 1 * MiB;
constexpr size_t WS_KMP = 1 * MiB + 512 * 1024;
constexpr size_t WS_SSQ0 = 2 * MiB, WS_SSQ1 = 3 * MiB;
constexpr size_t WS_GATES = 6 * MiB;
constexpr size_t WS_MLOC = 8 * MiB, WS_GLAST = WS_MLOC + 16384, WS_MPREV = WS_GLAST + 16384;
constexpr size_t WS_NLOC = 9 * MiB;
constexpr size_t WS_WIN = 10 * MiB, WS_WOUT = 17 * MiB, WS_WQKV1 = 19 * MiB, WS_WO1 = 22 * MiB, WS_WGU = 24 * MiB  , WS_WDN = 46 * MiB  , WS_WPG = 58 * MiB  , WS_WPU = 62 * MiB  ;
constexpr size_t WS_HB = 64 * MiB, WS_HB2 = 448 * MiB;
constexpr size_t WS_PB = 128 * MiB;
constexpr size_t WS_UP = 160 * MiB;
constexpr size_t WS_OG = 160 * MiB;
constexpr size_t WS_Q0 = 224 * MiB, WS_K0 = 256 * MiB, WS_V0 = 288 * MiB  , WS_CLOC = 384 * MiB  ;
constexpr size_t WS_ACT = 224 * MiB;
constexpr size_t WS_Q1 = 224 * MiB, WS_K1 = 288 * MiB, WS_V1 = 304 * MiB, WS_AO = 320 * MiB;
constexpr size_t WS_END = 512 * MiB;

constexpr int LDS_BYTES = 147456;
constexpr int RING_BYTES = 131072;
constexpr int LDSCTL_OFF = RING_BYTES;

__device__ __forceinline__ unsigned f2bf(float f) { unsigned u = __builtin_bit_cast(unsigned, f); return (u + 0x7fffu + ((u >> 16) & 1u)) >> 16; }
__device__ __forceinline__ unsigned pk2(float lo, float hi) { return pg8::cvt_pk_bf16(lo, hi); }
__device__ __forceinline__ float bf_lo(unsigned u) { return __builtin_bit_cast(float, u << 16); }
__device__ __forceinline__ float bf_hi(unsigned u) { return __builtin_bit_cast(float, u & 0xffff0000u); }
__device__ __forceinline__ float sigmoidf_(float x) { return __builtin_amdgcn_rcpf(1.0f + __builtin_amdgcn_exp2f(-1.4426950408889634f * x)); }
__device__ __forceinline__ float shx(float v, int mask, int lane) { return __builtin_bit_cast(float, __builtin_amdgcn_ds_bpermute((lane ^ mask) << 2, __builtin_bit_cast(int, v))); }
__device__ __forceinline__ int shxi(int v, int mask, int lane) { return __builtin_amdgcn_ds_bpermute((lane ^ mask) << 2, v); }
__device__ __forceinline__ float shup(float v, int o, int lane) { return __builtin_bit_cast(float, __builtin_amdgcn_ds_bpermute((lane >= o ? lane - o : lane) << 2, __builtin_bit_cast(int, v))); }
__device__ __forceinline__ float shidx(float v, int src) { return __builtin_bit_cast(float, __builtin_amdgcn_ds_bpermute(src << 2, __builtin_bit_cast(int, v))); }
__device__ __forceinline__ float wave_sum(float v, int lane) {
#pragma unroll
    for (int o = 1; o < 64; o <<= 1) v += shx(v, o, lane);
    return v;
}
__device__ __forceinline__ float wave_max(float v, int lane) {
#pragma unroll
    for (int o = 1; o < 64; o <<= 1) v = fmaxf(v, shx(v, o, lane));
    return v;
}

using pg8::Unit; using pg8::HALF; using pg8::BM;
#define ROWS8 _Pragma("unroll") for (int ai = 0; ai < 2; ++ai) _Pragma("unroll") for (int m = 0; m < 4; ++m)

#define EPI_ARGS const f32x4 (&acc)[2][2][4][2], const Unit& u, int wr, int wc, int fr, int fq, const float (&rs)[2][4]
#ifndef EPI_WT
#define EPI_WT 0
#endif
__device__ __forceinline__ void st16(void* base, size_t byte_off, v4u v) {
    if (EPI_WT) { const __amdgpu_buffer_rsrc_t r = __builtin_amdgcn_make_buffer_rsrc(base, (short)0, 0x7fffffff, 0x00020000); __builtin_amdgcn_raw_buffer_store_b128(v, r, (unsigned)byte_off, 0, 16); }
    else *(v4u*)((char*)base + byte_off) = v;
}
__device__ __forceinline__ v4u pack8(const f32x4 a, const f32x4 b) { v4u w; w.x = pk2(a[0], a[1]); w.y = pk2(a[2], a[3]); w.z = pk2(b[0], b[1]); w.w = pk2(b[2], b[3]); return w; }
__device__ __forceinline__ void unpack8(const v4u w, f32x4& a, f32x4& b) { a = (f32x4){bf_lo(w.x), bf_hi(w.x), bf_lo(w.y), bf_hi(w.y)}; b = (f32x4){bf_lo(w.z), bf_hi(w.z), bf_lo(w.w), bf_hi(w.w)}; }
struct EpiMl {
    static constexpr bool PERM = true, AFTER_DRAIN = false;
    unsigned char* ws;
    __device__ __forceinline__ void operator()(EPI_ARGS) const {
        const int row0 = u.pm * BM + wr * 64 + fr;
        const int t = u.pn < 2 ? 0 : (u.pn < 4 ? 1 : (u.pn < 8 ? 2 : 3));
        const size_t boff = t == 0 ? WS_Q0 : (t == 1 ? WS_K0 : (t == 2 ? WS_V0 : WS_OG));
        const int ld = t < 2 ? 512 : 1024, colt = (u.pn - (t == 0 ? 0 : (t == 1 ? 2 : (t == 2 ? 4 : 8)))) * 256; const float sc = t == 0 ? 0.125f : 1.f;
        bf16* base = (bf16*)(ws + boff);
        const int col0 = colt + wc * 32 + 8 * fq;
        ROWS8 { const size_t ro = ((size_t)(row0 + ai * HALF + m * 16) * ld + col0) * 2; const float r = rs[ai][m] * sc;
#pragma unroll
            for (int bj = 0; bj < 2; ++bj) st16(base, ro + bj * HALF * 2, pack8(acc[ai][bj][m][0] * r, acc[ai][bj][m][1] * r)); }
    }
};
struct EpiQkv1 {
    static constexpr bool PERM = true, AFTER_DRAIN = false;
    unsigned char* ws; LAS unsigned char* xl; const float* qg; const float* kg;
    __device__ __forceinline__ void operator()(const f32x4 (&acc)[2][2][4][2], const Unit& u, int wr, int wc, int fr_, int fq_, const float (&rs)[2][4]) const {
        int fr = fr_, fq = fq_; asm volatile("" : "+v"(fr), "+v"(fq));
        const int lane = fr + 16 * fq, rowl0 = wr * 64 + fr, row0 = u.pm * BM + rowl0;
        if (u.pn == 5) {
            bf16* base = (bf16*)(ws + WS_V1); const int col0 = wc * 32 + 8 * fq;
            ROWS8 { const float r = rs[ai][m]; const size_t ro = ((size_t)(row0 + ai * HALF + m * 16) * 256 + col0) * 2;
#pragma unroll
                for (int bj = 0; bj < 2; ++bj) st16(base, ro + bj * HALF * 2, pack8(acc[ai][bj][m][0] * r, acc[ai][bj][m][1] * r)); }
            return;
        }
        const bool isq = u.pn < 4;
        LAS float* ex = (LAS float*)xl;
        ROWS8 { const float r = rs[ai][m];
#pragma unroll
            for (int bj = 0; bj < 2; ++bj) { const f32x4 a = acc[ai][bj][m][0] * r, b = acc[ai][bj][m][1] * r; float q = ((a[0] * a[0] + a[1] * a[1]) + (a[2] * a[2] + a[3] * a[3])) + ((b[0] * b[0] + b[1] * b[1]) + (b[2] * b[2] + b[3] * b[3]));
                q = pg8::sum_x16(q); q = pg8::sum_x32(q);
                if (fq == 0) ex[(ai * HALF + rowl0 + m * 16) * 8 + bj * 4 + wc] = q; } }
        asm volatile("s_waitcnt lgkmcnt(0)\n\ts_barrier" ::: "memory");
        float gn[8];
        { const float* gp = (isq ? qg : kg) + 32 * (wc & 1) + 8 * fq; const float sc = isq ? 0.125f * 1.4426950408889634f : 1.0f;
#pragma unroll
          for (int e = 0; e < 8; ++e) gn[e] = gp[e] * sc; }
        const bool rot = (wc & 1) == 0;
        const float* rc = (const float*)(ws + WS_ROPE); const float* rsn = rc + SEQ * 8;
        bf16* base = (bf16*)(ws + (isq ? WS_Q1 : WS_K1)); const int ld = isq ? 1024 : 256, col0 = (isq ? u.pn * 256 : 0) + wc * 32 + 8 * fq;
        float ks[2][8];
#pragma unroll
        for (int bj = 0; bj < 2; ++bj)
#pragma unroll
            for (int e = 0; e < 8; ++e) ks[bj][e] = 0.f;
        ROWS8 { const int rowl = ai * HALF + rowl0 + m * 16, row = u.pm * BM + rowl; const float r = rs[ai][m];
            float cs[8], sn[8];
            if (rot) { const int pos = row & (SEQ - 1); const f32x4 c0 = *(const f32x4*)(rc + pos * 8), c1 = *(const f32x4*)(rc + pos * 8 + 4), s0 = *(const f32x4*)(rsn + pos * 8), s1 = *(const f32x4*)(rsn + pos * 8 + 4);
#pragma unroll
                for (int e = 0; e < 4; ++e) { cs[e] = c0[e]; cs[4 + e] = c1[e]; sn[e] = s0[e]; sn[4 + e] = s1[e]; } }
#pragma unroll
            for (int bj = 0; bj < 2; ++bj) {
                const float q = ex[rowl * 8 + bj * 4 + (wc & 2)] + ex[rowl * 8 + bj * 4 + (wc | 1)]; const float rn = r * __builtin_amdgcn_rsqf(q * (1.0f / 64.0f) + EPS);
                float v[8];
#pragma unroll
                for (int e = 0; e < 8; ++e) v[e] = acc[ai][bj][m][e >> 2][e & 3] * rn * gn[e];
                if (rot) {
#pragma unroll
                    for (int e = 0; e < 8; ++e) { const float p = pg8::shx16(v[e], lane); if (fq == 0) v[e] = v[e] * cs[e] - p * sn[e]; else if (fq == 1) v[e] = v[e] * cs[e] + p * sn[e]; } }
                st16(base, ((size_t)row * ld + col0 + bj * HALF) * 2, pack8((f32x4){v[0], v[1], v[2], v[3]}, (f32x4){v[4], v[5], v[6], v[7]}));
                if (!isq) {
#pragma unroll
                    for (int e = 0; e < 8; ++e) ks[bj][e] += v[e]; } }
            asm volatile("" ::: "memory"); }
        if (!isq) {
            LAS float* kx = ex + 2048;
#pragma unroll
            for (int bj = 0; bj < 2; ++bj)
#pragma unroll
                for (int e = 0; e < 8; ++e) { float t = ks[bj][e]; t += shx(t, 1, lane); t += shx(t, 2, lane); t += shx(t, 4, lane); t += shx(t, 8, lane); ks[bj][e] = t; }
            if (fr == 0) {
#pragma unroll
                for (int bj = 0; bj < 2; ++bj) { LAS float* kp = kx + wr * 256 + bj * HALF + wc * 32 + 8 * fq; *(LAS f32x4*)kp = (f32x4){ks[bj][0], ks[bj][1], ks[bj][2], ks[bj][3]}; *(LAS f32x4*)(kp + 4) = (f32x4){ks[bj][4], ks[bj][5], ks[bj][6], ks[bj][7]}; } }
            asm volatile("s_waitcnt lgkmcnt(0)\n\ts_barrier" ::: "memory");
            const int t = (wr * 4 + wc) * 64 + lane;
            if (t < 256) ((float*)(ws + WS_KMP))[(size_t)u.pm * 256 + t] = kx[t] + kx[256 + t];
        }
    }
};
struct EpiPlain {
    static constexpr bool PERM = true, AFTER_DRAIN = false;
    bf16* O; int ld;
    __device__ __forceinline__ void operator()(EPI_ARGS) const {
        const int row0 = u.pm * BM + wr * 64 + fr, col0 = u.pn * BM + wc * 32 + 8 * fq;
        ROWS8 { const size_t ro = ((size_t)(row0 + ai * HALF + m * 16) * ld + col0) * 2;
#pragma unroll
            for (int bj = 0; bj < 2; ++bj) st16(O, ro + bj * HALF * 2, pack8(acc[ai][bj][m][0], acc[ai][bj][m][1])); }
    }
};
struct EpiSwiglu {
    static constexpr bool PERM = true, AFTER_DRAIN = false;
    bf16* act;
    __device__ __forceinline__ void operator()(EPI_ARGS) const {
        const int row0 = u.pm * BM + wr * 64 + fr, col0 = u.pn * HALF + wc * 32 + 8 * fq;
        ROWS8 { const float r = rs[ai][m], rn = r * -1.4426950408889634f, r2 = r * r; const size_t ro = ((size_t)(row0 + ai * HALF + m * 16) * FF + col0) * 2; f32x4 o[2];
#pragma unroll
            for (int n = 0; n < 2; ++n)
#pragma unroll
                for (int e = 0; e < 4; ++e) { const float g_ = acc[ai][0][m][n][e]; o[n][e] = (g_ * acc[ai][1][m][n][e]) * (r2 * __builtin_amdgcn_rcpf(1.0f + __builtin_amdgcn_exp2f(g_ * rn))); }
            st16(act, ro, pack8(o[0], o[1])); }
    }
};
__device__ __forceinline__ void publish_rowssq(float (&q)[2][4], LAS float* xq, float* ssq, const Unit& u, int wr, int wc, int fr, int fq) {
    const int lane = fr + 16 * fq;
    ROWS8 { float t = q[ai][m]; t = pg8::sum_x16(t); t = pg8::sum_x32(t); if (fq == 0) xq[wc * 256 + ai * HALF + wr * 64 + m * 16 + fr] = t; }
    asm volatile("s_waitcnt lgkmcnt(0)\n\ts_barrier" ::: "memory");
    const int t = (wr * 4 + wc) * 64 + lane;
    if (t < 256) ssq[((size_t)u.pm * BM + t) * 4 + u.pn] = (xq[t] + xq[256 + t]) + (xq[512 + t] + xq[768 + t]);
}
__device__ __forceinline__ float sq8(const v4u w, float q) { q = pg8::dot2sq(w.x, q); q = pg8::dot2sq(w.y, q); q = pg8::dot2sq(w.z, q); return pg8::dot2sq(w.w, q); }
#define ER_OFF(ai, m, bj) ((size_t)((ai) * HALF + (m) * 16) * D + (bj) * HALF)
struct EpiRes {
    static constexpr bool PERM = true, AFTER_DRAIN = false;
    bf16* hb; float* ssq; LAS float* xq;
    __device__ __forceinline__ void operator()(EPI_ARGS) const {
        const int row0 = u.pm * BM + wr * 64 + fr, col0 = u.pn * BM + wc * 32 + 8 * fq;
        const size_t o0 = (size_t)row0 * D + col0; bf16* p0 = hb + o0;
        v4u hv[2][4][2];
#pragma unroll
        for (int ai = 0; ai < 2; ++ai)
#pragma unroll
            for (int m = 0; m < 4; ++m)
#pragma unroll
                for (int bj = 0; bj < 2; ++bj) hv[ai][m][bj] = *(const v4u*)(p0 + ER_OFF(ai, m, bj));
        asm volatile("" ::: "memory");
        float q[2][4];
#pragma unroll
        for (int ai = 0; ai < 2; ++ai)
#pragma unroll
            for (int m = 0; m < 4; ++m) q[ai][m] = 0.f;
#pragma unroll
        for (int ai = 0; ai < 2; ++ai)
#pragma unroll
            for (int m = 0; m < 4; ++m)
#pragma unroll
                for (int bj = 0; bj < 2; ++bj) { f32x4 a, b; unpack8(hv[ai][m][bj], a, b); const v4u w = pack8(a + acc[ai][bj][m][0], b + acc[ai][bj][m][1]); q[ai][m] = sq8(w, q[ai][m]); st16(hb, (o0 + ER_OFF(ai, m, bj)) * 2, w); }
        publish_rowssq(q, xq, ssq, u, wr, wc, fr, fq);
    }
};
template <bool LAST> struct EpiPle {
    static constexpr bool PERM = true, AFTER_DRAIN = false;
    const bf16* hin; bf16* hout; float* out; const bf16* up; float* ssq; LAS float* xq;
    __device__ __forceinline__ void operator()(const f32x4 (&acc)[2][2][4][2], const Unit& u, int wr, int wc, int fr_, int fq_, const float (&rs)[2][4]) const {
        int fr = fr_, fq = fq_; asm volatile("" : "+v"(fr), "+v"(fq));
        const int row0 = u.pm * BM + wr * 64 + fr, col0 = u.pn * BM + wc * 32 + 8 * fq;
        const size_t o0 = (size_t)row0 * D + col0;
        v4u hv[4][2], uv[4][2];
        float q[2][4];
#pragma unroll
        for (int ai = 0; ai < 2; ++ai)
#pragma unroll
            for (int m = 0; m < 4; ++m) q[ai][m] = 0.f;
#pragma unroll
        for (int ai = 0; ai < 2; ++ai) {
#pragma unroll
            for (int m = 0; m < 4; ++m)
#pragma unroll
                for (int bj = 0; bj < 2; ++bj) { hv[m][bj] = *(const v4u*)(hin + o0 + ER_OFF(ai, m, bj)); uv[m][bj] = *(const v4u*)(up + o0 + ER_OFF(ai, m, bj)); }
            asm volatile("" ::: "memory");
#pragma unroll
            for (int m = 0; m < 4; ++m) { const float rn = rs[ai][m] * -1.4426950408889634f;
#pragma unroll
                for (int bj = 0; bj < 2; ++bj) { f32x4 a, b, x0_, x1_; unpack8(hv[m][bj], a, b); unpack8(uv[m][bj], x0_, x1_); const f32x4 g0 = acc[ai][bj][m][0] * rn, g1 = acc[ai][bj][m][1] * rn;
#pragma unroll
                    for (int e = 0; e < 4; ++e) { a[e] += x0_[e] * __builtin_amdgcn_rcpf(1.0f + __builtin_amdgcn_exp2f(g0[e])); b[e] += x1_[e] * __builtin_amdgcn_rcpf(1.0f + __builtin_amdgcn_exp2f(g1[e])); }
                    const size_t off = o0 + ER_OFF(ai, m, bj);
                    if (LAST) { st16(out, off * 4, __builtin_bit_cast(v4u, a)); st16(out, off * 4 + 16, __builtin_bit_cast(v4u, b)); } else { const v4u w = pack8(a, b); q[ai][m] = sq8(w, q[ai][m]); st16(hout, off * 2, w); } } }
            asm volatile("" ::: "memory");
        }
        if (!LAST) publish_rowssq(q, xq, ssq, u, wr, wc, fr, fq);
    }
};
#undef ER_OFF

typedef GAS unsigned gu32;
#define RLX_AGENT __ATOMIC_RELAXED, __HIP_MEMORY_SCOPE_AGENT
#define XB_TMO      128
#define XB_XCNT(j)  (256  + 64 * (j))
#define XB_XSUB(j)  (1280 + 64 * (j))
#define XB_XGEN(j)  (2304 + 64 * (j))
#define XB_FLAG(j)  (3328 + (j))
#define XCD_BAR_WORDS 3456
#define XB_SPIN_CAP (1u << 22)
__device__ __forceinline__ unsigned xb_ld(unsigned* p)              { return __hip_atomic_load(p, __ATOMIC_RELAXED, __HIP_MEMORY_SCOPE_AGENT); }
__device__ __forceinline__ unsigned xb_add(unsigned* p, unsigned v) { return __hip_atomic_fetch_add(p, v, __ATOMIC_RELAXED, __HIP_MEMORY_SCOPE_AGENT); }
__device__ __forceinline__ unsigned xb_xcc_id() { return (unsigned)__builtin_amdgcn_s_getreg((3 << 11) | 20) & 0xFu; }
#define XB_SPIN(cond, bar) do { unsigned _sp = 0; while (cond) { __builtin_amdgcn_s_sleep(1); \
    if ((++_sp & 255u) == 0u) { if (xb_ld(&(bar)[XB_TMO])) break; if (_sp > XB_SPIN_CAP) { atomicAdd(&(bar)[XB_TMO], 1u); break; } } } } while (0)
struct XcdBarrier { unsigned* bar; unsigned x; volatile LAS unsigned* st; };
__device__ __forceinline__ XcdBarrier xcd_barrier_post(unsigned* bar, volatile LAS unsigned* st) {
    XcdBarrier b; b.bar = bar; b.x = xb_xcc_id(); b.st = st;
    if (threadIdx.x == 0) st[2] = xb_add(&bar[XB_XCNT(b.x)], 1u);
    return b;
}
__device__ __forceinline__ void xcd_barrier_complete(unsigned* bar, unsigned x, unsigned& nloc, unsigned& amask, unsigned& even) {
    const unsigned G = gridDim.x * gridDim.y * gridDim.z;
    unsigned sum, msk, mine, sp = 0u;
    for (;;) {
        sum = 0u; msk = 0u; mine = 0u; even = 1u;
#pragma unroll
        for (unsigned j = 0; j < 16; ++j) { const unsigned c = xb_ld(&bar[XB_XCNT(j)]); sum += c; msk |= (c > 0u) ? (1u << j) : 0u; mine = (j == x) ? c : mine; even &= (c == (j < 8u ? 32u : 0u)) ? 1u : 0u; }
        if (sum == G) break;
        __builtin_amdgcn_s_sleep(1);
        if ((++sp & 255u) == 0u) { if (xb_ld(&bar[XB_TMO])) break; if (sp > XB_SPIN_CAP) { atomicAdd(&bar[XB_TMO], 1u); break; } }
    }
    nloc = mine > 0u ? mine : 1u; amask = msk ? msk : 1u; even = (even != 0u && G == 256u && sum == G) ? 1u : 0u;
}
template <int MODE>
__device__ __forceinline__ void p0_transpose_item(const float* W, int K, int N, int ldw, const float* gain, bf16* WT, int row_off, LAS float* scr, int item, int lane) {
    const int nblk = (N + 31) / 32, kb = item / nblk, nb = item % nblk, k0 = 64 * kb, n0 = 32 * nb;
    const int ncol = n0 + (lane & 31); const bool nok = ncol < N;
    float tv[32];
#pragma unroll
    for (int i = 0; i < 32; ++i) { const int kk = 2 * i + (lane >> 5); tv[i] = nok ? W[(size_t)(k0 + kk) * ldw + ncol] : 0.f; }
#pragma unroll
    for (int i = 0; i < 32; ++i) { const int kk = 2 * i + (lane >> 5); float v = tv[i]; if (gain) v *= gain[k0 + kk]; scr[kk * 33 + (lane & 31)] = v; }
    asm volatile("s_waitcnt lgkmcnt(0)" ::: "memory");
    const int c = lane & 7;
    int drow0;
    if (MODE == 0) drow0 = row_off + n0; else { const int isu = n0 >= FF ? 1 : 0, j0 = n0 - isu * FF; drow0 = 256 * (j0 / 128) + 128 * isu + (j0 % 128); }
#pragma unroll
    for (int j = 0; j < 4; ++j) { const int n = (lane >> 3) + 8 * j; const LAS float* s = scr + (8 * c) * 33 + n;
        v4u o; o.x = pk2(s[0 * 33], s[1 * 33]); o.y = pk2(s[2 * 33], s[3 * 33]); o.z = pk2(s[4 * 33], s[5 * 33]); o.w = pk2(s[6 * 33], s[7 * 33]);
        if (n0 + n < N) *(v4u*)(WT + (size_t)(drow0 + n) * K + k0 + 8 * c) = o; }
    asm volatile("s_waitcnt lgkmcnt(0)" ::: "memory");
}

struct Args { const float* in[19]; float* out; unsigned char* ws; int ph_lo, ph_hi; };
typedef const Args __attribute__((address_space(4))) CArgs;

constexpr int WI_IN = 16 * 96, WI_SQ = 16 * 32, WI_KV = 16 * 16, WI_GU = 16 * 176, WI_DN = 44 * 32, WI_PU = 4 * 32;
constexpr int WI_N0 = WI_IN + WI_SQ + WI_GU + WI_DN + WI_SQ + WI_PU, WI_N1 = WI_SQ + WI_KV + WI_SQ + WI_GU + WI_DN + WI_SQ + WI_PU;
__device__ __forceinline__ void weight_item(CArgs* A, unsigned char* ws, LAS float* scr, const int layer, int r, const int lane) {
    if (layer == 0) {
        if (r < WI_IN) { p0_transpose_item<0>(A->in[3], D, 3072, ML_IN, A->in[2], (bf16*)(ws + WS_WIN), 0, scr, r, lane); return; } r -= WI_IN;
        if (r < WI_SQ) { p0_transpose_item<0>(A->in[6], D, D, D, nullptr, (bf16*)(ws + WS_WOUT), 0, scr, r, lane); return; } r -= WI_SQ;
    } else {
        if (r < WI_SQ) { p0_transpose_item<0>(A->in[10], D, D, D, A->in[2] + D, (bf16*)(ws + WS_WQKV1), 0, scr, r, lane); return; } r -= WI_SQ;
        if (r < WI_KV) { p0_transpose_item<0>(A->in[8], D, 512, 512, A->in[7], (bf16*)(ws + WS_WQKV1), D, scr, r, lane); return; } r -= WI_KV;
        if (r < WI_SQ) { p0_transpose_item<0>(A->in[12], D, D, D, nullptr, (bf16*)(ws + WS_WO1), 0, scr, r, lane); return; } r -= WI_SQ;
    }
    const int l = layer;
    if (r < WI_GU) { p0_transpose_item<1>(A->in[14] + (size_t)l * D * 2 * FF, D, 2 * FF, 2 * FF, A->in[13] + l * D, (bf16*)(ws + WS_WGU + l * 11 * MiB), 0, scr, r, lane); return; } r -= WI_GU;
    if (r < WI_DN) { p0_transpose_item<0>(A->in[15] + (size_t)l * FF * D, FF, D, D, nullptr, (bf16*)(ws + WS_WDN + l * 6 * MiB), 0, scr, r, lane); return; } r -= WI_DN;
    if (r < WI_SQ) { p0_transpose_item<0>(A->in[17] + (size_t)l * D * D, D, D, D, A->in[16] + l * D, (bf16*)(ws + WS_WPG + l * 2 * MiB), 0, scr, r, lane); return; } r -= WI_SQ;
    p0_transpose_item<0>(A->in[18] + (size_t)l * PLE * D, PLE, D, D, nullptr, (bf16*)(ws + WS_WPU + l * (MiB / 2)), 0, scr, r, lane);
}
__device__ __forceinline__ void p_chunk(CArgs* A, unsigned char* ws, const size_t g0, const int lane) {
    const float* p = A->in[1]; bf16* pb = (bf16*)(ws + WS_PB); f32x4 a[4], b[4];
#pragma unroll
    for (int q = 0; q < 4; ++q) { const size_t ii = g0 + q * 64 + lane; a[q] = *(const f32x4*)(p + ii * 8); b[q] = *(const f32x4*)(p + ii * 8 + 4); }
#pragma unroll
    for (int q = 0; q < 4; ++q) { const size_t ii = g0 + q * 64 + lane; v4u w; w.x = pk2(a[q][0], a[q][1]); w.y = pk2(a[q][2], a[q][3]); w.z = pk2(b[q][0], b[q][1]); w.w = pk2(b[q][2], b[q][3]); *(v4u*)(pb + ii * 8) = w; }
}
__device__ __forceinline__ void xcd_barrier(const XcdBarrier& b, CArgs* ap = nullptr, LAS unsigned char* lds = nullptr, const int job = -1, const int G = 0, const int bx = 0, const int wave_s = 0, const unsigned ones = 0u, const bool xlocal = false) {
    asm volatile("s_waitcnt vmcnt(0)" ::: "memory");
    __syncthreads();
    if (job >= 0 && wave_s >= 1) {
        unsigned o_ = ones; asm volatile("" : "+s"(o_)); const int lane = (int)__builtin_amdgcn_mbcnt_hi(o_, __builtin_amdgcn_mbcnt_lo(o_, 0u));
        const int slot = (job & 3) * (G * 7) + bx * 7 + (wave_s - 1);
        if (job < 4) { if (slot < WI_N1) weight_item(ap, ap->ws, (LAS float*)(lds + wave_s * 16384), 1, slot, lane); }
        else if (slot < 4096) p_chunk(ap, ap->ws, (size_t)M * PLE / 8 + (size_t)slot * 256, lane);
        asm volatile("s_waitcnt vmcnt(0) lgkmcnt(0)" ::: "memory");
    }
    if (threadIdx.x == 0) {
        unsigned* bar = b.bar;
        __builtin_amdgcn_s_waitcnt(0);
        unsigned nloc = b.st[0], amask = b.st[1];
        if (nloc == 0u) { unsigned even; xcd_barrier_complete(bar, b.x, nloc, amask, even); b.st[0] = nloc; b.st[1] = amask; b.st[3] = even; }
        if (xlocal) amask = 1u << b.x;
        const unsigned old = xb_add(&bar[XB_XSUB(b.x)], 1u);
        const unsigned target = old / nloc + 1u;
        if (old + 1u == target * nloc) {
            if (!xlocal) { __builtin_amdgcn_fence(__ATOMIC_RELEASE, "agent"); asm volatile("s_waitcnt vmcnt(0)" ::: "memory"); }
            __hip_atomic_store(&bar[XB_FLAG(b.x)], target, __ATOMIC_RELAXED, __HIP_MEMORY_SCOPE_AGENT);
        }
        __builtin_amdgcn_fence(__ATOMIC_ACQUIRE, "agent");
        unsigned sp = 0u;
        for (;;) {
            unsigned f[16];
#pragma unroll
            for (unsigned j = 0; j < 16; ++j) f[j] = xb_ld(&bar[XB_FLAG(j)]);
            unsigned mn = target;
#pragma unroll
            for (unsigned j = 0; j < 16; ++j) { const unsigned v = ((amask >> j) & 1u) ? f[j] : target; mn = v < mn ? v : mn; }
            if (mn >= target) break;
            __builtin_amdgcn_s_sleep(1);
            if ((++sp & 255u) == 0u) { if (xb_ld(&bar[XB_TMO])) break; if (sp > XB_SPIN_CAP) { atomicAdd(&bar[XB_TMO], 1u); break; } }
        }
        asm volatile("s_waitcnt vmcnt(0)" ::: "memory");
    }
    __syncthreads();
}

__device__ __forceinline__ void p0_prologue(CArgs* A, LAS unsigned char* lds, int G, int vcu, int wave, int lane) {
    unsigned char* ws = A->ws;
    LAS float* scr = (LAS float*)(lds + wave * 16384);
    const int gw = vcu * NWAVES + wave, NGW = G * NWAVES;
    {
        const int tid = wave * 64 + lane;
        LAS f32x4* T = (LAS f32x4*)lds;
        { const float* W = A->in[3]; const float* gn = A->in[2];
          for (int idx = tid; idx < 4096; idx += NTHREADS) { const int k = idx >> 2, nq = idx & 3, j = k >> 8, lk = (k & 255) >> 2, e = k & 3;
              T[((j * 4 + e) * 4 + nq) * 64 + lk] = *(const f32x4*)(W + (size_t)k * ML_IN + 3072 + 4 * nq) * gn[k]; } }
        __syncthreads();
        const float* x = A->in[0]; bf16* hb = (bf16*)(ws + WS_HB); float* gates = (float*)(ws + WS_GATES); float* ssq0 = (float*)(ws + WS_SSQ0);
        const float bg = A->in[4][lane & 15];
        for (int m0 = gw * 4; m0 < M; m0 += NGW * 4) {
            f32x4 v[4][4]; float rstd[4];
#pragma unroll
            for (int r = 0; r < 4; ++r) { const f32x4* xr = (const f32x4*)(x + (size_t)(m0 + r) * D) + lane; float q = 0.f;
#pragma unroll
                for (int j = 0; j < 4; ++j) { v[r][j] = xr[64 * j]; q += (v[r][j][0] * v[r][j][0] + v[r][j][1] * v[r][j][1]) + (v[r][j][2] * v[r][j][2] + v[r][j][3] * v[r][j][3]); }
                const float qs = wave_sum(q, lane); rstd[r] = __builtin_amdgcn_rsqf(qs * (1.0f / D) + EPS);
                if (lane == 0) *(f32x4*)(ssq0 + (size_t)(m0 + r) * 4) = (f32x4){qs, 0.f, 0.f, 0.f};
                unsigned long long* o8 = (unsigned long long*)(hb + (size_t)(m0 + r) * D) + lane;
#pragma unroll
                for (int j = 0; j < 4; ++j) o8[64 * j] = (unsigned long long)pk2(v[r][j][0], v[r][j][1]) | ((unsigned long long)pk2(v[r][j][2], v[r][j][3]) << 32); }
            float o[64];
#pragma unroll
            for (int i = 0; i < 64; ++i) o[i] = 0.f;
#pragma unroll
            for (int j = 0; j < 4; ++j)
#pragma unroll
                for (int e = 0; e < 4; ++e)
#pragma unroll
                    for (int nq = 0; nq < 4; ++nq) { const f32x4 w = T[((j * 4 + e) * 4 + nq) * 64 + lane];
#pragma unroll
                        for (int r = 0; r < 4; ++r)
#pragma unroll
                            for (int i = 0; i < 4; ++i) o[r * 16 + nq * 4 + i] += v[r][j][e] * w[i];
                        if (nq == 3) asm volatile("" ::: "memory"); }
#define RED_STEP(OFF, N) _Pragma("unroll") for (int i = 0; i < (N) / 2; ++i) { const bool up = (lane & (OFF)) != 0; const float send = up ? o[i] : o[i + (N) / 2]; const float keep = up ? o[i + (N) / 2] : o[i]; o[i] = keep + shx(send, OFF, lane); }
            RED_STEP(32, 64) RED_STEP(16, 32) RED_STEP(8, 16) RED_STEP(4, 8) RED_STEP(2, 4) RED_STEP(1, 2)
#undef RED_STEP
            const int rr = lane >> 4; const float rsel = rr == 0 ? rstd[0] : (rr == 1 ? rstd[1] : (rr == 2 ? rstd[2] : rstd[3]));
            const float pre = o[0] * rsel + bg; const float t2 = __expf(pre * (2.0f / GATE_CAP)); const float cp = GATE_CAP * (t2 - 1.0f) * __builtin_amdgcn_rcpf(t2 + 1.0f);
            gates[(size_t)m0 * 16 + lane] = ((lane & 15) < 8) ? cp : -__logf(1.0f + __expf(-cp));
        }
        __syncthreads();
    }
    const bool all_here = !(SIDE_JOBS && MK_N_LAUNCHES == 1 && G == 256);
    for (int it = gw; it < WI_N0; it += NGW) weight_item(A, ws, scr, 0, it, lane);
    if (all_here) for (int it = gw; it < WI_N1; it += NGW) weight_item(A, ws, scr, 1, it, lane);
    { const size_t n8h = (size_t)M * PLE / 8 * (all_here ? 2 : 1);
      for (size_t g0 = (size_t)gw * 256; g0 < n8h; g0 += (size_t)NGW * 256) p_chunk(A, ws, g0, lane); }
    {
        float* rc = (float*)(ws + WS_ROPE); float* rsn = rc + SEQ * 8;
        const int gt = gw * 64 + lane;
        if (gt < SEQ * 8) { const int pos = gt >> 3, i = gt & 7;
            const float inv = (i == 0 ? 1.000000000e+00f : i == 1 ? 1.939227432e-01f : i == 2 ? 3.760603070e-02f : i == 3 ? 7.292664610e-03f : i == 4 ? 1.414213562e-03f : i == 5 ? 2.742481884e-04f : i == 6 ? 5.318295734e-05f : 1.031338525e-05f);
            const float angf = (float)pos * inv;
            const double rev = (double)angf * 0.15915494309189535; const double fr = rev - rint(rev);
            rc[gt] = __builtin_amdgcn_cosf((float)fr); rsn[gt] = __builtin_amdgcn_sinf((float)fr); }
    }
}

namespace ml {
template <int CTRL, int RMASK> __device__ __forceinline__ float dpp_f(float old, float v) { return __builtin_bit_cast(float, __builtin_amdgcn_update_dpp(__builtin_bit_cast(int, old), __builtin_bit_cast(int, v), CTRL, RMASK, 0xF, false)); }
__device__ __forceinline__ float scan_add64(float v) {
    v += dpp_f<0x111, 0xF>(0.f, v); v += dpp_f<0x112, 0xF>(0.f, v); v += dpp_f<0x114, 0xF>(0.f, v); v += dpp_f<0x118, 0xF>(0.f, v);
    v += dpp_f<0x142, 0xA>(0.f, v); v += dpp_f<0x143, 0xC>(0.f, v); return v; }
__device__ __forceinline__ float scan_max64(float v) {
    v = fmaxf(v, dpp_f<0x111, 0xF>(-INFINITY, v)); v = fmaxf(v, dpp_f<0x112, 0xF>(-INFINITY, v)); v = fmaxf(v, dpp_f<0x114, 0xF>(-INFINITY, v)); v = fmaxf(v, dpp_f<0x118, 0xF>(-INFINITY, v));
    v = fmaxf(v, dpp_f<0x142, 0xA>(-INFINITY, v)); v = fmaxf(v, dpp_f<0x143, 0xC>(-INFINITY, v)); return v; }
__device__ __forceinline__ float last64(float v) { return __builtin_bit_cast(float, __builtin_amdgcn_readlane(__builtin_bit_cast(int, v), 63)); }
typedef short bf16x8 __attribute__((ext_vector_type(8)));
typedef short s16x4 __attribute__((ext_vector_type(4)));
typedef short v4i16_t __attribute__((ext_vector_type(4)));
constexpr int KST = 160, VST = 288, QST = 144;
__device__ __forceinline__ s16x4 tr16(const LAS unsigned char* p) { return __builtin_bit_cast(s16x4, __builtin_amdgcn_ds_read_tr16_b64_v4i16((LAS v4i16_t*)p)); }
__device__ __forceinline__ bf16x8 cat8(s16x4 a, s16x4 b) { return (bf16x8){a[0], a[1], a[2], a[3], b[0], b[1], b[2], b[3]}; }
__device__ __forceinline__ bf16x8 trfrag(const LAS unsigned char* img, int stride, int ks, int col0, int c, int g) {
    const LAS unsigned char* p = img + (32 * ks + 4 * g + (c >> 2)) * stride + (col0 + 4 * (c & 3)) * 2;
    return cat8(tr16(p), tr16(p + 16 * stride));
}
__device__ __forceinline__ void st8(LAS unsigned char* d, float a, float b, float c, float e) { v2u w; w.x = pk2(a, b); w.y = pk2(c, e); *(LAS v2u*)d = w; }

__device__ __forceinline__ void phase_a(CArgs* A, LAS unsigned char* lds, int G, const int bx, const int tid) {
    unsigned char* ws = A->ws; const int lane = tid & 63, wid = __builtin_amdgcn_readfirstlane(tid >> 6), c = lane & 15, g = lane >> 4;
    LAS unsigned char* Ks = lds; LAS unsigned char* Vs = lds + 64 * KST; LAS float* wl = (LAS float*)(Vs + 64 * VST);
    const float* gates = (const float*)(ws + WS_GATES); const bf16* K0 = (const bf16*)(ws + WS_K0); const bf16* V0 = (const bf16*)(ws + WS_V0);
    bf16* cloc = (bf16*)(ws + WS_CLOC); float* nloc = (float*)(ws + WS_NLOC); float* mloc = (float*)(ws + WS_MLOC); float* glast = (float*)(ws + WS_GLAST);
    const int NU = NB_ * ML_H * ML_NC, srow = tid >> 3, pc = tid & 7;
    v4u kxA, vx0A, vx1A, kxB, vx0B, vx1B; float liA = 0.f, lfA = 0.f, liB = 0.f, lfB = 0.f;
    unsigned zz = 0u; asm volatile("" : "+v"(zz));
#define MLA_LOAD(S, unit) do { const int bh_ = (unit) >> 6, c_ = (unit) & 63, b_ = bh_ >> 3, h_ = bh_ & 7, r_ = b_ * SEQ + c_ * ML_L + srow; \
        kx##S = *(const v4u*)(K0 + (size_t)r_ * 512 + h_ * 64 + pc * 8); vx0##S = *(const v4u*)(V0 + (size_t)r_ * 1024 + h_ * 128 + pc * 16); vx1##S = *(const v4u*)(V0 + (size_t)r_ * 1024 + h_ * 128 + pc * 16 + 8); \
        if (tid < 64) { const size_t gr_ = (size_t)(b_ * SEQ + c_ * ML_L + tid) * 16; li##S = gates[gr_ + h_]; lf##S = gates[gr_ + 8 + h_]; } } while (0)
#define MLA_UNIT(S, unit) do { \
        if (tid < 64) { \
            const float gs = scan_add64(lf##S); const float gl = last64(gs); \
            const float a = gl - gs + li##S; const float ml = last64(scan_max64(a)); const float w_ = __expf(a - ml); \
            wl[tid] = w_; *(LAS v4u*)(Vs + tid * VST + 256) = (v4u){f2bf(w_), zz, zz, zz}; *(LAS v4u*)(Vs + tid * VST + 272) = (v4u){zz, zz, zz, zz};     \
            if (tid == 0) { mloc[unit] = ml; glast[unit] = gl; } \
        } \
        *(LAS v4u*)(Ks + srow * KST + pc * 16) = kx##S; \
        __syncthreads(); \
        { const float w = wl[srow]; v4u o0, o1; \
          o0.x = pk2(w * bf_lo(vx0##S.x), w * bf_hi(vx0##S.x)); o0.y = pk2(w * bf_lo(vx0##S.y), w * bf_hi(vx0##S.y)); o0.z = pk2(w * bf_lo(vx0##S.z), w * bf_hi(vx0##S.z)); o0.w = pk2(w * bf_lo(vx0##S.w), w * bf_hi(vx0##S.w)); \
          o1.x = pk2(w * bf_lo(vx1##S.x), w * bf_hi(vx1##S.x)); o1.y = pk2(w * bf_lo(vx1##S.y), w * bf_hi(vx1##S.y)); o1.z = pk2(w * bf_lo(vx1##S.z), w * bf_hi(vx1##S.z)); o1.w = pk2(w * bf_lo(vx1##S.w), w * bf_hi(vx1##S.w)); \
          *(LAS v4u*)(Vs + srow * VST + pc * 32) = o0; *(LAS v4u*)(Vs + srow * VST + pc * 32 + 16) = o1; } \
        __syncthreads(); \
        { const int nx2 = (unit) + 2 * ust; if (nx2 < NUE) MLA_LOAD(S, nx2); }                       \
        { bf16x8 bfr[2]; \
          _Pragma("unroll") for (int ks = 0; ks < 2; ++ks) bfr[ks] = trfrag(Vs, VST, ks, 16 * wid, c, g); \
          bf16* orow = cloc + ((size_t)(unit) * 128 + 16 * wid + c) * 64 + 4 * g; \
          _Pragma("unroll") for (int kt = 0; kt < 4; ++kt) { f32x4 acc = (f32x4){0.f, 0.f, 0.f, 0.f}; \
              _Pragma("unroll") for (int ks = 0; ks < 2; ++ks) acc = __builtin_amdgcn_mfma_f32_16x16x32_bf16(trfrag(Ks, KST, ks, 16 * kt, c, g), bfr[ks], acc, 0, 0, 0); \
              v2u w; w.x = pk2(acc[0], acc[1]); w.y = pk2(acc[2], acc[3]); *(v2u*)(orow + 16 * kt) = w; } \
          if (wid == 0) { _Pragma("unroll") for (int ks = 0; ks < 2; ++ks) bfr[ks] = trfrag(Vs, VST, ks, 128, c, g); \
              _Pragma("unroll") for (int kt = 0; kt < 4; ++kt) { f32x4 acc = (f32x4){0.f, 0.f, 0.f, 0.f}; \
                  _Pragma("unroll") for (int ks = 0; ks < 2; ++ks) acc = __builtin_amdgcn_mfma_f32_16x16x32_bf16(trfrag(Ks, KST, ks, 16 * kt, c, g), bfr[ks], acc, 0, 0, 0); \
                  if (c == 0) *(f32x4*)(nloc + (size_t)(unit) * 64 + 16 * kt + 4 * g) = acc; } } } \
        __syncthreads(); } while (0)
    const bool bl = (G == 256); const int ust = bl ? 32 : G, NUE = bl ? 512 * (bx & 7) + 512 : NU;
    int unit = bl ? 512 * (bx & 7) + (bx >> 3) : bx;
    if (unit < NUE) MLA_LOAD(A, unit);
    if (unit + ust < NUE) MLA_LOAD(B, unit + ust);
    for (;;) {
        if (unit >= NUE) break;
        MLA_UNIT(A, unit); unit += ust;
        if (unit >= NUE) break;
        MLA_UNIT(B, unit); unit += ust;
    }
#undef MLA_LOAD
#undef MLA_UNIT
}
__device__ __forceinline__ void phase_scan(CArgs* A, int G, const int bx, const int tid) {
    unsigned char* ws = A->ws;
    bf16* cloc = (bf16*)(ws + WS_CLOC); float* nloc = (float*)(ws + WS_NLOC); const float* mloc = (const float*)(ws + WS_MLOC); const float* glast = (const float*)(ws + WS_GLAST); float* mprev = (float*)(ws + WS_MPREV);
    for (int su = (G == 256) ? 32 * (bx & 7) + (bx >> 3) : bx; su < 64 * 4; su += G) {
        const int bh = su >> 2, qt = su & 3;
        bf16* cp = cloc + (size_t)bh * 64 * 8192 + qt * 2048 + tid * 4;
        float C0 = 0.f, C1 = 0.f, C2 = 0.f, C3 = 0.f, n = 0.f, m = 0.f;
#pragma unroll 1
        for (int c0 = 0; c0 < 64; c0 += 8) {
            v2u cl[8]; float ml[8], gl[8], nl[8];
#pragma unroll
            for (int i = 0; i < 8; ++i) { cl[i] = *(const v2u*)(cp + (size_t)(c0 + i) * 8192); ml[i] = mloc[bh * 64 + c0 + i]; gl[i] = glast[bh * 64 + c0 + i];
                nl[i] = (qt == 0 && tid < 64) ? nloc[(size_t)(bh * 64 + c0 + i) * 64 + tid] : 0.f; }
#pragma unroll
            for (int i = 0; i < 8; ++i) {
                const float mn = fmaxf(gl[i] + m, ml[i]), sp = __expf(gl[i] + m - mn), sl = __expf(ml[i] - mn);
                v2u o; o.x = pk2(C0, C1); o.y = pk2(C2, C3); *(v2u*)(cp + (size_t)(c0 + i) * 8192) = o;
                C0 = sp * C0 + sl * bf_lo(cl[i].x); C1 = sp * C1 + sl * bf_hi(cl[i].x); C2 = sp * C2 + sl * bf_lo(cl[i].y); C3 = sp * C3 + sl * bf_hi(cl[i].y);
                if (qt == 0 && tid < 64) { nloc[(size_t)(bh * 64 + c0 + i) * 64 + tid] = n; n = sp * n + sl * nl[i]; }
                if (qt == 0 && tid == 0) mprev[bh * 64 + c0 + i] = m;
                m = mn;
            }
        }
    }
}
__device__ __forceinline__ void phase_c(CArgs* A, LAS unsigned char* lds, int G, const int bx, const int tid) {
    unsigned char* ws = A->ws; const int lane = tid & 63, wid = __builtin_amdgcn_readfirstlane(tid >> 6), c = lane & 15, g = lane >> 4, jt = wid & 3, vh = wid >> 2;
    LAS unsigned char* Qs = lds; LAS unsigned char* Ks = Qs + 64 * QST; LAS unsigned char* Cs = Ks + 64 * QST; LAS unsigned char* Vs = Cs + 128 * QST; LAS unsigned char* Os = Vs + 64 * VST;
    LAS float* sc = (LAS float*)(Os + 64 * VST);
    const float* gates = (const float*)(ws + WS_GATES); const bf16* Q0 = (const bf16*)(ws + WS_Q0); const bf16* K0 = (const bf16*)(ws + WS_K0); const bf16* V0 = (const bf16*)(ws + WS_V0);
    const bf16* OG = (const bf16*)(ws + WS_OG); bf16* HC = (bf16*)(ws + WS_V0);
    const bf16* cprev = (const bf16*)(ws + WS_CLOC); const float* nprev = (const float*)(ws + WS_NLOC); const float* mprev = (const float*)(ws + WS_MPREV);
    const float* mh_gain = A->in[5];
    const int NU = NB_ * ML_H * ML_NC, srow = tid >> 3, pc = tid & 7;
    v4u qx, kx, vx0, vx1, cx0, cx1, ox0, ox1; float li = 0.f, lf = 0.f, mp = 0.f, np = 0.f;
#define MLC_LOAD(unit) do { const int bh_ = (unit) >> 6, c_ = (unit) & 63, b_ = bh_ >> 3, h_ = bh_ & 7, r_ = b_ * SEQ + c_ * ML_L + srow; \
        qx = *(const v4u*)(Q0 + (size_t)r_ * 512 + h_ * 64 + pc * 8); kx = *(const v4u*)(K0 + (size_t)r_ * 512 + h_ * 64 + pc * 8); \
        vx0 = *(const v4u*)(V0 + (size_t)r_ * 1024 + h_ * 128 + pc * 16); vx1 = *(const v4u*)(V0 + (size_t)r_ * 1024 + h_ * 128 + pc * 16 + 8); \
        ox0 = *(const v4u*)(OG + (size_t)r_ * 1024 + h_ * 128 + pc * 16); ox1 = *(const v4u*)(OG + (size_t)r_ * 1024 + h_ * 128 + pc * 16 + 8); \
        cx0 = *(const v4u*)(cprev + (size_t)(unit) * 8192 + tid * 16); cx1 = *(const v4u*)(cprev + (size_t)(unit) * 8192 + tid * 16 + 8); \
        if (tid < 64) { const size_t gr_ = (size_t)(b_ * SEQ + c_ * ML_L + tid) * 16; li = gates[gr_ + h_]; lf = gates[gr_ + 8 + h_]; mp = mprev[unit]; np = nprev[(size_t)(unit) * 64 + tid]; } } while (0)
    const bool bl = (G == 256); const int ust = bl ? 32 : G, NUE = bl ? 512 * (bx & 7) + 512 : NU;
    int unit = bl ? 512 * (bx & 7) + (bx >> 3) : bx;
    if (unit < NUE) MLC_LOAD(unit);
    for (; unit < NUE; unit += ust) {
        const int bh = unit >> 6, cc = unit & 63, b = bh >> 3, h = bh & 7, row0 = b * SEQ + cc * ML_L;
        if (tid < 64) {
            const float gs = scan_add64(lf); const float pm = scan_max64(li - gs);
            const float mintra = gs + pm, minter = gs + mp, mc = fmaxf(minter, mintra);
            sc[tid] = gs - mc; sc[64 + tid] = li - gs; sc[128 + tid] = __expf(minter - mc); sc[192 + tid] = __expf(-mc); sc[256 + tid] = np;
        }
        *(LAS v4u*)(Qs + srow * QST + pc * 16) = qx; *(LAS v4u*)(Ks + srow * QST + pc * 16) = kx;
        *(LAS v4u*)(Vs + srow * VST + pc * 32) = vx0; *(LAS v4u*)(Vs + srow * VST + pc * 32 + 16) = vx1;
        *(LAS v4u*)(Os + srow * VST + pc * 32) = ox0; *(LAS v4u*)(Os + srow * VST + pc * 32 + 16) = ox1;
        { const int cv = tid >> 2, cp = (tid & 3) * 2; *(LAS v4u*)(Cs + cv * QST + cp * 16) = cx0; *(LAS v4u*)(Cs + cv * QST + cp * 16 + 16) = cx1; }
        __syncthreads();
        const int nxt = unit + ust;
        if (nxt < NUE) MLC_LOAD(nxt);
        const int j = 16 * jt + c;
        bf16x8 qf[2];
#pragma unroll
        for (int ks = 0; ks < 2; ++ks) qf[ks] = *(const LAS bf16x8*)(Qs + j * QST + (32 * ks + 8 * g) * 2);
        f32x4 p[4]; float rs = 0.f; const float uj = sc[j];
#pragma unroll
        for (int st = 0; st < 4; ++st) { f32x4 acc = (f32x4){0.f, 0.f, 0.f, 0.f};
#pragma unroll
            for (int ks = 0; ks < 2; ++ks) acc = __builtin_amdgcn_mfma_f32_16x16x32_bf16(*(const LAS bf16x8*)(Ks + (16 * st + c) * QST + (32 * ks + 8 * g) * 2), qf[ks], acc, 0, 0, 0);
            const f32x4 tt = *(const LAS f32x4*)(sc + 64 + 16 * st + 4 * g);
#pragma unroll
            for (int r = 0; r < 4; ++r) { const int s = 16 * st + 4 * g + r; const float v = (s <= j) ? acc[r] * __expf(uj + tt[r]) : 0.f; p[st][r] = v; rs += v; } }
        bf16x8 pb[2];
#pragma unroll
        for (int ks = 0; ks < 2; ++ks) { v4u w; w.x = pk2(p[2 * ks][0], p[2 * ks][1]); w.y = pk2(p[2 * ks][2], p[2 * ks][3]); w.z = pk2(p[2 * ks + 1][0], p[2 * ks + 1][1]); w.w = pk2(p[2 * ks + 1][2], p[2 * ks + 1][3]); pb[ks] = __builtin_bit_cast(bf16x8, w); }
        f32x4 hh[4]; const float wi = sc[128 + j];
#pragma unroll
        for (int vt = 0; vt < 4; ++vt) { f32x4 acc = (f32x4){0.f, 0.f, 0.f, 0.f};
#pragma unroll
            for (int ks = 0; ks < 2; ++ks) acc = __builtin_amdgcn_mfma_f32_16x16x32_bf16(*(const LAS bf16x8*)(Cs + (64 * vh + 16 * vt + c) * QST + (32 * ks + 8 * g) * 2), qf[ks], acc, 0, 0, 0);
            acc = acc * wi;
#pragma unroll
            for (int ks = 0; ks < 2; ++ks) acc = __builtin_amdgcn_mfma_f32_16x16x32_bf16(trfrag(Vs, VST, ks, 64 * vh + 16 * vt, c, g), pb[ks], acc, 0, 0, 0);
            hh[vt] = acc; }
        float qn = 0.f;
        { const v4u q0 = *(const LAS v4u*)(Qs + j * QST + 32 * g), q1 = *(const LAS v4u*)(Qs + j * QST + 32 * g + 16); const LAS f32x4* nv = (const LAS f32x4*)(sc + 256 + 16 * g);
          const f32x4 n0 = nv[0], n1 = nv[1], n2 = nv[2], n3 = nv[3];
          qn = (bf_lo(q0.x) * n0[0] + bf_hi(q0.x) * n0[1] + bf_lo(q0.y) * n0[2] + bf_hi(q0.y) * n0[3]) + (bf_lo(q0.z) * n1[0] + bf_hi(q0.z) * n1[1] + bf_lo(q0.w) * n1[2] + bf_hi(q0.w) * n1[3])
             + (bf_lo(q1.x) * n2[0] + bf_hi(q1.x) * n2[1] + bf_lo(q1.y) * n2[2] + bf_hi(q1.y) * n2[3]) + (bf_lo(q1.z) * n3[0] + bf_hi(q1.z) * n3[1] + bf_lo(q1.w) * n3[2] + bf_hi(q1.w) * n3[3]); }
        qn += shx(qn, 16, lane); qn += shx(qn, 32, lane); rs += shx(rs, 16, lane); rs += shx(rs, 32, lane);
        const float inv = 1.0f / fmaxf(fabsf(wi * qn + rs), sc[192 + j]);
        float ss = 0.f;
#pragma unroll
        for (int vt = 0; vt < 4; ++vt) { hh[vt] = hh[vt] * inv; ss += (hh[vt][0] * hh[vt][0] + hh[vt][1] * hh[vt][1]) + (hh[vt][2] * hh[vt][2] + hh[vt][3] * hh[vt][3]); }
        ss += shx(ss, 16, lane); ss += shx(ss, 32, lane);
        if (g == 0) sc[320 + 64 * vh + j] = ss;
        __syncthreads();
        const float rn = __builtin_amdgcn_rsqf((sc[320 + j] + sc[384 + j]) * (1.0f / ML_DV) + EPS);
#pragma unroll
        for (int vt = 0; vt < 4; ++vt) { const int v0 = 64 * vh + 16 * vt + 4 * g; const v2u ow = *(const LAS v2u*)(Os + j * VST + v0 * 2); const f32x4 gn = *(const f32x4*)(mh_gain + v0);
            st8(Vs + j * VST + v0 * 2, hh[vt][0] * rn * gn[0] * sigmoidf_(bf_lo(ow.x)), hh[vt][1] * rn * gn[1] * sigmoidf_(bf_hi(ow.x)), hh[vt][2] * rn * gn[2] * sigmoidf_(bf_lo(ow.y)), hh[vt][3] * rn * gn[3] * sigmoidf_(bf_hi(ow.y))); }
        __syncthreads();
        { const v4u o0 = *(const LAS v4u*)(Vs + srow * VST + pc * 32), o1 = *(const LAS v4u*)(Vs + srow * VST + pc * 32 + 16); bf16* op = HC + (size_t)(row0 + srow) * 1024 + h * 128 + pc * 16;
          *(v4u*)op = o0; *(v4u*)(op + 8) = o1; }
        __syncthreads();
    }
#undef MLC_LOAD
}
}

namespace mattn {
using bf16=__hip_bfloat16;
using bf16x8=__attribute__((ext_vector_type(8)))short;
using s16x4=__attribute__((ext_vector_type(4)))short;
using f32x16=__attribute__((ext_vector_type(16)))float;
using u32x4=__attribute__((ext_vector_type(4)))unsigned;
constexpr int BATCH=8,NHEAD=16,SEQ=4096,D=64,DM=NHEAD*D,KP=256;
constexpr int NW=8,QBLK=32,QB=QBLK*NW,KVBLK=64,NQB=SEQ/QB;
constexpr int ATTN_PITCH=DM, ATTN_UNIT_ROWS=QB;
__device__ __forceinline__ int crow(int r,int hi){return (r&3)+8*(r>>2)+4*hi;}
#define SBAR() __builtin_amdgcn_sched_barrier(0)
__device__ __forceinline__ void cmask(f32x16&p0,f32x16&p1,int jb,int qrel,int hi){
  asm volatile("":"+v"(hi),"+v"(qrel));
  const float NEG=-INFINITY; int kb=64*jb+4*hi;
  #pragma unroll
  for(int r=0;r<16;++r){int kv=kb+(r&3)+8*(r>>2); if(kv>qrel)p0[r]=NEG; if(kv+32>qrel)p1[r]=NEG;}
}

constexpr int NSLOT=3, SLOTB=8192;
constexpr int LDS_K=0, LDS_V=NSLOT*SLOTB, LDS_WS=2*NSLOT*SLOTB, LDS_OST=LDS_WS+NW*64*4, LDS_KM=LDS_OST+NW*4096, LDS_BYTES=LDS_KM+4096;
constexpr float C2=0.125f*1.4426950408889634f;
__device__ __forceinline__ void glds16(const void*sbase,unsigned voff,unsigned lds_dst){unsigned keep;
  asm volatile("s_nop 4\n\ts_mov_b32 %0, m0\n\ts_mov_b32 m0, %3\n\ts_nop 0\n\tglobal_load_lds_dwordx4 %1, %2\n\ts_mov_b32 m0, %0":"=&s"(keep):"v"(voff),"s"(sbase),"s"(lds_dst):"memory");}
__device__ __forceinline__ float max3f(float a,float b,float c){float r;asm("v_max3_f32 %0, %1, %2, %3":"=v"(r):"v"(a),"v"(b),"v"(c));return r;}
__device__ __forceinline__ float max2f(float a,float b){float r;asm("v_max_f32_e32 %0, %1, %2":"=v"(r):"v"(a),"v"(b));return r;}
__device__ __forceinline__ float fadd_s(float a,float b){float r;asm("v_add_f32_e32 %0, %1, %2":"=v"(r):"v"(a),"v"(b));return r;}
__device__ __forceinline__ float fsub_s(float a,float b){float r;asm("v_sub_f32_e32 %0, %1, %2":"=v"(r):"v"(a),"v"(b));return r;}
typedef float f32x2_t __attribute__((ext_vector_type(2))); typedef __bf16 bf16x2_t __attribute__((ext_vector_type(2)));
__device__ __forceinline__ unsigned cvtpk_s(float lo,float hi){f32x2_t v={lo,hi};bf16x2_t b=__builtin_convertvector(v,bf16x2_t);return __builtin_bit_cast(unsigned,b);}
#define WAIT_BAR(N) asm volatile("s_waitcnt vmcnt(" #N ") lgkmcnt(0)\n\ts_barrier":::"memory")

__device__ __forceinline__ void qkt(f32x16&p0,f32x16&p1,const char*Kslot,const bf16x8*qr,const f32x16&negm,int r32,int hi){
  const char*kb=Kslot+hi*1024+r32*16;
  #pragma unroll
  for(int d0=0;d0<4;++d0){
    const bf16x8 b0=*reinterpret_cast<const bf16x8*>(kb+d0*2048);
    const bf16x8 b1=*reinterpret_cast<const bf16x8*>(kb+d0*2048+512);
    if(d0==0){p0=__builtin_amdgcn_mfma_f32_32x32x16_bf16(b0,qr[0],negm,0,0,0);p1=__builtin_amdgcn_mfma_f32_32x32x16_bf16(b1,qr[0],negm,0,0,0);}
    else{p0=__builtin_amdgcn_mfma_f32_32x32x16_bf16(b0,qr[d0],p0,0,0,0);p1=__builtin_amdgcn_mfma_f32_32x32x16_bf16(b1,qr[d0],p1,0,0,0);}}
}
typedef __attribute__((address_space(3))) const char* lds_cptr;
typedef short v4i16_t __attribute__((ext_vector_type(4)));
__device__ __forceinline__ void kload8(bf16x8*kf,lds_cptr kp){
  kf[0]=*(const __attribute__((address_space(3))) bf16x8*)(kp);      kf[1]=*(const __attribute__((address_space(3))) bf16x8*)(kp+512);
  kf[2]=*(const __attribute__((address_space(3))) bf16x8*)(kp+2048); kf[3]=*(const __attribute__((address_space(3))) bf16x8*)(kp+2560);
  kf[4]=*(const __attribute__((address_space(3))) bf16x8*)(kp+4096); kf[5]=*(const __attribute__((address_space(3))) bf16x8*)(kp+4608);
  kf[6]=*(const __attribute__((address_space(3))) bf16x8*)(kp+6144); kf[7]=*(const __attribute__((address_space(3))) bf16x8*)(kp+6656);
}
__device__ __forceinline__ void kload2(bf16x8*kf,lds_cptr kp,int j){ kf[2*j]=*(const __attribute__((address_space(3))) bf16x8*)(kp+j*2048); kf[2*j+1]=*(const __attribute__((address_space(3))) bf16x8*)(kp+j*2048+512); }
__device__ __forceinline__ s16x4 vtr(lds_cptr p){ return __builtin_bit_cast(s16x4,__builtin_amdgcn_ds_read_tr16_b64_v4i16((__attribute__((address_space(3))) v4i16_t*)p)); }
__device__ __forceinline__ float rowmax(const f32x16&p0,const f32x16&p1){
  float a=max3f(p0[0],p0[1],p1[0]),b=max3f(p0[2],p0[3],p1[1]);a=max3f(a,p1[2],p1[3]);
  #pragma unroll
  for(int r=4;r<16;r+=4){a=max3f(a,p0[r],p0[r+1]);b=max3f(b,p0[r+2],p0[r+3]);a=max3f(a,p1[r],p1[r+1]);b=max3f(b,p1[r+2],p1[r+3]);}
  const float m=max2f(a,b);
  auto rr=__builtin_amdgcn_permlane32_swap(__float_as_uint(m),__float_as_uint(m),false,false);
  return max2f(__uint_as_float(rr[0]),__uint_as_float(rr[1]));
}
__device__ __forceinline__ void pv(f32x16*o,int vb,bf16x8 pa0,bf16x8 pa1,bf16x8 pa2,bf16x8 pa3){
  #pragma unroll
  for(int d0=0;d0<2;++d0){s16x4 lo[4],hi[4];
    #pragma unroll
    for(int ks=0;ks<4;++ks){
      asm volatile("ds_read_b64_tr_b16 %0,%1 offset:%c2":"=&v"(lo[ks]):"v"(vb),"i"(d0*4096+ks*1024):"memory");
      asm volatile("ds_read_b64_tr_b16 %0,%1 offset:%c2":"=&v"(hi[ks]):"v"(vb),"i"(d0*4096+ks*1024+512):"memory");}
    asm volatile("s_waitcnt lgkmcnt(0)":::"memory");SBAR();
    #define PK(k) (bf16x8){lo[k][0],lo[k][1],lo[k][2],lo[k][3],hi[k][0],hi[k][1],hi[k][2],hi[k][3]}
    o[d0]=__builtin_amdgcn_mfma_f32_32x32x16_bf16(pa0,PK(0),o[d0],0,0,0);
    o[d0]=__builtin_amdgcn_mfma_f32_32x32x16_bf16(pa1,PK(1),o[d0],0,0,0);
    o[d0]=__builtin_amdgcn_mfma_f32_32x32x16_bf16(pa2,PK(2),o[d0],0,0,0);
    o[d0]=__builtin_amdgcn_mfma_f32_32x32x16_bf16(pa3,PK(3),o[d0],0,0,0);
    #undef PK
  }
}

#ifndef ATTN_STORE16
#define ATTN_STORE16(p,v) (*(u32x4*)(p)=(v))
#endif
__device__ __forceinline__ void attn_unit(int b,int h,int qb,const bf16*Q,const bf16*__restrict__ K,const bf16*__restrict__ V,bf16*O,char*shm,const float*kmsum,const float mref,const bool fill_km,const int tid){
  const int lane=tid&63,r32=lane&31,hi=lane>>5; const int wid=__builtin_amdgcn_readfirstlane(tid>>6);
  const long rowbase=(long)b*SEQ; const int q0=qb*QB;
  const bf16*Qw=Q+(rowbase+q0+wid*QBLK)*DM+h*D;
  const bf16*Kh=K+rowbase*KP+(h>>2)*D,*Vh=V+rowbase*KP+(h>>2)*D;
  const lds_cptr shm3=(lds_cptr)shm;
  const unsigned lds0=(unsigned)(uintptr_t)shm;
  float*wsf=(float*)(shm+LDS_WS)+wid*64;
  const unsigned kvoff=(unsigned)(lane*KP+wid*8)*2u;
  const unsigned vvoff=(unsigned)((16*(wid&3)+(lane>>2))*KP+(wid>>2)*32+(lane&3)*8)*2u;
  const unsigned kdst=lds0+LDS_K+wid*1024, vdst=lds0+LDS_V+wid*1024;
  #define DMA_K(t,slot) glds16(Kh+(long)(t)*KVBLK*KP,kvoff,(unsigned)__builtin_amdgcn_readfirstlane(kdst+(slot)))
  #define DMA_V(t,slot) glds16(Vh+(long)(t)*KVBLK*KP,vvoff,(unsigned)__builtin_amdgcn_readfirstlane(vdst+(slot)))
  const int vb0=(int)(lds0+LDS_V)+((lane>>4)&1)*32+(lane&3)*8+(4*hi+((lane&15)>>2))*64;
  const char*Kbase=shm+LDS_K; bf16x8 kf[8];
  const lds_cptr kp0=shm3+LDS_K+hi*1024+r32*16; const lds_cptr vp0=shm3+LDS_V+((lane>>4)&1)*32+(lane&3)*8+(4*hi+((lane&15)>>2))*64;
  const int NT=(q0+QB)/KVBLK;
  typedef __attribute__((address_space(3))) float ldsf;
  if(fill_km){ const float*ks0=kmsum+((size_t)b*16*4+(h>>2))*64;
    typedef __attribute__((address_space(3))) unsigned short ldsh;
    #pragma unroll
    for(int i=0;i<2;++i){const int idx=tid+512*i,n=idx>>6,d=idx&63; const float v=ks0[(size_t)n*256+d];
      const unsigned hb=cvtpk_s(v,0.f)&0xffffu; const unsigned lb=cvtpk_s(v-__uint_as_float(hb<<16),0.f)&0xffffu;
      ldsh*kp_=(ldsh*)(shm3+LDS_KM+(d>>3)*512+(d&7)*2); kp_[n*8]=(unsigned short)hb; kp_[(16+n)*8]=(unsigned short)lb;}
    asm volatile("s_waitcnt vmcnt(0) lgkmcnt(0)\n\ts_barrier":::"memory"); }
  DMA_K(0,0);DMA_V(0,0);DMA_K(1,SLOTB);
  bf16x8 qr[4];
  #pragma unroll
  for(int d0=0;d0<4;++d0)qr[d0]=*reinterpret_cast<const bf16x8*>(&Qw[(long)r32*DM+d0*16+hi*8]);
  unsigned selm=1u<<qb;
  if(qb>0){
    f32x16 gp;
    const lds_cptr kmp=shm3+LDS_KM+hi*512+r32*16;
    #pragma unroll
    for(int d0=0;d0<4;++d0){ const bf16x8 a=*(const __attribute__((address_space(3))) bf16x8*)(kmp+d0*1024);
      if(d0==0)gp=__builtin_amdgcn_mfma_f32_32x32x16_bf16(a,qr[0],f32x16{},0,0,0); else gp=__builtin_amdgcn_mfma_f32_32x32x16_bf16(a,qr[d0],gp,0,0,0); }
    float g[16];
    #pragma unroll
    for(int j=0;j<8;++j){ const float sg=gp[j]+gp[j+8]; const int n0=(j&3)+8*(j>>2);
      auto rr=__builtin_amdgcn_permlane32_swap(__float_as_uint(sg),__float_as_uint(sg),false,false);
      g[n0]=(n0<qb)?__uint_as_float(rr[0]):-INFINITY; g[n0+4]=(n0+4<qb)?__uint_as_float(rr[1]):-INFINITY; }
    #pragma unroll
    for(int r=0;r<3;++r){ float best=-INFINITY; int bi=0;
      #pragma unroll
      for(int n=0;n<15;++n)if(g[n]>best){best=g[n];bi=n;}
      if(best>-INFINITY)selm|=1u<<bi;
      #pragma unroll
      for(int n=0;n<15;++n)g[n]=(n==bi)?-INFINITY:g[n]; }
  }
  float l_reg=0.f;f32x16 o[2];o[0]=f32x16{};o[1]=f32x16{};f32x16 negm;
  #define SETNEG(t) do{ const float v_=((selm>>((t)>>2))&1u)?-mref:-INFINITY; _Pragma("unroll") for(int r=0;r<16;++r)negm[r]=v_; asm volatile("":"+v"(negm)); }while(0)
  SETNEG(0);
  const int qrel=wid*QBLK+r32;
  #define CMASK(P0,P1,t) do{int jb_=(t)-(NT-4); if(jb_>=0)cmask(P0,P1,jb_,qrel,hi);}while(0)
  #define START(P0,P1) do{ _Pragma("unroll") for(int r=0;r<16;++r)P0[r]=__builtin_amdgcn_exp2f(P0[r]); }while(0)
  #define RESC() do{}while(0)
  f32x16 pA0,pA1,pB0,pB1;
  int sl_prev=0,sl_cur=0,sl_next=SLOTB;
  #define ROT() do{sl_prev=sl_cur;sl_cur=sl_next;sl_next=(sl_next==(NSLOT-1)*SLOTB)?0:sl_next+SLOTB;}while(0)
  DMA_K(2,2*SLOTB);
  WAIT_BAR(3);
  qkt(pA0,pA1,Kbase,qr,negm,r32,hi);asm volatile("s_nop 15\n\ts_nop 7":"+v"(pA0),"+v"(pA1));CMASK(pA0,pA1,0);
  START(pA0,pA1);
  _Pragma("unroll") for(int r=0;r<16;++r)pA1[r]=__builtin_amdgcn_exp2f(pA1[r]);
  WAIT_BAR(0);
  DMA_K(3,0);DMA_V(1,SLOTB);
  ROT();
  kload8(kf,kp0+sl_cur);
  WAIT_BAR(2);
  s16x4 vlo[8],vhi[8]; u32x4 pw0,pw1,pw2,pw3;
  #define PKW(P,B) cvtpk_s(P[B],P[B+1])
  #define PAF(k) __builtin_bit_cast(bf16x8,pw##k)
  #define VFR(i) (bf16x8){vlo[i][0],vlo[i][1],vlo[i][2],vlo[i][3],vhi[i][0],vhi[i][1],vhi[i][2],vhi[i][3]}
  #define PIN(x) asm volatile("":"+v"(x))
  #define MX3(a,b,c) __builtin_fmaxf(__builtin_fmaxf((a),(b)),(c))
  #define GAPA(MF,A0,A1,A2,A3,W0,W1,PW) do{ MF; sacc+=A0; sacc+=A1; sacc+=A2; sacc+=A3; PIN(sacc); W0; W1; PIN(PW); SBAR(); }while(0)
  #define EX(v) __builtin_amdgcn_exp2f(v)
  #define GAPB(MF,X,B) do{ MF; X[B]=EX(X[B]); X[B+1]=EX(X[B+1]); X[B+2]=EX(X[B+2]); X[B+3]=EX(X[B+3]); PIN(X); SBAR(); }while(0)
  #define VRD(i) do{ vlo[i]=vtr(vp_+(((i)>>2)*4096+((i)&3)*1024)); vhi[i]=vtr(vp_+(((i)>>2)*4096+((i)&3)*1024+512)); }while(0)
  #define KRD(G,j) do{ if(G){ kload2(kf,kp0+sl_next,j); SBAR(); } }while(0)
  #define STEP(C0,C1,P0,P1,t,GK,GV,GL) do{ if((((t))&3)==0){SETNEG(t);} SBAR(); \
    const lds_cptr vp_=vp0+sl_prev; \
    VRD(0); SBAR(); float sacc=(P0[0]+P0[1]); \
    GAPA(C0=__builtin_amdgcn_mfma_f32_32x32x16_bf16(kf[0],qr[0],negm,0,0,0), P0[2],P0[3],P0[4],P0[5],     pw0[0]=PKW(P0,0), pw0[1]=PKW(P0,2), pw0); \
    VRD(4); SBAR(); GAPA(C1=__builtin_amdgcn_mfma_f32_32x32x16_bf16(kf[1],qr[0],negm,0,0,0), P0[6],P0[7],P0[8],P0[9],     pw0[2]=PKW(P0,4), pw0[3]=PKW(P0,6), pw0); \
    VRD(1); SBAR(); GAPA(C0=__builtin_amdgcn_mfma_f32_32x32x16_bf16(kf[2],qr[1],C0,0,0,0),   P0[10],P0[11],P0[12],P0[13], pw1[0]=PKW(P0,8), pw1[1]=PKW(P0,10), pw1); \
    VRD(5); SBAR(); GAPA(C1=__builtin_amdgcn_mfma_f32_32x32x16_bf16(kf[3],qr[1],C1,0,0,0),   P0[14],P0[15],P1[0],P1[1],   pw1[2]=PKW(P0,12),pw1[3]=PKW(P0,14), pw1); \
    VRD(2); SBAR(); GAPA(C0=__builtin_amdgcn_mfma_f32_32x32x16_bf16(kf[4],qr[2],C0,0,0,0),   P1[2],P1[3],P1[4],P1[5],     pw2[0]=PKW(P1,0), pw2[1]=PKW(P1,2), pw2); \
    VRD(6); SBAR(); GAPA(C1=__builtin_amdgcn_mfma_f32_32x32x16_bf16(kf[5],qr[2],C1,0,0,0),   P1[6],P1[7],P1[8],P1[9],     pw2[2]=PKW(P1,4), pw2[3]=PKW(P1,6), pw2); \
    VRD(3); SBAR(); GAPA(C0=__builtin_amdgcn_mfma_f32_32x32x16_bf16(kf[6],qr[3],C0,0,0,0),   P1[10],P1[11],P1[12],P1[13], pw3[0]=PKW(P1,8), pw3[1]=PKW(P1,10), pw3); \
    VRD(7); SBAR(); GAPA(C1=__builtin_amdgcn_mfma_f32_32x32x16_bf16(kf[7],qr[3],C1,0,0,0),   P1[14],P1[15],0.f,0.f,       pw3[2]=PKW(P1,12),pw3[3]=PKW(P1,14), pw3); \
    l_reg+=sacc; \
    if(GK){DMA_K((t)+3,sl_cur);} if(GV){DMA_V((t)+1,sl_next);} \
    CMASK(C0,C1,t); \
    SBAR(); \
    GAPB(o[0]=__builtin_amdgcn_mfma_f32_32x32x16_bf16(PAF(0),VFR(0),o[0],0,0,0), C0,0); \
    GAPB(o[1]=__builtin_amdgcn_mfma_f32_32x32x16_bf16(PAF(0),VFR(4),o[1],0,0,0), C0,4); \
    KRD(GL,0); GAPB(o[0]=__builtin_amdgcn_mfma_f32_32x32x16_bf16(PAF(1),VFR(1),o[0],0,0,0), C0,8); \
    KRD(GL,1); GAPB(o[1]=__builtin_amdgcn_mfma_f32_32x32x16_bf16(PAF(1),VFR(5),o[1],0,0,0), C0,12); \
    KRD(GL,2); GAPB(o[0]=__builtin_amdgcn_mfma_f32_32x32x16_bf16(PAF(2),VFR(2),o[0],0,0,0), C1,0); \
    KRD(GL,3); GAPB(o[1]=__builtin_amdgcn_mfma_f32_32x32x16_bf16(PAF(2),VFR(6),o[1],0,0,0), C1,4); \
    GAPB(o[0]=__builtin_amdgcn_mfma_f32_32x32x16_bf16(PAF(3),VFR(3),o[0],0,0,0), C1,8); \
    GAPB(o[1]=__builtin_amdgcn_mfma_f32_32x32x16_bf16(PAF(3),VFR(7),o[1],0,0,0), C1,12); \
    }while(0)
  int t=1;
  #undef CMASK
  #define CMASK(P0,P1,t) do{}while(0)
  for(;t+5<NT;t+=2){
    STEP(pB0,pB1,pA0,pA1,t,true,true,true);     WAIT_BAR(2); RESC(); ROT();
    STEP(pA0,pA1,pB0,pB1,t+1,true,true,true);   WAIT_BAR(2); RESC(); ROT();
  }
  #undef CMASK
  #define CMASK(P0,P1,t) do{int jb_=(t)-(NT-4); if(jb_>=0)cmask(P0,P1,jb_,qrel,hi);}while(0)
  #define ENDW(tt) do{ if((tt)+3<NT){WAIT_BAR(2);} else if((tt)+2<NT){WAIT_BAR(1);} else {WAIT_BAR(0);} }while(0)
  for(;t+1<NT;t+=2){
    STEP(pB0,pB1,pA0,pA1,t,(t+3<NT),(t+1<NT),(t+1<NT));       ENDW(t);   RESC(); ROT();
    STEP(pA0,pA1,pB0,pB1,t+1,(t+4<NT),(t+2<NT),(t+2<NT));     ENDW(t+1); RESC(); ROT();
  }
  STEP(pB0,pB1,pA0,pA1,NT-1,false,false,false); RESC();
  { float sacc=pB0[0]+pB0[1]; _Pragma("unroll") for(int r=2;r<16;++r)sacc+=pB0[r]; _Pragma("unroll") for(int r=0;r<16;++r)sacc+=pB1[r]; l_reg+=sacc;
    pw0=(u32x4){PKW(pB0,0),PKW(pB0,2),PKW(pB0,4),PKW(pB0,6)};pw1=(u32x4){PKW(pB0,8),PKW(pB0,10),PKW(pB0,12),PKW(pB0,14)};pw2=(u32x4){PKW(pB1,0),PKW(pB1,2),PKW(pB1,4),PKW(pB1,6)};pw3=(u32x4){PKW(pB1,8),PKW(pB1,10),PKW(pB1,12),PKW(pB1,14)};
    SBAR(); pv(o,vb0+sl_cur,PAF(0),PAF(1),PAF(2),PAF(3)); }
  #undef PKW
  #undef PAF
  #undef VFR
  #undef PIN
  #undef MX3
  #undef GAPA
  #undef GAPB
  #undef EX
  #undef VRD
  #undef KRD
  #undef STEP
  #undef ENDW
  {auto rr=__builtin_amdgcn_permlane32_swap(__float_as_uint(l_reg),__float_as_uint(l_reg),false,false);l_reg=__uint_as_float(rr[0])+__uint_as_float(rr[1]);}
  if(hi==0)wsf[32+r32]=l_reg;asm volatile("s_waitcnt lgkmcnt(0)":::"memory");
  float rli[16];
  #pragma unroll
  for(int r=0;r<16;++r)rli[r]=__builtin_amdgcn_rcpf(wsf[32+crow(r,hi)]);
  bf16*Ow=O+(rowbase+q0+wid*QBLK)*DM+h*D;
  { bf16*stg=(bf16*)(shm+LDS_OST)+wid*2048;
    #pragma unroll
    for(int r=0;r<16;++r){const int orow=crow(r,hi);
      #pragma unroll
      for(int d0=0;d0<2;++d0)stg[orow*64+d0*32+r32]=__float2bfloat16(o[d0][r]*rli[r]);}
    asm volatile("s_waitcnt lgkmcnt(0)":::"memory");
    #pragma unroll
    for(int i=0;i<4;++i){const int row=i*8+(lane>>3),ch=lane&7; const u32x4 v=*(const u32x4*)(stg+row*64+ch*8); ATTN_STORE16(Ow+(long)row*DM+ch*8,v);} }
  asm volatile("s_waitcnt lgkmcnt(0)\n\ts_barrier":::"memory");
  #undef DMA_K
  #undef DMA_V
  #undef CMASK
  #undef START
  #undef SETNEG
  #undef RESC
  #undef ROT
}
constexpr int ATTN_LDS_BYTES=LDS_BYTES;
struct AttnTensors { const bf16* Q; const bf16* K; const bf16* V; bf16* O; const float* kmsum; };
struct AttnUnit { int bh; int qb; };
struct StaticOrder {
  int vcu, G;
  __device__ __forceinline__ StaticOrder(int grid,int vc):vcu(vc),G(grid){}
  __device__ __forceinline__ bool next(int i,AttnUnit&u)const{ const int uu=vcu+i*G; if(uu>=2048)return false; const int v=uu&255,ii=uu>>8,hf=v&1,j=ii>>1; u.bh=v>>1; u.qb=(ii&1)?15-2*j-hf:2*j+hf; return true; }
};
__device__ __forceinline__ void attn_phase(char*lds,const AttnTensors&T,const StaticOrder&S,const float mref,const int tid){
  AttnUnit u;
  int last=-1;
  for(int i=0;S.next(i,u);++i){ const int key=(u.bh/NHEAD)*4+((u.bh%NHEAD)>>2); attn_unit(u.bh/NHEAD,u.bh%NHEAD,u.qb,T.Q,T.K,T.V,T.O,lds,T.kmsum,mref,key!=last,tid); last=key; }
}
#undef SBAR
#undef WAIT_BAR
}

constexpr int N_PHASES = 18;
#define PHASE_TID() unsigned ones_ = ones; asm volatile("" : "+s"(ones_)); const int tid = (wave_s << 6) | (int)__builtin_amdgcn_mbcnt_hi(ones_, __builtin_amdgcn_mbcnt_lo(ones_, 0u));
__device__ __forceinline__ void run_phase(const int ph, CArgs* ap, LAS unsigned char* lds, const int G, const int bx, const int wave_s, const unsigned ones) {
    const int vcu = (G % 8 == 0) ? (bx % 8) * (G / 8) + bx / 8 : bx;
    CArgs* A = ap;
    unsigned char* ws = A->ws;
    const int l = ph >= 10 ? 1 : 0;
    bf16* HB0 = (bf16*)(ws + WS_HB); bf16* HB1 = (bf16*)(ws + WS_HB2);
    bf16* HBl = l ? HB1 : HB0; bf16* HBo = l ? HB0 : HB1;
    float* SSQ0 = (float*)(ws + WS_SSQ0); float* SSQ1 = (float*)(ws + WS_SSQ1); LAS float* XQ = (LAS float*)(lds + LDSCTL_OFF + 12288);
    switch (ph) {
    case 0: { PHASE_TID() p0_prologue(A, lds, G, vcu, wave_s, tid & 63); } break;
    case 1: { PHASE_TID() pg8::Gemm g{HB0, (const bf16*)(ws + WS_WIN), M, ML_INP, D, SSQ0}; pg8::StaticOrder S; S.init(M, ML_INP, G, bx);
        EpiMl E{ws};
        pg8::gemm_phase<EpiMl, pg8::StaticOrder, true, true, true>(lds, g, S, E, tid); } break;
    case 2: { PHASE_TID() ml::phase_a(A, lds, G, bx, tid); } break;
    case 3: { PHASE_TID() ml::phase_scan(A, G, bx, tid); } break;
    case 4: { PHASE_TID() ml::phase_c(A, lds, G, bx, tid); } break;
    case 10: { PHASE_TID() pg8::Gemm g{HB1, (const bf16*)(ws + WS_WQKV1), M, 1536, D, SSQ1}; pg8::StaticOrder S; S.init(M, 1536, G, bx);
        EpiQkv1 E{ws, lds + LDSCTL_OFF + 1024, A->in[11], A->in[9]};
        pg8::gemm_phase<EpiQkv1, pg8::StaticOrder, true, true, true>(lds, g, S, E, tid); } break;
    case 11: break;
    case 12: { PHASE_TID()
        const mattn::AttnTensors AT{(const mattn::bf16*)(ws + WS_Q1), (const mattn::bf16*)(ws + WS_K1), (const mattn::bf16*)(ws + WS_V1), (mattn::bf16*)(ws + WS_AO), (const float*)(ws + WS_KMP)};
        const mattn::StaticOrder S(G, vcu);
        float mref; { const int lane = tid & 63; const float gq = wave_max(fabsf(A->in[11][lane]), lane), gk = wave_max(fabsf(A->in[9][lane]), lane);
            mref = __builtin_bit_cast(float, __builtin_amdgcn_readfirstlane(__builtin_bit_cast(int, 64.0f * 0.125f * 1.4426950408889634f * gq * gk))); }
        mattn::attn_phase((char*)lds, AT, S, mref, tid);
        } break;
    case 5: case 13: case 7: case 15: {
        PHASE_TID() const bool dn = (ph == 7 || ph == 15);
        const size_t aoff = dn ? WS_ACT : (ph == 5 ? WS_V0 : WS_AO), boff = dn ? WS_WDN + l * 6 * MiB : (ph == 5 ? WS_WOUT : WS_WO1);
        pg8::Gemm g{(const bf16*)(ws + aoff), (const bf16*)(ws + boff), M, D, dn ? FF : D, nullptr}; pg8::StaticOrder S; S.init(M, D, G, bx);
        EpiRes E{HBl, l ? SSQ1 : SSQ0, XQ};
        pg8::gemm_phase<EpiRes, pg8::StaticOrder, true, true, false>(lds, g, S, E, tid); } break;
    case 6: case 14: { PHASE_TID() pg8::Gemm g{HBl, (const bf16*)(ws + WS_WGU + l * 11 * MiB), M, 2 * FF, D, l ? SSQ1 : SSQ0}; pg8::StaticOrder S; S.init(M, 2 * FF, G, bx);
        EpiSwiglu E{(bf16*)(ws + WS_ACT)};
        pg8::gemm_phase<EpiSwiglu, pg8::StaticOrder, true, true, true>(lds, g, S, E, tid); } break;
    case 8: case 16: { PHASE_TID() pg8::Gemm g{(const bf16*)(ws + WS_PB) + (size_t)l * M * PLE, (const bf16*)(ws + WS_WPU + l * (MiB / 2)), M, D, PLE, nullptr}; pg8::StaticOrder S; S.init(M, D, G, bx);
        EpiPlain E{(bf16*)(ws + WS_UP), D};
        pg8::gemm_phase<EpiPlain, pg8::StaticOrder, true, true, false>(lds, g, S, E, tid); } break;
    case 9: { PHASE_TID() pg8::Gemm g{HB0, (const bf16*)(ws + WS_WPG), M, D, D, SSQ0}; pg8::StaticOrder S; S.init(M, D, G, bx);
        EpiPle<false> E{HB0, HB1, nullptr, (const bf16*)(ws + WS_UP), SSQ1, XQ};
        pg8::gemm_phase<EpiPle<false>, pg8::StaticOrder, true, true, true>(lds, g, S, E, tid); } break;
    case 17: { PHASE_TID() pg8::Gemm g{HB1, (const bf16*)(ws + WS_WPG + 2 * MiB), M, D, D, SSQ1}; pg8::StaticOrder S; S.init(M, D, G, bx);
        EpiPle<true> E{HB1, nullptr, A->out, (const bf16*)(ws + WS_UP), nullptr, XQ};
        pg8::gemm_phase<EpiPle<true>, pg8::StaticOrder, true, true, true>(lds, g, S, E, tid); } break;
    default: break;
    }
}
#ifndef PHASE_MASK
#define PHASE_MASK 0xFFFFFFFFu
#endif
#ifndef LOCAL_MODE
#define LOCAL_MODE 1
#endif

__global__ void __launch_bounds__(NTHREADS, 2) yoco_fwd(Args args) {
    extern __shared__ __attribute__((aligned(16))) unsigned char lds_raw[];
    LAS unsigned char* lds = (LAS unsigned char*)lds_raw;
    volatile LAS unsigned* MISC = (volatile LAS unsigned*)(lds + LDSCTL_OFF);
    for (int u = threadIdx.x; u < (LDS_BYTES - LDSCTL_OFF) / 4; u += NTHREADS) ((LAS unsigned*)(lds + LDSCTL_OFF))[u] = 0u;
    __syncthreads();
    XcdBarrier bar; bar.bar = (unsigned*)(args.ws + WS_CTL) + 4096; bar.x = 0; bar.st = nullptr;
    if (MK_N_LAUNCHES == 1) bar = xcd_barrier_post((unsigned*)(args.ws + WS_CTL) + 4096, MISC + 8);
    const int lo = args.ph_lo, hi = args.ph_hi;
    const int wave_s = __builtin_amdgcn_readfirstlane(threadIdx.x >> 6);
#pragma unroll 1
    for (int ph = lo; ph < hi; ++ph) {
        CArgs* ap = (CArgs*)__builtin_amdgcn_kernarg_segment_ptr(); unsigned ones = ~0u; int G = gridDim.x, bx = blockIdx.x;
        bool local = false;
        if (LOCAL_MODE && MK_N_LAUNCHES == 1 && ph > 0) { const unsigned ev = (unsigned)__builtin_amdgcn_readfirstlane((int)MISC[11]), rk = (unsigned)__builtin_amdgcn_readfirstlane((int)MISC[10]);
            if (ev != 0u && rk < 32u && bar.x < 8u) { local = true; bx = (int)(rk * 8u + bar.x); } }
        asm volatile("" : "+s"(ap), "+s"(ones), "+s"(G), "+s"(bx));
#if defined(TS_MASK)
        if (wave_s == 0) MISC[17] = (unsigned)__builtin_amdgcn_s_memrealtime();
#endif
        if ((PHASE_MASK >> ph) & 1u) run_phase(ph, ap, lds, G, bx, wave_s, ones);
#if defined(TS_MASK)
        { XcdBarrier b2 = bar; asm volatile("" : "+s"(b2.bar)); xcd_barrier(b2); }
        if (((TS_MASK >> ph) & 1u) && wave_s == 0) MISC[16] = MISC[16] + ((unsigned)__builtin_amdgcn_s_memrealtime() - MISC[17]);
#else
        if (ph + 1 < hi && ph != 7 && ph != 15 && ph != 10) { XcdBarrier b2 = bar; asm volatile("" : "+s"(b2.bar));
            const int job = (SIDE_JOBS && G == 256) ? ((ph >= 1 && ph <= 4) ? ph - 1 : (ph == 5 ? 4 : (ph == 6 ? 5 : (ph == 8 ? 6 : -1)))) : -1;
            xcd_barrier(b2, ap, lds, job, G, bx, wave_s, ones, local && !(ph == 5 || ph == 9 || ph == 13)); }
#endif
    }
#if defined(TS_MASK)
    if (blockIdx.x == 0 && wave_s == 0) args.out[0] += (float)MISC[16] * 0.001f;
#endif
}

extern "C" void kernel_launch(void* const* d_in, const int* in_sizes, int n_in, void* d_out, int out_size, void* d_ws, size_t ws_size, hipStream_t stream) {
    static int grid = 0;
    if (grid == 0) {
        if (n_in != 19 || in_sizes[0] != M * D || out_size != M * D || ws_size < WS_END) { fprintf(stderr, "kernel_launch: unexpected shapes (n_in %d, in0 %d, out %d, ws %zu); nothing launched\n", n_in, n_in > 0 ? in_sizes[0] : -1, out_size, ws_size); grid = -1; return; }
        int dev = 0, cus = 0, per_cu = 0;
        if (hipGetDevice(&dev) != hipSuccess || hipDeviceGetAttribute(&cus, hipDeviceAttributeMultiprocessorCount, dev) != hipSuccess) { grid = -1; return; }
        if (hipFuncSetAttribute((const void*)yoco_fwd, hipFuncAttributeMaxDynamicSharedMemorySize, LDS_BYTES) != hipSuccess) { fprintf(stderr, "kernel_launch: hipFuncSetAttribute failed\n"); grid = -1; return; }
        if (hipOccupancyMaxActiveBlocksPerMultiprocessor(&per_cu, (const void*)yoco_fwd, NTHREADS, LDS_BYTES) != hipSuccess || per_cu < 1) { fprintf(stderr, "kernel_launch: occupancy query says %d blocks per CU\n", per_cu); per_cu = 1; }
        (void)hipGetLastError();
        grid = cus;
    }
    if (grid < 0) return;
    (void)hipMemsetAsync((char*)d_ws + WS_CTL, 0, CTL_ZERO_BYTES, stream);
    Args a{};
    for (int i = 0; i < 19; ++i) a.in[i] = (const float*)d_in[i];
    a.out = (float*)d_out; a.ws = (unsigned char*)d_ws;
    if (MK_N_LAUNCHES == 1) {
        a.ph_lo = 0; a.ph_hi = N_PHASES;
        hipLaunchKernelGGL(yoco_fwd, dim3(grid), dim3(NTHREADS), LDS_BYTES, stream, a);
    } else {
        for (int p = 0; p < N_PHASES; ++p) { a.ph_lo = p; a.ph_hi = p + 1; hipLaunchKernelGGL(yoco_fwd, dim3(grid), dim3(NTHREADS), LDS_BYTES, stream, a); }
    }
}
```

```cpp
#include <hip/hip_runtime.h>
#include <hip/hip_bf16.h>
#include <cstdio>
#include <cstdint>

#ifndef SIDE_JOBS
#define SIDE_JOBS 1
#endif
#ifndef MK_N_LAUNCHES
#define MK_N_LAUNCHES 1
#endif

#define LAS __attribute__((address_space(3)))
#define GAS __attribute__((address_space(1)))

#ifndef SSQ_INLOOP
#define SSQ_INLOOP 0
#endif
namespace pg8 {
#define PG8_LAS __attribute__((address_space(3)))
typedef unsigned short bf16_t;
typedef short bf16x8 __attribute__((ext_vector_type(8)));
typedef float f32x4 __attribute__((ext_vector_type(4)));
typedef unsigned u32x4 __attribute__((ext_vector_type(4)));
typedef unsigned u32x2 __attribute__((ext_vector_type(2)));
constexpr int BM = 256, BK = 64, HALF = 128, HTB = HALF * BK * 2, STAGE_BYTES = 8 * HTB, NXCD = 8, WGM = 8;

__host__ __device__ __forceinline__ int lds_byte(int r, int c) { const int st = (r >> 4) * 2 + (c >> 5), rr = r & 15, cc = c & 31, ob = rr * 64 + cc * 2; return st * 1024 + (ob ^ (((ob >> 9) & 1) << 5)); }
__host__ __device__ __forceinline__ void stage_rc(int b, int& R, int& C) { const int st = b / 1024, sb = b % 1024, swz = sb ^ (((sb >> 9) & 1) << 5); R = (st >> 1) * 16 + swz / 64; C = (st & 1) * 32 + (swz % 64) / 2; }
__host__ __device__ __forceinline__ int perm32(int rho) { const int n = rho >> 4, i = rho & 15; return 8 * (i >> 2) + 4 * n + (i & 3); }

struct Unit { int pm, pn; };
struct Gemm { const bf16_t* A; const bf16_t* Bt; int M, N, K; const float* ssq; };

struct StaticOrder {
    int nM, nN, nwg, G, c;
    __host__ __device__ void init(int M, int N, int G_, int c_) { nM = M / BM; nN = N / BM; nwg = nM * nN; G = G_; c = c_; }
    __host__ __device__ bool next(int i, Unit& u) const {
        const long L = (long)i * G + c; if (L >= nwg) return false;
        int wgid = (int)L; { const int q = nwg / NXCD, r = nwg % NXCD, xcd = wgid % NXCD, off = wgid / NXCD; wgid = (xcd < r ? xcd * (q + 1) : r * (q + 1) + (xcd - r) * q) + off; }
        const int nig = WGM * nN, gid = wgid / nig, fm = gid * WGM, gsz = (nM % WGM == 0) ? WGM : ((nM - fm) < WGM ? (nM - fm) : WGM);
        u.pm = fm + ((wgid % nig) % gsz); u.pn = (wgid % nig) / gsz; return true;
    }
    __device__ __forceinline__ void a_ready(const Unit&) const {}
    __device__ __forceinline__ void done(const Unit&) const {}
};

typedef float f32x2_t __attribute__((ext_vector_type(2))); typedef __bf16 bf16x2_t __attribute__((ext_vector_type(2)));
__device__ __forceinline__ unsigned cvt_pk_bf16(float lo, float hi) { f32x2_t v = {lo, hi}; bf16x2_t b = __builtin_convertvector(v, bf16x2_t); return __builtin_bit_cast(unsigned, b); }

static_assert(true, "");
__device__ __forceinline__ float dot2sq(unsigned w, float acc) { typedef __bf16 bfx2 __attribute__((ext_vector_type(2))); const bfx2 v = __builtin_bit_cast(bfx2, w); return __builtin_amdgcn_fdot2_f32_bf16(v, v, acc, false); }
__device__ __forceinline__ float shx16(float v, int lane) { return __builtin_bit_cast(float, __builtin_amdgcn_ds_bpermute((lane ^ 16) << 2, __builtin_bit_cast(int, v))); }
__device__ __forceinline__ float shx32(float v, int lane) { return __builtin_bit_cast(float, __builtin_amdgcn_ds_bpermute((lane ^ 32) << 2, __builtin_bit_cast(int, v))); }
__device__ __forceinline__ float sum_x16(float v) { const unsigned u = __builtin_bit_cast(unsigned, v); auto r = __builtin_amdgcn_permlane16_swap(u, u, false, false); return __builtin_bit_cast(float, (unsigned)r[0]) + __builtin_bit_cast(float, (unsigned)r[1]); }
__device__ __forceinline__ float sum_x32(float v) { const unsigned u = __builtin_bit_cast(unsigned, v); auto r = __builtin_amdgcn_permlane32_swap(u, u, false, false); return __builtin_bit_cast(float, (unsigned)r[0]) + __builtin_bit_cast(float, (unsigned)r[1]); }
template <class Epi, class Sched, bool ALIGN_EPI = false, bool SP2 = false, bool ROWSSQ = false>
__device__ __forceinline__ void gemm_phase(PG8_LAS unsigned char* lds, const Gemm g, const Sched& S, const Epi& E, const int tid) {
    const int wid = __builtin_amdgcn_readfirstlane(tid >> 6), lane = tid & 63, wr = wid >> 2, wc = wid & 3, fr = lane & 15, fq = lane >> 4;
    int K_ = g.K; asm volatile("" : "+s"(K_));
    const int K = K_, nt = K / BK;
    unsigned voffA[2], voffB[2];
#pragma unroll
    for (int i = 0; i < 2; ++i) { int R, C; stage_rc(tid * 16 + i * 8192, R, C); const int Rb = Epi::PERM ? ((R & ~31) + perm32(R & 31)) : R;
        voffA[i] = (unsigned)(R * K + C) * 2u; voffB[i] = (unsigned)(Rb * K + C) * 2u; }
    const size_t kstep = (size_t)(BK * 2);
    const size_t hstep = (size_t)HALF * K * 2;
    const size_t tstep = 2 * hstep;
    const unsigned ldsw = (unsigned)wid * 1024u;
    const int aoff = lds_byte(wr * 64 + fr, fq * 8), boff = lds_byte(wc * 32 + fr, fq * 8);
#define PG8_SA(b, h) (((b) * 2 + (h)) * HTB)
#define PG8_SB(b, h) ((4 + (b) * 2 + (h)) * HTB)
    const unsigned lds_u = (unsigned)(uintptr_t)lds + ldsw;
#define PG8_STAGE(bufoff, gbase, voff) do { _Pragma("unroll") for (int _i = 0; _i < 2; ++_i) \
        asm volatile("s_mov_b32 m0, %2\n\ts_nop 0\n\tglobal_load_lds_dwordx4 %0, %1" :: "v"((voff)[_i]), "s"((const char*)(gbase)), "s"(lds_u + (unsigned)((bufoff) + _i * 8192)) : "memory", "m0"); } while (0)
#define PG8_LDA(dst, b, h) do { _Pragma("unroll") for (int m = 0; m < 4; ++m) _Pragma("unroll") for (int k = 0; k < 2; ++k) dst[m][k] = *(const PG8_LAS bf16x8*)(lds + PG8_SA(b, h) + aoff + m * 2048 + k * 1024); } while (0)
#define PG8_LDB(dst, b, h) do { _Pragma("unroll") for (int n = 0; n < 2; ++n) _Pragma("unroll") for (int k = 0; k < 2; ++k) dst[n][k] = *(const PG8_LAS bf16x8*)(lds + PG8_SB(b, h) + boff + n * 2048 + k * 1024); } while (0)
#define PG8_MMA(ai, bj, At, Bt) do { __builtin_amdgcn_s_setprio(1); _Pragma("unroll") for (int m = 0; m < 4; ++m) _Pragma("unroll") for (int n = 0; n < 2; ++n) _Pragma("unroll") for (int k = 0; k < 2; ++k) \
        acc[ai][bj][m][n] = __builtin_amdgcn_mfma_f32_16x16x32_bf16(Bt[n][k], At[m][k], acc[ai][bj][m][n], 0, 0, 0); __builtin_amdgcn_s_setprio(0); } while (0)
#define PG8_SSQ(ai, At) do { if constexpr (ROWSSQ && SSQ_INLOOP) { _Pragma("unroll") for (int m = 0; m < 4; ++m) _Pragma("unroll") for (int k = 0; k < 2; ++k) { const u32x4 w_ = __builtin_bit_cast(u32x4, At[m][k]); \
        ssq[ai][m] = dot2sq(w_.x, ssq[ai][m]); ssq[ai][m] = dot2sq(w_.y, ssq[ai][m]); ssq[ai][m] = dot2sq(w_.z, ssq[ai][m]); ssq[ai][m] = dot2sq(w_.w, ssq[ai][m]); } } } while (0)
#define PG8_WAIT_V(n) asm volatile("s_waitcnt vmcnt(" #n ")" ::: "memory")
#define PG8_WAIT_L(n) asm volatile("s_waitcnt lgkmcnt(" #n ")" ::: "memory")
#define PG8_BAR __builtin_amdgcn_s_barrier()
#define PG8_SCHED __builtin_amdgcn_sched_barrier(0)
    Unit cur, nxt; int ui = 0;
    if (!S.next(0, cur)) return;
    f32x4 acc[2][2][4][2];
#pragma unroll
    for (int a = 0; a < 2; ++a)
#pragma unroll
        for (int b = 0; b < 2; ++b)
#pragma unroll
            for (int m = 0; m < 4; ++m)
#pragma unroll
                for (int n = 0; n < 2; ++n) acc[a][b][m][n] = (f32x4){0.f, 0.f, 0.f, 0.f};
    bf16x8 At[4][2], B0[2][2], B1[2][2];
    float ssq[2][4];
#pragma unroll
    for (int a = 0; a < 2; ++a)
#pragma unroll
        for (int m = 0; m < 4; ++m) ssq[a][m] = 0.f;
    const char* cA = (const char*)g.A + (size_t)cur.pm * tstep; const char* cB = (const char*)g.Bt + (size_t)cur.pn * tstep;
#define PG8_SSQ_LOAD(u_) do { if constexpr (ROWSSQ && !SSQ_INLOOP) { const float* sp_ = g.ssq + ((size_t)(u_).pm * BM + wr * 64 + fr) * 4 + fq; \
        _Pragma("unroll") for (int a = 0; a < 2; ++a) _Pragma("unroll") for (int m = 0; m < 4; ++m) ssq[a][m] = sp_[(a * HALF + m * 16) * 4]; } } while (0)
    PG8_SSQ_LOAD(cur);
    S.a_ready(cur);
    if constexpr (SP2) {
        PG8_STAGE(PG8_SB(0, 0), cB, voffB); PG8_STAGE(PG8_SB(0, 1), cB + hstep, voffB); PG8_STAGE(PG8_SA(0, 0), cA, voffA); PG8_STAGE(PG8_SA(0, 1), cA + hstep, voffA);
        if (wr == 1) PG8_BAR;
        PG8_WAIT_V(2); PG8_BAR;
        PG8_STAGE(PG8_SB(1, 0), cB + kstep, voffB); PG8_STAGE(PG8_SA(1, 0), cA + kstep, voffA); PG8_STAGE(PG8_SB(1, 1), cB + hstep + kstep, voffB);
        PG8_WAIT_V(6); PG8_BAR;
    } else {
        PG8_STAGE(PG8_SB(0, 0), cB, voffB); PG8_STAGE(PG8_SA(0, 0), cA, voffA); PG8_STAGE(PG8_SB(0, 1), cB + hstep, voffB); PG8_STAGE(PG8_SA(0, 1), cA + hstep, voffA);
        if (wr == 1) PG8_BAR;
        PG8_WAIT_V(4); PG8_BAR;
        PG8_STAGE(PG8_SB(1, 0), cB + kstep, voffB); PG8_STAGE(PG8_SA(1, 0), cA + kstep, voffA); PG8_STAGE(PG8_SB(1, 1), cB + hstep + kstep, voffB);
        PG8_WAIT_V(6); PG8_BAR;
    }
    for (;;) {
        const bool has_next = S.next(ui + 1, nxt);
        const char* nA = has_next ? (const char*)g.A + (size_t)nxt.pm * tstep : cA; const char* nB = has_next ? (const char*)g.Bt + (size_t)nxt.pn * tstep : cB;
        for (int t = 0; t < nt; t += 2) {
            const bool last = (t == nt - 2);
            const char* a1 = cA + (size_t)(t + 1) * kstep;
            const char* a2 = last ? nA : cA + (size_t)(t + 2) * kstep; const char* b2 = last ? nB : cB + (size_t)(t + 2) * kstep;
            const char* a3 = a2 + kstep; const char* b3 = b2 + kstep;
            if (last && has_next) S.a_ready(nxt);
            if constexpr (SP2) {
            PG8_LDB(B0, 0, 0); PG8_LDB(B1, 0, 1); PG8_SCHED; PG8_LDA(At, 0, 0); PG8_STAGE(PG8_SA(1, 1), a1 + hstep, voffA);
            PG8_WAIT_V(8); PG8_WAIT_L(0); PG8_BAR; PG8_MMA(0, 0, At, B0); PG8_SSQ(0, At); PG8_MMA(0, 1, At, B1); PG8_BAR; PG8_SCHED;
            PG8_LDA(At, 0, 1); PG8_STAGE(PG8_SB(0, 0), b2, voffB); PG8_STAGE(PG8_SB(0, 1), b2 + hstep, voffB); PG8_STAGE(PG8_SA(0, 0), a2, voffA);
            PG8_WAIT_V(8); PG8_WAIT_L(0); PG8_BAR; PG8_MMA(1, 0, At, B0); PG8_SSQ(1, At); PG8_MMA(1, 1, At, B1); PG8_BAR; PG8_SCHED;
            PG8_LDB(B0, 1, 0); PG8_LDB(B1, 1, 1); PG8_SCHED; PG8_LDA(At, 1, 0); PG8_STAGE(PG8_SA(0, 1), a2 + hstep, voffA);
            PG8_WAIT_V(8); PG8_WAIT_L(0); PG8_BAR; PG8_MMA(0, 0, At, B0); PG8_SSQ(0, At); PG8_MMA(0, 1, At, B1); PG8_BAR; PG8_SCHED;
            PG8_LDA(At, 1, 1); PG8_STAGE(PG8_SB(1, 0), b3, voffB); PG8_STAGE(PG8_SB(1, 1), b3 + hstep, voffB); PG8_STAGE(PG8_SA(1, 0), a3, voffA);
            PG8_WAIT_V(8); PG8_WAIT_L(0); PG8_BAR; PG8_MMA(1, 0, At, B0); PG8_SSQ(1, At); PG8_MMA(1, 1, At, B1); PG8_BAR; PG8_SCHED;
            } else {
            PG8_LDB(B0, 0, 0); PG8_SCHED; PG8_LDA(At, 0, 0); PG8_STAGE(PG8_SA(1, 1), a1 + hstep, voffA);
            PG8_WAIT_L(8); PG8_BAR; PG8_WAIT_L(0); PG8_MMA(0, 0, At, B0); PG8_BAR; PG8_SCHED;
            PG8_LDB(B1, 0, 1); PG8_STAGE(PG8_SB(0, 0), b2, voffB);
            PG8_BAR; PG8_WAIT_L(0); PG8_MMA(0, 1, At, B1); PG8_BAR;
            PG8_LDA(At, 0, 1); PG8_STAGE(PG8_SA(0, 0), a2, voffA);
            PG8_BAR; PG8_WAIT_L(0); PG8_MMA(1, 0, At, B0); PG8_BAR; PG8_SCHED;
            PG8_STAGE(PG8_SB(0, 1), b2 + hstep, voffB);
            PG8_WAIT_V(6); PG8_BAR; PG8_MMA(1, 1, At, B1); PG8_BAR;
            PG8_LDB(B0, 1, 0); PG8_SCHED; PG8_LDA(At, 1, 0); PG8_STAGE(PG8_SA(0, 1), a2 + hstep, voffA);
            PG8_WAIT_L(8); PG8_BAR; PG8_WAIT_L(0); PG8_MMA(0, 0, At, B0); PG8_BAR; PG8_SCHED;
            PG8_LDB(B1, 1, 1); PG8_STAGE(PG8_SB(1, 0), b3, voffB);
            PG8_BAR; PG8_WAIT_L(0); PG8_MMA(0, 1, At, B1); PG8_BAR;
            PG8_LDA(At, 1, 1); PG8_STAGE(PG8_SA(1, 0), a3, voffA);
            PG8_BAR; PG8_WAIT_L(0); PG8_MMA(1, 0, At, B0); PG8_BAR; PG8_SCHED;
            PG8_STAGE(PG8_SB(1, 1), b3 + hstep, voffB);
            PG8_WAIT_V(6); PG8_BAR; PG8_MMA(1, 1, At, B1); PG8_BAR;
            }
        }
        if constexpr (ALIGN_EPI) { if (wr == 0) PG8_BAR; }
        float rs[2][4];
#pragma unroll
        for (int a = 0; a < 2; ++a)
#pragma unroll
            for (int m = 0; m < 4; ++m) { float q_ = ssq[a][m]; if constexpr (ROWSSQ) { q_ = sum_x16(q_); q_ = sum_x32(q_); q_ = __builtin_amdgcn_rsqf(q_ * (1.0f / (float)K) + 1e-6f); } rs[a][m] = q_; ssq[a][m] = 0.f; }
        E(acc, cur, wr, wc, fr, fq, rs); S.done(cur);
        if (!has_next) break;
        PG8_SSQ_LOAD(nxt);
        { typedef unsigned long long u64x2_ __attribute__((ext_vector_type(2)));
          unsigned long long z64 = 0ull; asm volatile("" : "+v"(z64));
#pragma unroll
        for (int a = 0; a < 2; ++a)
#pragma unroll
            for (int b = 0; b < 2; ++b)
#pragma unroll
                for (int m = 0; m < 4; ++m)
#pragma unroll
                    for (int n = 0; n < 2; ++n) acc[a][b][m][n] = __builtin_bit_cast(f32x4, (u64x2_){z64, z64}); }
        cur = nxt; cA = nA; cB = nB; ++ui;
        if constexpr (ALIGN_EPI) { if (wr == 1) PG8_BAR; }
    }
    PG8_WAIT_V(0);
    if constexpr (!ALIGN_EPI) { if (wr == 0) PG8_BAR; }
    PG8_BAR;
#undef PG8_SA
#undef PG8_SB
#undef PG8_STAGE
#undef PG8_LDA
#undef PG8_LDB
#undef PG8_MMA
#undef PG8_SSQ
#undef PG8_SSQ_LOAD
#undef PG8_WAIT_V
#undef PG8_WAIT_L
#undef PG8_BAR
#undef PG8_SCHED
}
}

typedef unsigned short bf16;
typedef float f32x4 __attribute__((ext_vector_type(4)));
typedef unsigned v4u __attribute__((ext_vector_type(4)));
typedef unsigned v2u __attribute__((ext_vector_type(2)));
constexpr int NB_ = 8, SEQ = 4096, D = 1024, M = NB_ * SEQ;
constexpr int ML_H = 8, ML_DV = 128, ML_DQK = 64, ML_L = 64, ML_NC = SEQ / ML_L, ML_IN = 3088, ML_INP = 3072;
constexpr int MB_H = 16, MB_KVH = 4, MB_HD = 64, MB_BLK = 256, MB_NB = SEQ / MB_BLK;
constexpr int FF = 2816, PLE = 256;
constexpr float EPS = 1e-6f, GATE_CAP = 15.0f;
constexpr int NWAVES = 8, NTHREADS = 512;

constexpr size_t MiB = 1u << 20;
constexpr size_t WS_CTL = 0, CTL_ZERO_BYTES = 64 * 1024;
constexpr size_t WS_ROPE = 1 * MiB;
constexpr size_t WS_KMP = 1 * MiB + 512 * 1024;
constexpr size_t WS_SSQ0 = 2 * MiB, WS_SSQ1 = 3 * MiB;
constexpr size_t WS_GATES = 6 * MiB;
constexpr size_t WS_MLOC = 8 * MiB, WS_GLAST = WS_MLOC + 16384, WS_MPREV = WS_GLAST + 16384;
constexpr size_t WS_NLOC = 9 * MiB;
constexpr size_t WS_WIN = 10 * MiB, WS_WOUT = 17 * MiB, WS_WQKV1 = 19 * MiB, WS_WO1 = 22 * MiB, WS_WGU = 24 * MiB  , WS_WDN = 46 * MiB  , WS_WPG = 58 * MiB  , WS_WPU = 62 * MiB  ;
constexpr size_t WS_HB = 64 * MiB, WS_HB2 = 448 * MiB;
constexpr size_t WS_PB = 128 * MiB;
constexpr size_t WS_UP = 160 * MiB;
constexpr size_t WS_OG = 160 * MiB;
constexpr size_t WS_Q0 = 224 * MiB, WS_K0 = 256 * MiB, WS_V0 = 288 * MiB  , WS_CLOC = 384 * MiB  ;
constexpr size_t WS_ACT = 224 * MiB;
constexpr size_t WS_Q1 = 224 * MiB, WS_K1 = 288 * MiB, WS_V1 = 304 * MiB, WS_AO = 320 * MiB;
constexpr size_t WS_END = 512 * MiB;

constexpr int LDS_BYTES = 147456;
constexpr int RING_BYTES = 131072;
constexpr int LDSCTL_OFF = RING_BYTES;

__device__ __forceinline__ unsigned f2bf(float f) { unsigned u = __builtin_bit_cast(unsigned, f); return (u + 0x7fffu + ((u >> 16) & 1u)) >> 16; }
__device__ __forceinline__ unsigned pk2(float lo, float hi) { return pg8::cvt_pk_bf16(lo, hi); }
__device__ __forceinline__ float bf_lo(unsigned u) { return __builtin_bit_cast(float, u << 16); }
__device__ __forceinline__ float bf_hi(unsigned u) { return __builtin_bit_cast(float, u & 0xffff0000u); }
__device__ __forceinline__ float sigmoidf_(float x) { return __builtin_amdgcn_rcpf(1.0f + __builtin_amdgcn_exp2f(-1.4426950408889634f * x)); }
__device__ __forceinline__ float shx(float v, int mask, int lane) { return __builtin_bit_cast(float, __builtin_amdgcn_ds_bpermute((lane ^ mask) << 2, __builtin_bit_cast(int, v))); }
__device__ __forceinline__ int shxi(int v, int mask, int lane) { return __builtin_amdgcn_ds_bpermute((lane ^ mask) << 2, v); }
__device__ __forceinline__ float shup(float v, int o, int lane) { return __builtin_bit_cast(float, __builtin_amdgcn_ds_bpermute((lane >= o ? lane - o : lane) << 2, __builtin_bit_cast(int, v))); }
__device__ __forceinline__ float shidx(float v, int src) { return __builtin_bit_cast(float, __builtin_amdgcn_ds_bpermute(src << 2, __builtin_bit_cast(int, v))); }
__device__ __forceinline__ float wave_sum(float v, int lane) {
#pragma unroll
    for (int o = 1; o < 64; o <<= 1) v += shx(v, o, lane);
    return v;
}
__device__ __forceinline__ float wave_max(float v, int lane) {
#pragma unroll
    for (int o = 1; o < 64; o <<= 1) v = fmaxf(v, shx(v, o, lane));
    return v;
}

using pg8::Unit; using pg8::HALF; using pg8::BM;
#define ROWS8 _Pragma("unroll") for (int ai = 0; ai < 2; ++ai) _Pragma("unroll") for (int m = 0; m < 4; ++m)

#define EPI_ARGS const f32x4 (&acc)[2][2][4][2], const Unit& u, int wr, int wc, int fr, int fq, const float (&rs)[2][4]
#ifndef EPI_WT
#define EPI_WT 0
#endif
__device__ __forceinline__ void st16(void* base, size_t byte_off, v4u v) {
    if (EPI_WT) { const __amdgpu_buffer_rsrc_t r = __builtin_amdgcn_make_buffer_rsrc(base, (short)0, 0x7fffffff, 0x00020000); __builtin_amdgcn_raw_buffer_store_b128(v, r, (unsigned)byte_off, 0, 16); }
    else *(v4u*)((char*)base + byte_off) = v;
}
__device__ __forceinline__ v4u pack8(const f32x4 a, const f32x4 b) { v4u w; w.x = pk2(a[0], a[1]); w.y = pk2(a[2], a[3]); w.z = pk2(b[0], b[1]); w.w = pk2(b[2], b[3]); return w; }
__device__ __forceinline__ void unpack8(const v4u w, f32x4& a, f32x4& b) { a = (f32x4){bf_lo(w.x), bf_hi(w.x), bf_lo(w.y), bf_hi(w.y)}; b = (f32x4){bf_lo(w.z), bf_hi(w.z), bf_lo(w.w), bf_hi(w.w)}; }
struct EpiMl {
    static constexpr bool PERM = true, AFTER_DRAIN = false;
    unsigned char* ws;
    __device__ __forceinline__ void operator()(EPI_ARGS) const {
        const int row0 = u.pm * BM + wr * 64 + fr;
        const int t = u.pn < 2 ? 0 : (u.pn < 4 ? 1 : (u.pn < 8 ? 2 : 3));
        const size_t boff = t == 0 ? WS_Q0 : (t == 1 ? WS_K0 : (t == 2 ? WS_V0 : WS_OG));
        const int ld = t < 2 ? 512 : 1024, colt = (u.pn - (t == 0 ? 0 : (t == 1 ? 2 : (t == 2 ? 4 : 8)))) * 256; const float sc = t == 0 ? 0.125f : 1.f;
        bf16* base = (bf16*)(ws + boff);
        const int col0 = colt + wc * 32 + 8 * fq;
        ROWS8 { const unsigned ro = (unsigned)((row0 + ai * HALF + m * 16) * ld + col0) * 2u; const float r = rs[ai][m] * sc;
#pragma unroll
            for (int bj = 0; bj < 2; ++bj) st16(base, ro + bj * HALF * 2, pack8(acc[ai][bj][m][0] * r, acc[ai][bj][m][1] * r)); }
    }
};
struct EpiQkv1 {
    static constexpr bool PERM = true, AFTER_DRAIN = false;
    unsigned char* ws; LAS unsigned char* xl; const float* qg; const float* kg;
    __device__ __forceinline__ void operator()(const f32x4 (&acc)[2][2][4][2], const Unit& u, int wr, int wc, int fr_, int fq_, const float (&rs)[2][4]) const {
        int fr = fr_, fq = fq_; asm volatile("" : "+v"(fr), "+v"(fq));
        const int lane = fr + 16 * fq, rowl0 = wr * 64 + fr, row0 = u.pm * BM + rowl0;
        if (u.pn == 5) {
            bf16* base = (bf16*)(ws + WS_V1); const int col0 = wc * 32 + 8 * fq;
            ROWS8 { const float r = rs[ai][m]; const unsigned ro = (unsigned)((row0 + ai * HALF + m * 16) * 256 + col0) * 2u;
#pragma unroll
                for (int bj = 0; bj < 2; ++bj) st16(base, ro + bj * HALF * 2, pack8(acc[ai][bj][m][0] * r, acc[ai][bj][m][1] * r)); }
            return;
        }
        const bool isq = u.pn < 4;
        LAS float* ex = (LAS float*)xl;
        ROWS8 { const float r = rs[ai][m];
#pragma unroll
            for (int bj = 0; bj < 2; ++bj) { const f32x4 a = acc[ai][bj][m][0] * r, b = acc[ai][bj][m][1] * r; float q = ((a[0] * a[0] + a[1] * a[1]) + (a[2] * a[2] + a[3] * a[3])) + ((b[0] * b[0] + b[1] * b[1]) + (b[2] * b[2] + b[3] * b[3]));
                q = pg8::sum_x16(q); q = pg8::sum_x32(q);
                if (fq == 0) ex[(ai * HALF + rowl0 + m * 16) * 8 + bj * 4 + wc] = q; } }
        asm volatile("s_waitcnt lgkmcnt(0)\n\ts_barrier" ::: "memory");
        float gn[8];
        { const float* gp = (isq ? qg : kg) + 32 * (wc & 1) + 8 * fq; const float sc = isq ? 0.125f * 1.4426950408889634f : 1.0f;
#pragma unroll
          for (int e = 0; e < 8; ++e) gn[e] = gp[e] * sc; }
        const bool rot = (wc & 1) == 0;
        const float* rc = (const float*)(ws + WS_ROPE); const float* rsn = rc + SEQ * 8;
        bf16* base = (bf16*)(ws + (isq ? WS_Q1 : WS_K1)); const int ld = isq ? 1024 : 256, col0 = (isq ? u.pn * 256 : 0) + wc * 32 + 8 * fq;
        float ks[2][8];
#pragma unroll
        for (int bj = 0; bj < 2; ++bj)
#pragma unroll
            for (int e = 0; e < 8; ++e) ks[bj][e] = 0.f;
        ROWS8 { const int rowl = ai * HALF + rowl0 + m * 16, row = u.pm * BM + rowl; const float r = rs[ai][m];
            float cs[8], sn[8];
            if (rot) { const int pos = row & (SEQ - 1); const f32x4 c0 = *(const f32x4*)(rc + pos * 8), c1 = *(const f32x4*)(rc + pos * 8 + 4), s0 = *(const f32x4*)(rsn + pos * 8), s1 = *(const f32x4*)(rsn + pos * 8 + 4);
#pragma unroll
                for (int e = 0; e < 4; ++e) { cs[e] = c0[e]; cs[4 + e] = c1[e]; sn[e] = s0[e]; sn[4 + e] = s1[e]; } }
#pragma unroll
            for (int bj = 0; bj < 2; ++bj) {
                const float q = ex[rowl * 8 + bj * 4 + (wc & 2)] + ex[rowl * 8 + bj * 4 + (wc | 1)]; const float rn = r * __builtin_amdgcn_rsqf(q * (1.0f / 64.0f) + EPS);
                float v[8];
#pragma unroll
                for (int e = 0; e < 8; ++e) v[e] = acc[ai][bj][m][e >> 2][e & 3] * rn * gn[e];
                if (rot) {
#pragma unroll
                    for (int e = 0; e < 8; ++e) { const float p = pg8::shx16(v[e], lane); if (fq == 0) v[e] = v[e] * cs[e] - p * sn[e]; else if (fq == 1) v[e] = v[e] * cs[e] + p * sn[e]; } }
                st16(base, (unsigned)(row * ld + col0 + bj * HALF) * 2u, pack8((f32x4){v[0], v[1], v[2], v[3]}, (f32x4){v[4], v[5], v[6], v[7]}));
                if (!isq) {
#pragma unroll
                    for (int e = 0; e < 8; ++e) ks[bj][e] += v[e]; } }
            asm volatile("" ::: "memory"); }
        if (!isq) {
            LAS float* kx = ex + 2048;
#pragma unroll
            for (int bj = 0; bj < 2; ++bj)
#pragma unroll
                for (int e = 0; e < 8; ++e) { float t = ks[bj][e]; t += shx(t, 1, lane); t += shx(t, 2, lane); t += shx(t, 4, lane); t += shx(t, 8, lane); ks[bj][e] = t; }
            if (fr == 0) {
#pragma unroll
                for (int bj = 0; bj < 2; ++bj) { LAS float* kp = kx + wr * 256 + bj * HALF + wc * 32 + 8 * fq; *(LAS f32x4*)kp = (f32x4){ks[bj][0], ks[bj][1], ks[bj][2], ks[bj][3]}; *(LAS f32x4*)(kp + 4) = (f32x4){ks[bj][4], ks[bj][5], ks[bj][6], ks[bj][7]}; } }
            asm volatile("s_waitcnt lgkmcnt(0)\n\ts_barrier" ::: "memory");
            const int t = (wr * 4 + wc) * 64 + lane;
            if (t < 256) ((float*)(ws + WS_KMP))[(size_t)u.pm * 256 + t] = kx[t] + kx[256 + t];
        }
    }
};
struct EpiPlain {
    static constexpr bool PERM = true, AFTER_DRAIN = false;
    bf16* O; int ld;
    __device__ __forceinline__ void operator()(EPI_ARGS) const {
        const int row0 = u.pm * BM + wr * 64 + fr, col0 = u.pn * BM + wc * 32 + 8 * fq;
        ROWS8 { const unsigned ro = (unsigned)((row0 + ai * HALF + m * 16) * ld + col0) * 2u;
#pragma unroll
            for (int bj = 0; bj < 2; ++bj) st16(O, ro + bj * HALF * 2, pack8(acc[ai][bj][m][0], acc[ai][bj][m][1])); }
    }
};
struct EpiSwiglu {
    static constexpr bool PERM = true, AFTER_DRAIN = false;
    bf16* act;
    __device__ __forceinline__ void operator()(EPI_ARGS) const {
        const int row0 = u.pm * BM + wr * 64 + fr, col0 = u.pn * HALF + wc * 32 + 8 * fq;
        ROWS8 { const float r = rs[ai][m], rn = r * -1.4426950408889634f, r2 = r * r; const unsigned ro = (unsigned)((row0 + ai * HALF + m * 16) * FF + col0) * 2u; f32x4 o[2];
#pragma unroll
            for (int n = 0; n < 2; ++n)
#pragma unroll
                for (int e = 0; e < 4; ++e) { const float g_ = acc[ai][0][m][n][e]; o[n][e] = (g_ * acc[ai][1][m][n][e]) * (r2 * __builtin_amdgcn_rcpf(1.0f + __builtin_amdgcn_exp2f(g_ * rn))); }
            st16(act, ro, pack8(o[0], o[1])); }
    }
};
__device__ __forceinline__ void publish_rowssq(float (&q)[2][4], LAS float* xq, float* ssq, const Unit& u, int wr, int wc, int fr, int fq) {
    const int lane = fr + 16 * fq;
    ROWS8 { float t = q[ai][m]; t = pg8::sum_x16(t); t = pg8::sum_x32(t); if (fq == 0) xq[wc * 256 + ai * HALF + wr * 64 + m * 16 + fr] = t; }
    asm volatile("s_waitcnt lgkmcnt(0)\n\ts_barrier" ::: "memory");
    const int t = (wr * 4 + wc) * 64 + lane;
    if (t < 256) ssq[((size_t)u.pm * BM + t) * 4 + u.pn] = (xq[t] + xq[256 + t]) + (xq[512 + t] + xq[768 + t]);
}
__device__ __forceinline__ float sq8(const v4u w, float q) { q = pg8::dot2sq(w.x, q); q = pg8::dot2sq(w.y, q); q = pg8::dot2sq(w.z, q); return pg8::dot2sq(w.w, q); }
#define ER_OFF(ai, m, bj) ((unsigned)(((ai) * HALF + (m) * 16) * D + (bj) * HALF))
struct EpiRes {
    static constexpr bool PERM = true, AFTER_DRAIN = false;
    bf16* hb; float* ssq; LAS float* xq;
    __device__ __forceinline__ void operator()(EPI_ARGS) const {
        const int row0 = u.pm * BM + wr * 64 + fr, col0 = u.pn * BM + wc * 32 + 8 * fq;
        const unsigned o0 = (unsigned)(row0 * D + col0);
        v4u hv[2][4][2];
#pragma unroll
        for (int ai = 0; ai < 2; ++ai)
#pragma unroll
            for (int m = 0; m < 4; ++m)
#pragma unroll
                for (int bj = 0; bj < 2; ++bj) hv[ai][m][bj] = *(const v4u*)((const char*)hb + (size_t)((o0 + ER_OFF(ai, m, bj)) * 2u));
        asm volatile("" ::: "memory");
        float q[2][4];
#pragma unroll
        for (int ai = 0; ai < 2; ++ai)
#pragma unroll
            for (int m = 0; m < 4; ++m) q[ai][m] = 0.f;
#pragma unroll
        for (int ai = 0; ai < 2; ++ai)
#pragma unroll
            for (int m = 0; m < 4; ++m)
#pragma unroll
                for (int bj = 0; bj < 2; ++bj) { f32x4 a, b; unpack8(hv[ai][m][bj], a, b); const v4u w = pack8(a + acc[ai][bj][m][0], b + acc[ai][bj][m][1]); q[ai][m] = sq8(w, q[ai][m]); st16(hb, (o0 + ER_OFF(ai, m, bj)) * 2, w); }
        publish_rowssq(q, xq, ssq, u, wr, wc, fr, fq);
    }
};
template <bool LAST> struct EpiPle {
    static constexpr bool PERM = true, AFTER_DRAIN = false;
    const bf16* hin; bf16* hout; float* out; const bf16* up; float* ssq; LAS float* xq;
    __device__ __forceinline__ void operator()(const f32x4 (&acc)[2][2][4][2], const Unit& u, int wr, int wc, int fr_, int fq_, const float (&rs)[2][4]) const {
        int fr = fr_, fq = fq_; asm volatile("" : "+v"(fr), "+v"(fq));
        const int row0 = u.pm * BM + wr * 64 + fr, col0 = u.pn * BM + wc * 32 + 8 * fq;
        const unsigned o0 = (unsigned)(row0 * D + col0);
        v4u hv[4][2], uv[4][2];
        float q[2][4];
#pragma unroll
        for (int ai = 0; ai < 2; ++ai)
#pragma unroll
            for (int m = 0; m < 4; ++m) q[ai][m] = 0.f;
#pragma unroll
        for (int ai = 0; ai < 2; ++ai) {
#pragma unroll
            for (int m = 0; m < 4; ++m)
#pragma unroll
                for (int bj = 0; bj < 2; ++bj) { const unsigned ob_ = (o0 + ER_OFF(ai, m, bj)) * 2u; hv[m][bj] = *(const v4u*)((const char*)hin + (size_t)ob_); uv[m][bj] = *(const v4u*)((const char*)up + (size_t)ob_); }
            asm volatile("" ::: "memory");
#pragma unroll
            for (int m = 0; m < 4; ++m) { const float rn = rs[ai][m] * -1.4426950408889634f;
#pragma unroll
                for (int bj = 0; bj < 2; ++bj) { f32x4 a, b, x0_, x1_; unpack8(hv[m][bj], a, b); unpack8(uv[m][bj], x0_, x1_); const f32x4 g0 = acc[ai][bj][m][0] * rn, g1 = acc[ai][bj][m][1] * rn;
#pragma unroll
                    for (int e = 0; e < 4; ++e) { a[e] += x0_[e] * __builtin_amdgcn_rcpf(1.0f + __builtin_amdgcn_exp2f(g0[e])); b[e] += x1_[e] * __builtin_amdgcn_rcpf(1.0f + __builtin_amdgcn_exp2f(g1[e])); }
                    const unsigned off = o0 + ER_OFF(ai, m, bj);
                    if (LAST) { st16(out, off * 4, __builtin_bit_cast(v4u, a)); st16(out, off * 4 + 16, __builtin_bit_cast(v4u, b)); } else { const v4u w = pack8(a, b); q[ai][m] = sq8(w, q[ai][m]); st16(hout, off * 2, w); } } }
            asm volatile("" ::: "memory");
        }
        if (!LAST) publish_rowssq(q, xq, ssq, u, wr, wc, fr, fq);
    }
};
#undef ER_OFF

typedef GAS unsigned gu32;
#define RLX_AGENT __ATOMIC_RELAXED, __HIP_MEMORY_SCOPE_AGENT
#define XB_TMO      128
#define XB_XCNT(j)  (256  + 64 * (j))
#define XB_XSUB(j)  (1280 + 64 * (j))
#define XB_XGEN(j)  (2304 + 64 * (j))
#define XB_FLAG(j)  (3328 + (j))
#define XCD_BAR_WORDS 3456
#define XB_SPIN_CAP (1u << 22)
__device__ __forceinline__ unsigned xb_ld(unsigned* p)              { return __hip_atomic_load(p, __ATOMIC_RELAXED, __HIP_MEMORY_SCOPE_AGENT); }
__device__ __forceinline__ unsigned xb_add(unsigned* p, unsigned v) { return __hip_atomic_fetch_add(p, v, __ATOMIC_RELAXED, __HIP_MEMORY_SCOPE_AGENT); }
__device__ __forceinline__ unsigned xb_xcc_id() { return (unsigned)__builtin_amdgcn_s_getreg((3 << 11) | 20) & 0xFu; }
#define XB_SPIN(cond, bar) do { unsigned _sp = 0; while (cond) { __builtin_amdgcn_s_sleep(1); \
    if ((++_sp & 255u) == 0u) { if (xb_ld(&(bar)[XB_TMO])) break; if (_sp > XB_SPIN_CAP) { atomicAdd(&(bar)[XB_TMO], 1u); break; } } } } while (0)
struct XcdBarrier { unsigned* bar; unsigned x; volatile LAS unsigned* st; };
__device__ __forceinline__ XcdBarrier xcd_barrier_post(unsigned* bar, volatile LAS unsigned* st) {
    XcdBarrier b; b.bar = bar; b.x = xb_xcc_id(); b.st = st;
    if (threadIdx.x == 0) st[2] = xb_add(&bar[XB_XCNT(b.x)], 1u);
    return b;
}
__device__ __forceinline__ void xcd_barrier_complete(unsigned* bar, unsigned x, unsigned& nloc, unsigned& amask, unsigned& even) {
    const unsigned G = gridDim.x * gridDim.y * gridDim.z;
    unsigned sum, msk, mine, sp = 0u;
    for (;;) {
        sum = 0u; msk = 0u; mine = 0u; even = 1u;
#pragma unroll
        for (unsigned j = 0; j < 16; ++j) { const unsigned c = xb_ld(&bar[XB_XCNT(j)]); sum += c; msk |= (c > 0u) ? (1u << j) : 0u; mine = (j == x) ? c : mine; even &= (c == (j < 8u ? 32u : 0u)) ? 1u : 0u; }
        if (sum == G) break;
        __builtin_amdgcn_s_sleep(1);
        if ((++sp & 255u) == 0u) { if (xb_ld(&bar[XB_TMO])) break; if (sp > XB_SPIN_CAP) { atomicAdd(&bar[XB_TMO], 1u); break; } }
    }
    nloc = mine > 0u ? mine : 1u; amask = msk ? msk : 1u; even = (even != 0u && G == 256u && sum == G) ? 1u : 0u;
}
template <int MODE>
__device__ __forceinline__ void p0_transpose_item(const float* W, int K, int N, int ldw, const float* gain, bf16* WT, int row_off, LAS float* scr, int item, int lane) {
    const int nblk = (N + 31) / 32, kb = item / nblk, nb = item % nblk, k0 = 64 * kb, n0 = 32 * nb;
    const int ncol = n0 + (lane & 31); const bool nok = ncol < N;
    float tv[32];
#pragma unroll
    for (int i = 0; i < 32; ++i) { const int kk = 2 * i + (lane >> 5); tv[i] = nok ? W[(size_t)(k0 + kk) * ldw + ncol] : 0.f; }
#pragma unroll
    for (int i = 0; i < 32; ++i) { const int kk = 2 * i + (lane >> 5); float v = tv[i]; if (gain) v *= gain[k0 + kk]; scr[kk * 33 + (lane & 31)] = v; }
    asm volatile("s_waitcnt lgkmcnt(0)" ::: "memory");
    const int c = lane & 7;
    int drow0;
    if (MODE == 0) drow0 = row_off + n0; else { const int isu = n0 >= FF ? 1 : 0, j0 = n0 - isu * FF; drow0 = 256 * (j0 / 128) + 128 * isu + (j0 % 128); }
#pragma unroll
    for (int j = 0; j < 4; ++j) { const int n = (lane >> 3) + 8 * j; const LAS float* s = scr + (8 * c) * 33 + n;
        v4u o; o.x = pk2(s[0 * 33], s[1 * 33]); o.y = pk2(s[2 * 33], s[3 * 33]); o.z = pk2(s[4 * 33], s[5 * 33]); o.w = pk2(s[6 * 33], s[7 * 33]);
        if (n0 + n < N) *(v4u*)(WT + (size_t)(drow0 + n) * K + k0 + 8 * c) = o; }
    asm volatile("s_waitcnt lgkmcnt(0)" ::: "memory");
}

struct Args { const float* in[19]; float* out; unsigned char* ws; int ph_lo, ph_hi; };
typedef const Args __attribute__((address_space(4))) CArgs;

constexpr int WI_IN = 16 * 96, WI_SQ = 16 * 32, WI_KV = 16 * 16, WI_GU = 16 * 176, WI_DN = 44 * 32, WI_PU = 4 * 32;
constexpr int WI_N0 = WI_IN + WI_SQ + WI_GU + WI_DN + WI_SQ + WI_PU, WI_N1 = WI_SQ + WI_KV + WI_SQ + WI_GU + WI_DN + WI_SQ + WI_PU;
__device__ __forceinline__ void weight_item(CArgs* A, unsigned char* ws, LAS float* scr, const int layer, int r, const int lane) {
    if (layer == 0) {
        if (r < WI_IN) { p0_transpose_item<0>(A->in[3], D, 3072, ML_IN, A->in[2], (bf16*)(ws + WS_WIN), 0, scr, r, lane); return; } r -= WI_IN;
        if (r < WI_SQ) { p0_transpose_item<0>(A->in[6], D, D, D, nullptr, (bf16*)(ws + WS_WOUT), 0, scr, r, lane); return; } r -= WI_SQ;
    } else {
        if (r < WI_SQ) { p0_transpose_item<0>(A->in[10], D, D, D, A->in[2] + D, (bf16*)(ws + WS_WQKV1), 0, scr, r, lane); return; } r -= WI_SQ;
        if (r < WI_KV) { p0_transpose_item<0>(A->in[8], D, 512, 512, A->in[7], (bf16*)(ws + WS_WQKV1), D, scr, r, lane); return; } r -= WI_KV;
        if (r < WI_SQ) { p0_transpose_item<0>(A->in[12], D, D, D, nullptr, (bf16*)(ws + WS_WO1), 0, scr, r, lane); return; } r -= WI_SQ;
    }
    const int l = layer;
    if (r < WI_GU) { p0_transpose_item<1>(A->in[14] + (size_t)l * D * 2 * FF, D, 2 * FF, 2 * FF, A->in[13] + l * D, (bf16*)(ws + WS_WGU + l * 11 * MiB), 0, scr, r, lane); return; } r -= WI_GU;
    if (r < WI_DN) { p0_transpose_item<0>(A->in[15] + (size_t)l * FF * D, FF, D, D, nullptr, (bf16*)(ws + WS_WDN + l * 6 * MiB), 0, scr, r, lane); return; } r -= WI_DN;
    if (r < WI_SQ) { p0_transpose_item<0>(A->in[17] + (size_t)l * D * D, D, D, D, A->in[16] + l * D, (bf16*)(ws + WS_WPG + l * 2 * MiB), 0, scr, r, lane); return; } r -= WI_SQ;
    p0_transpose_item<0>(A->in[18] + (size_t)l * PLE * D, PLE, D, D, nullptr, (bf16*)(ws + WS_WPU + l * (MiB / 2)), 0, scr, r, lane);
}
__device__ __forceinline__ void p_chunk(CArgs* A, unsigned char* ws, const size_t g0, const int lane) {
    const float* p = A->in[1]; bf16* pb = (bf16*)(ws + WS_PB); f32x4 a[4], b[4];
#pragma unroll
    for (int q = 0; q < 4; ++q) { const size_t ii = g0 + q * 64 + lane; a[q] = *(const f32x4*)(p + ii * 8); b[q] = *(const f32x4*)(p + ii * 8 + 4); }
#pragma unroll
    for (int q = 0; q < 4; ++q) { const size_t ii = g0 + q * 64 + lane; v4u w; w.x = pk2(a[q][0], a[q][1]); w.y = pk2(a[q][2], a[q][3]); w.z = pk2(b[q][0], b[q][1]); w.w = pk2(b[q][2], b[q][3]); *(v4u*)(pb + ii * 8) = w; }
}
__device__ __forceinline__ void xcd_barrier(const XcdBarrier& b, CArgs* ap = nullptr, LAS unsigned char* lds = nullptr, const int job = -1, const int G = 0, const int bx = 0, const int wave_s = 0, const unsigned ones = 0u, const bool xlocal = false) {
    asm volatile("s_waitcnt vmcnt(0)" ::: "memory");
    __syncthreads();
    if (job >= 0 && wave_s >= 1) {
        unsigned o_ = ones; asm volatile("" : "+s"(o_)); const int lane = (int)__builtin_amdgcn_mbcnt_hi(o_, __builtin_amdgcn_mbcnt_lo(o_, 0u));
        const int slot = (job & 3) * (G * 7) + bx * 7 + (wave_s - 1);
        if (job < 4) { if (slot < WI_N1) weight_item(ap, ap->ws, (LAS float*)(lds + wave_s * 16384), 1, slot, lane); }
        else if (slot < 4096) p_chunk(ap, ap->ws, (size_t)M * PLE / 8 + (size_t)slot * 256, lane);
        asm volatile("s_waitcnt vmcnt(0) lgkmcnt(0)" ::: "memory");
    }
    if (threadIdx.x == 0) {
        unsigned* bar = b.bar;
        __builtin_amdgcn_s_waitcnt(0);
        unsigned nloc = b.st[0], amask = b.st[1];
        if (nloc == 0u) { unsigned even; xcd_barrier_complete(bar, b.x, nloc, amask, even); b.st[0] = nloc; b.st[1] = amask; b.st[3] = even; }
        if (xlocal) amask = 1u << b.x;
        const unsigned old = xb_add(&bar[XB_XSUB(b.x)], 1u);
        const unsigned target = old / nloc + 1u;
        if (old + 1u == target * nloc) {
            if (!xlocal) { __builtin_amdgcn_fence(__ATOMIC_RELEASE, "agent"); asm volatile("s_waitcnt vmcnt(0)" ::: "memory"); }
            __hip_atomic_store(&bar[XB_FLAG(b.x)], target, __ATOMIC_RELAXED, __HIP_MEMORY_SCOPE_AGENT);
        }
        __builtin_amdgcn_fence(__ATOMIC_ACQUIRE, "agent");
        unsigned sp = 0u;
        for (;;) {
            unsigned f[16];
#pragma unroll
            for (unsigned j = 0; j < 16; ++j) f[j] = xb_ld(&bar[XB_FLAG(j)]);
            unsigned mn = target;
#pragma unroll
            for (unsigned j = 0; j < 16; ++j) { const unsigned v = ((amask >> j) & 1u) ? f[j] : target; mn = v < mn ? v : mn; }
            if (mn >= target) break;
            __builtin_amdgcn_s_sleep(1);
            if ((++sp & 255u) == 0u) { if (xb_ld(&bar[XB_TMO])) break; if (sp > XB_SPIN_CAP) { atomicAdd(&bar[XB_TMO], 1u); break; } }
        }
        asm volatile("s_waitcnt vmcnt(0)" ::: "memory");
    }
    __syncthreads();
}

__device__ __forceinline__ void p0_prologue(CArgs* A, LAS unsigned char* lds, int G, int vcu, int wave, int lane) {
    unsigned char* ws = A->ws;
    LAS float* scr = (LAS float*)(lds + wave * 16384);
    const int gw = vcu * NWAVES + wave, NGW = G * NWAVES;
    {
        const int tid = wave * 64 + lane;
        LAS f32x4* T = (LAS f32x4*)lds;
        { const float* W = A->in[3]; const float* gn = A->in[2];
          for (int idx = tid; idx < 4096; idx += NTHREADS) { const int k = idx >> 2, nq = idx & 3, j = k >> 8, lk = (k & 255) >> 2, e = k & 3;
              T[((j * 4 + e) * 4 + nq) * 64 + lk] = *(const f32x4*)(W + (size_t)k * ML_IN + 3072 + 4 * nq) * gn[k]; } }
        __syncthreads();
        const float* x = A->in[0]; bf16* hb = (bf16*)(ws + WS_HB); float* gates = (float*)(ws + WS_GATES); float* ssq0 = (float*)(ws + WS_SSQ0);
        const float bg = A->in[4][lane & 15];
        f32x4 v[4][4];
        { const int m0 = gw * 4;
          if (m0 < M) {
#pragma unroll
            for (int r = 0; r < 4; ++r) { const f32x4* xr = (const f32x4*)(x + (size_t)(m0 + r) * D) + lane;
#pragma unroll
                for (int j = 0; j < 4; ++j) v[r][j] = xr[64 * j]; } } }
        for (int m0 = gw * 4; m0 < M; m0 += NGW * 4) {
            float rstd[4];
#pragma unroll
            for (int r = 0; r < 4; ++r) { float q = 0.f;
#pragma unroll
                for (int j = 0; j < 4; ++j) q += (v[r][j][0] * v[r][j][0] + v[r][j][1] * v[r][j][1]) + (v[r][j][2] * v[r][j][2] + v[r][j][3] * v[r][j][3]);
                const float qs = wave_sum(q, lane); rstd[r] = __builtin_amdgcn_rsqf(qs * (1.0f / D) + EPS);
                if (lane == 0) *(f32x4*)(ssq0 + (size_t)(m0 + r) * 4) = (f32x4){qs, 0.f, 0.f, 0.f};
                unsigned long long* o8 = (unsigned long long*)(hb + (size_t)(m0 + r) * D) + lane;
#pragma unroll
                for (int j = 0; j < 4; ++j) o8[64 * j] = (unsigned long long)pk2(v[r][j][0], v[r][j][1]) | ((unsigned long long)pk2(v[r][j][2], v[r][j][3]) << 32); }
            f32x4 vn[4][4];
#pragma unroll
            for (int r = 0; r < 4; ++r)
#pragma unroll
                for (int j = 0; j < 4; ++j) vn[r][j] = (f32x4){0.f, 0.f, 0.f, 0.f};
            { const int mn = m0 + NGW * 4;
              if (mn < M) {
#pragma unroll
                for (int r = 0; r < 4; ++r) { const f32x4* xr = (const f32x4*)(x + (size_t)(mn + r) * D) + lane;
#pragma unroll
                    for (int j = 0; j < 4; ++j) vn[r][j] = xr[64 * j]; } } }
            float o[64];
#pragma unroll
            for (int i = 0; i < 64; ++i) o[i] = 0.f;
#pragma unroll
            for (int j = 0; j < 4; ++j)
#pragma unroll
                for (int e = 0; e < 4; ++e)
#pragma unroll
                    for (int nq = 0; nq < 4; ++nq) { const f32x4 w = T[((j * 4 + e) * 4 + nq) * 64 + lane];
#pragma unroll
                        for (int r = 0; r < 4; ++r)
#pragma unroll
                            for (int i = 0; i < 4; ++i) o[r * 16 + nq * 4 + i] += v[r][j][e] * w[i];
                        if (nq == 3) asm volatile("" ::: "memory"); }
#define RED_STEP(OFF, N) _Pragma("unroll") for (int i = 0; i < (N) / 2; ++i) { const bool up = (lane & (OFF)) != 0; const float send = up ? o[i] : o[i + (N) / 2]; const float keep = up ? o[i + (N) / 2] : o[i]; o[i] = keep + shx(send, OFF, lane); }
            RED_STEP(32, 64) RED_STEP(16, 32) RED_STEP(8, 16) RED_STEP(4, 8) RED_STEP(2, 4) RED_STEP(1, 2)
#undef RED_STEP
            const int rr = lane >> 4; const float rsel = rr == 0 ? rstd[0] : (rr == 1 ? rstd[1] : (rr == 2 ? rstd[2] : rstd[3]));
            const float pre = o[0] * rsel + bg; const float t2 = __expf(pre * (2.0f / GATE_CAP)); const float cp = GATE_CAP * (t2 - 1.0f) * __builtin_amdgcn_rcpf(t2 + 1.0f);
            gates[(size_t)m0 * 16 + lane] = ((lane & 15) < 8) ? cp : -__logf(1.0f + __expf(-cp));
#pragma unroll
            for (int r = 0; r < 4; ++r)
#pragma unroll
                for (int j = 0; j < 4; ++j) v[r][j] = vn[r][j];
        }
        __syncthreads();
    }
    const bool all_here = !(SIDE_JOBS && MK_N_LAUNCHES == 1 && G == 256);
    for (int it = gw; it < WI_N0; it += NGW) weight_item(A, ws, scr, 0, it, lane);
    if (all_here) for (int it = gw; it < WI_N1; it += NGW) weight_item(A, ws, scr, 1, it, lane);
    { const size_t n8h = (size_t)M * PLE / 8 * (all_here ? 2 : 1);
      for (size_t g0 = (size_t)gw * 256; g0 < n8h; g0 += (size_t)NGW * 256) p_chunk(A, ws, g0, lane); }
    {
        float* rc = (float*)(ws + WS_ROPE); float* rsn = rc + SEQ * 8;
        const int gt = gw * 64 + lane;
        if (gt < SEQ * 8) { const int pos = gt >> 3, i = gt & 7;
            const float inv = (i == 0 ? 1.000000000e+00f : i == 1 ? 1.939227432e-01f : i == 2 ? 3.760603070e-02f : i == 3 ? 7.292664610e-03f : i == 4 ? 1.414213562e-03f : i == 5 ? 2.742481884e-04f : i == 6 ? 5.318295734e-05f : 1.031338525e-05f);
            const float angf = (float)pos * inv;
            const double rev = (double)angf * 0.15915494309189535; const double fr = rev - rint(rev);
            rc[gt] = __builtin_amdgcn_cosf((float)fr); rsn[gt] = __builtin_amdgcn_sinf((float)fr); }
    }
}

namespace ml {
template <int CTRL, int RMASK> __device__ __forceinline__ float dpp_f(float old, float v) { return __builtin_bit_cast(float, __builtin_amdgcn_update_dpp(__builtin_bit_cast(int, old), __builtin_bit_cast(int, v), CTRL, RMASK, 0xF, false)); }
__device__ __forceinline__ float scan_add64(float v) {
    v += dpp_f<0x111, 0xF>(0.f, v); v += dpp_f<0x112, 0xF>(0.f, v); v += dpp_f<0x114, 0xF>(0.f, v); v += dpp_f<0x118, 0xF>(0.f, v);
    v += dpp_f<0x142, 0xA>(0.f, v); v += dpp_f<0x143, 0xC>(0.f, v); return v; }
__device__ __forceinline__ float scan_max64(float v) {
    v = fmaxf(v, dpp_f<0x111, 0xF>(-INFINITY, v)); v = fmaxf(v, dpp_f<0x112, 0xF>(-INFINITY, v)); v = fmaxf(v, dpp_f<0x114, 0xF>(-INFINITY, v)); v = fmaxf(v, dpp_f<0x118, 0xF>(-INFINITY, v));
    v = fmaxf(v, dpp_f<0x142, 0xA>(-INFINITY, v)); v = fmaxf(v, dpp_f<0x143, 0xC>(-INFINITY, v)); return v; }
__device__ __forceinline__ float last64(float v) { return __builtin_bit_cast(float, __builtin_amdgcn_readlane(__builtin_bit_cast(int, v), 63)); }
typedef short bf16x8 __attribute__((ext_vector_type(8)));
typedef short s16x4 __attribute__((ext_vector_type(4)));
typedef short v4i16_t __attribute__((ext_vector_type(4)));
constexpr int KST = 160, VST = 288, QST = 144;
__device__ __forceinline__ s16x4 tr16(const LAS unsigned char* p) { return __builtin_bit_cast(s16x4, __builtin_amdgcn_ds_read_tr16_b64_v4i16((LAS v4i16_t*)p)); }
__device__ __forceinline__ bf16x8 cat8(s16x4 a, s16x4 b) { return (bf16x8){a[0], a[1], a[2], a[3], b[0], b[1], b[2], b[3]}; }
__device__ __forceinline__ bf16x8 trfrag(const LAS unsigned char* img, int stride, int ks, int col0, int c, int g) {
    const LAS unsigned char* p = img + (32 * ks + 4 * g + (c >> 2)) * stride + (col0 + 4 * (c & 3)) * 2;
    return cat8(tr16(p), tr16(p + 16 * stride));
}
__device__ __forceinline__ void st8(LAS unsigned char* d, float a, float b, float c, float e) { v2u w; w.x = pk2(a, b); w.y = pk2(c, e); *(LAS v2u*)d = w; }

__device__ __forceinline__ void phase_a(CArgs* A, LAS unsigned char* lds, int G, const int bx, const int tid) {
    unsigned char* ws = A->ws; const int lane = tid & 63, wid = __builtin_amdgcn_readfirstlane(tid >> 6), c = lane & 15, g = lane >> 4;
    LAS unsigned char* Ks = lds; LAS unsigned char* Vs = lds + 64 * KST; LAS float* wl = (LAS float*)(Vs + 64 * VST);
    const float* gates = (const float*)(ws + WS_GATES); const bf16* K0 = (const bf16*)(ws + WS_K0); const bf16* V0 = (const bf16*)(ws + WS_V0);
    bf16* cloc = (bf16*)(ws + WS_CLOC); float* nloc = (float*)(ws + WS_NLOC); float* mloc = (float*)(ws + WS_MLOC); float* glast = (float*)(ws + WS_GLAST);
    const int NU = NB_ * ML_H * ML_NC, srow = tid >> 3, pc = tid & 7;
    v4u kxA, vx0A, vx1A, kxB, vx0B, vx1B; float liA = 0.f, lfA = 0.f, liB = 0.f, lfB = 0.f;
    unsigned zz = 0u; asm volatile("" : "+v"(zz));
#define MLA_LOAD(S, unit) do { const int bh_ = (unit) >> 6, c_ = (unit) & 63, b_ = bh_ >> 3, h_ = bh_ & 7, r_ = b_ * SEQ + c_ * ML_L + srow; \
        kx##S = *(const v4u*)(K0 + (size_t)r_ * 512 + h_ * 64 + pc * 8); vx0##S = *(const v4u*)(V0 + (size_t)r_ * 1024 + h_ * 128 + pc * 16); vx1##S = *(const v4u*)(V0 + (size_t)r_ * 1024 + h_ * 128 + pc * 16 + 8); \
        if (tid < 64) { const size_t gr_ = (size_t)(b_ * SEQ + c_ * ML_L + tid) * 16; li##S = gates[gr_ + h_]; lf##S = gates[gr_ + 8 + h_]; } } while (0)
#define MLA_UNIT(S, unit) do { \
        if (tid < 64) { \
            const float gs = scan_add64(lf##S); const float gl = last64(gs); \
            const float a = gl - gs + li##S; const float ml = last64(scan_max64(a)); const float w_ = __expf(a - ml); \
            wl[tid] = w_; *(LAS v4u*)(Vs + tid * VST + 256) = (v4u){f2bf(w_), zz, zz, zz}; *(LAS v4u*)(Vs + tid * VST + 272) = (v4u){zz, zz, zz, zz};     \
            if (tid == 0) { mloc[unit] = ml; glast[unit] = gl; } \
        } \
        *(LAS v4u*)(Ks + srow * KST + pc * 16) = kx##S; \
        __syncthreads(); \
        { const float w = wl[srow]; v4u o0, o1; \
          o0.x = pk2(w * bf_lo(vx0##S.x), w * bf_hi(vx0##S.x)); o0.y = pk2(w * bf_lo(vx0##S.y), w * bf_hi(vx0##S.y)); o0.z = pk2(w * bf_lo(vx0##S.z), w * bf_hi(vx0##S.z)); o0.w = pk2(w * bf_lo(vx0##S.w), w * bf_hi(vx0##S.w)); \
          o1.x = pk2(w * bf_lo(vx1##S.x), w * bf_hi(vx1##S.x)); o1.y = pk2(w * bf_lo(vx1##S.y), w * bf_hi(vx1##S.y)); o1.z = pk2(w * bf_lo(vx1##S.z), w * bf_hi(vx1##S.z)); o1.w = pk2(w * bf_lo(vx1##S.w), w * bf_hi(vx1##S.w)); \
          *(LAS v4u*)(Vs + srow * VST + pc * 32) = o0; *(LAS v4u*)(Vs + srow * VST + pc * 32 + 16) = o1; } \
        __syncthreads(); \
        { const int nx2 = (unit) + 2 * ust; if (nx2 < NUE) MLA_LOAD(S, nx2); }                       \
        { bf16x8 bfr[2]; \
          _Pragma("unroll") for (int ks = 0; ks < 2; ++ks) bfr[ks] = trfrag(Vs, VST, ks, 16 * wid, c, g); \
          bf16* orow = cloc + ((size_t)(unit) * 128 + 16 * wid + c) * 64 + 4 * g; \
          _Pragma("unroll") for (int kt = 0; kt < 4; ++kt) { f32x4 acc = (f32x4){0.f, 0.f, 0.f, 0.f}; \
              _Pragma("unroll") for (int ks = 0; ks < 2; ++ks) acc = __builtin_amdgcn_mfma_f32_16x16x32_bf16(trfrag(Ks, KST, ks, 16 * kt, c, g), bfr[ks], acc, 0, 0, 0); \
              v2u w; w.x = pk2(acc[0], acc[1]); w.y = pk2(acc[2], acc[3]); *(v2u*)(orow + 16 * kt) = w; } \
          if (wid == 0) { _Pragma("unroll") for (int ks = 0; ks < 2; ++ks) bfr[ks] = trfrag(Vs, VST, ks, 128, c, g); \
              _Pragma("unroll") for (int kt = 0; kt < 4; ++kt) { f32x4 acc = (f32x4){0.f, 0.f, 0.f, 0.f}; \
                  _Pragma("unroll") for (int ks = 0; ks < 2; ++ks) acc = __builtin_amdgcn_mfma_f32_16x16x32_bf16(trfrag(Ks, KST, ks, 16 * kt, c, g), bfr[ks], acc, 0, 0, 0); \
                  if (c == 0) *(f32x4*)(nloc + (size_t)(unit) * 64 + 16 * kt + 4 * g) = acc; } } } \
        __syncthreads(); } while (0)
    const bool bl = (G == 256); const int ust = bl ? 32 : G, NUE = bl ? 512 * (bx & 7) + 512 : NU;
    int unit = bl ? 512 * (bx & 7) + (bx >> 3) : bx;
    if (unit < NUE) MLA_LOAD(A, unit);
    if (unit + ust < NUE) MLA_LOAD(B, unit + ust);
    for (;;) {
        if (unit >= NUE) break;
        MLA_UNIT(A, unit); unit += ust;
        if (unit >= NUE) break;
        MLA_UNIT(B, unit); unit += ust;
    }
#undef MLA_LOAD
#undef MLA_UNIT
}
__device__ __forceinline__ void phase_scan(CArgs* A, int G, const int bx, const int tid) {
    unsigned char* ws = A->ws;
    bf16* cloc = (bf16*)(ws + WS_CLOC); float* nloc = (float*)(ws + WS_NLOC); const float* mloc = (const float*)(ws + WS_MLOC); const float* glast = (const float*)(ws + WS_GLAST); float* mprev = (float*)(ws + WS_MPREV);
    for (int su = (G == 256) ? 32 * (bx & 7) + (bx >> 3) : bx; su < 64 * 4; su += G) {
        const int bh = su >> 2, qt = su & 3;
        bf16* cp = cloc + (size_t)bh * 64 * 8192 + qt * 2048 + tid * 4;
        float C0 = 0.f, C1 = 0.f, C2 = 0.f, C3 = 0.f, n = 0.f, m = 0.f;
#pragma unroll 1
        for (int c0 = 0; c0 < 64; c0 += 8) {
            v2u cl[8]; float ml[8], gl[8], nl[8];
#pragma unroll
            for (int i = 0; i < 8; ++i) { cl[i] = *(const v2u*)(cp + (size_t)(c0 + i) * 8192); ml[i] = mloc[bh * 64 + c0 + i]; gl[i] = glast[bh * 64 + c0 + i];
                nl[i] = (qt == 0 && tid < 64) ? nloc[(size_t)(bh * 64 + c0 + i) * 64 + tid] : 0.f; }
#pragma unroll
            for (int i = 0; i < 8; ++i) {
                const float mn = fmaxf(gl[i] + m, ml[i]), sp = __expf(gl[i] + m - mn), sl = __expf(ml[i] - mn);
                v2u o; o.x = pk2(C0, C1); o.y = pk2(C2, C3); *(v2u*)(cp + (size_t)(c0 + i) * 8192) = o;
                C0 = sp * C0 + sl * bf_lo(cl[i].x); C1 = sp * C1 + sl * bf_hi(cl[i].x); C2 = sp * C2 + sl * bf_lo(cl[i].y); C3 = sp * C3 + sl * bf_hi(cl[i].y);
                if (qt == 0 && tid < 64) { nloc[(size_t)(bh * 64 + c0 + i) * 64 + tid] = n; n = sp * n + sl * nl[i]; }
                if (qt == 0 && tid == 0) mprev[bh * 64 + c0 + i] = m;
                m = mn;
            }
        }
    }
}
__device__ __forceinline__ void phase_c(CArgs* A, LAS unsigned char* lds, int G, const int bx, const int tid) {
    unsigned char* ws = A->ws; const int lane = tid & 63, wid = __builtin_amdgcn_readfirstlane(tid >> 6), c = lane & 15, g = lane >> 4, jt = wid & 3, vh = wid >> 2;
    LAS unsigned char* Qs = lds; LAS unsigned char* Ks = Qs + 64 * QST; LAS unsigned char* Cs = Ks + 64 * QST; LAS unsigned char* Vs = Cs + 128 * QST; LAS unsigned char* Os = Vs + 64 * VST;
    LAS float* sc = (LAS float*)(Os + 64 * VST);
    const float* gates = (const float*)(ws + WS_GATES); const bf16* Q0 = (const bf16*)(ws + WS_Q0); const bf16* K0 = (const bf16*)(ws + WS_K0); const bf16* V0 = (const bf16*)(ws + WS_V0);
    const bf16* OG = (const bf16*)(ws + WS_OG); bf16* HC = (bf16*)(ws + WS_V0);
    const bf16* cprev = (const bf16*)(ws + WS_CLOC); const float* nprev = (const float*)(ws + WS_NLOC); const float* mprev = (const float*)(ws + WS_MPREV);
    const float* mh_gain = A->in[5];
    const int NU = NB_ * ML_H * ML_NC, srow = tid >> 3, pc = tid & 7;
    v4u qx, kx, vx0, vx1, cx0, cx1, ox0, ox1; float li = 0.f, lf = 0.f, mp = 0.f, np = 0.f;
#define MLC_LOAD(unit) do { const int bh_ = (unit) >> 6, c_ = (unit) & 63, b_ = bh_ >> 3, h_ = bh_ & 7, r_ = b_ * SEQ + c_ * ML_L + srow; \
        qx = *(const v4u*)(Q0 + (size_t)r_ * 512 + h_ * 64 + pc * 8); kx = *(const v4u*)(K0 + (size_t)r_ * 512 + h_ * 64 + pc * 8); \
        vx0 = *(const v4u*)(V0 + (size_t)r_ * 1024 + h_ * 128 + pc * 16); vx1 = *(const v4u*)(V0 + (size_t)r_ * 1024 + h_ * 128 + pc * 16 + 8); \
        ox0 = *(const v4u*)(OG + (size_t)r_ * 1024 + h_ * 128 + pc * 16); ox1 = *(const v4u*)(OG + (size_t)r_ * 1024 + h_ * 128 + pc * 16 + 8); \
        cx0 = *(const v4u*)(cprev + (size_t)(unit) * 8192 + tid * 16); cx1 = *(const v4u*)(cprev + (size_t)(unit) * 8192 + tid * 16 + 8); \
        if (tid < 64) { const size_t gr_ = (size_t)(b_ * SEQ + c_ * ML_L + tid) * 16; li = gates[gr_ + h_]; lf = gates[gr_ + 8 + h_]; mp = mprev[unit]; np = nprev[(size_t)(unit) * 64 + tid]; } } while (0)
    const bool bl = (G == 256); const int ust = bl ? 32 : G, NUE = bl ? 512 * (bx & 7) + 512 : NU;
    int unit = bl ? 512 * (bx & 7) + (bx >> 3) : bx;
    if (unit < NUE) MLC_LOAD(unit);
    for (; unit < NUE; unit += ust) {
        const int bh = unit >> 6, cc = unit & 63, b = bh >> 3, h = bh & 7, row0 = b * SEQ + cc * ML_L;
        if (tid < 64) {
            const float gs = scan_add64(lf); const float pm = scan_max64(li - gs);
            const float mintra = gs + pm, minter = gs + mp, mc = fmaxf(minter, mintra);
            sc[tid] = gs - mc; sc[64 + tid] = li - gs; sc[128 + tid] = __expf(minter - mc); sc[192 + tid] = __expf(-mc); sc[256 + tid] = np;
        }
        *(LAS v4u*)(Qs + srow * QST + pc * 16) = qx; *(LAS v4u*)(Ks + srow * QST + pc * 16) = kx;
        *(LAS v4u*)(Vs + srow * VST + pc * 32) = vx0; *(LAS v4u*)(Vs + srow * VST + pc * 32 + 16) = vx1;
        *(LAS v4u*)(Os + srow * VST + pc * 32) = ox0; *(LAS v4u*)(Os + srow * VST + pc * 32 + 16) = ox1;
        { const int cv = tid >> 2, cp = (tid & 3) * 2; *(LAS v4u*)(Cs + cv * QST + cp * 16) = cx0; *(LAS v4u*)(Cs + cv * QST + cp * 16 + 16) = cx1; }
        __syncthreads();
        const int nxt = unit + ust;
        if (nxt < NUE) MLC_LOAD(nxt);
        const int j = 16 * jt + c;
        bf16x8 qf[2];
#pragma unroll
        for (int ks = 0; ks < 2; ++ks) qf[ks] = *(const LAS bf16x8*)(Qs + j * QST + (32 * ks + 8 * g) * 2);
        f32x4 p[4]; float rs = 0.f; const float uj = sc[j];
#pragma unroll
        for (int st = 0; st < 4; ++st) { f32x4 acc = (f32x4){0.f, 0.f, 0.f, 0.f};
#pragma unroll
            for (int ks = 0; ks < 2; ++ks) acc = __builtin_amdgcn_mfma_f32_16x16x32_bf16(*(const LAS bf16x8*)(Ks + (16 * st + c) * QST + (32 * ks + 8 * g) * 2), qf[ks], acc, 0, 0, 0);
            const f32x4 tt = *(const LAS f32x4*)(sc + 64 + 16 * st + 4 * g);
#pragma unroll
            for (int r = 0; r < 4; ++r) { const int s = 16 * st + 4 * g + r; const float v = (s <= j) ? acc[r] * __expf(uj + tt[r]) : 0.f; p[st][r] = v; rs += v; } }
        bf16x8 pb[2];
#pragma unroll
        for (int ks = 0; ks < 2; ++ks) { v4u w; w.x = pk2(p[2 * ks][0], p[2 * ks][1]); w.y = pk2(p[2 * ks][2], p[2 * ks][3]); w.z = pk2(p[2 * ks + 1][0], p[2 * ks + 1][1]); w.w = pk2(p[2 * ks + 1][2], p[2 * ks + 1][3]); pb[ks] = __builtin_bit_cast(bf16x8, w); }
        f32x4 hh[4]; const float wi = sc[128 + j];
#pragma unroll
        for (int vt = 0; vt < 4; ++vt) { f32x4 acc = (f32x4){0.f, 0.f, 0.f, 0.f};
#pragma unroll
            for (int ks = 0; ks < 2; ++ks) acc = __builtin_amdgcn_mfma_f32_16x16x32_bf16(*(const LAS bf16x8*)(Cs + (64 * vh + 16 * vt + c) * QST + (32 * ks + 8 * g) * 2), qf[ks], acc, 0, 0, 0);
            acc = acc * wi;
#pragma unroll
            for (int ks = 0; ks < 2; ++ks) acc = __builtin_amdgcn_mfma_f32_16x16x32_bf16(trfrag(Vs, VST, ks, 64 * vh + 16 * vt, c, g), pb[ks], acc, 0, 0, 0);
            hh[vt] = acc; }
        float qn = 0.f;
        { const v4u q0 = *(const LAS v4u*)(Qs + j * QST + 32 * g), q1 = *(const LAS v4u*)(Qs + j * QST + 32 * g + 16); const LAS f32x4* nv = (const LAS f32x4*)(sc + 256 + 16 * g);
          const f32x4 n0 = nv[0], n1 = nv[1], n2 = nv[2], n3 = nv[3];
          qn = (bf_lo(q0.x) * n0[0] + bf_hi(q0.x) * n0[1] + bf_lo(q0.y) * n0[2] + bf_hi(q0.y) * n0[3]) + (bf_lo(q0.z) * n1[0] + bf_hi(q0.z) * n1[1] + bf_lo(q0.w) * n1[2] + bf_hi(q0.w) * n1[3])
             + (bf_lo(q1.x) * n2[0] + bf_hi(q1.x) * n2[1] + bf_lo(q1.y) * n2[2] + bf_hi(q1.y) * n2[3]) + (bf_lo(q1.z) * n3[0] + bf_hi(q1.z) * n3[1] + bf_lo(q1.w) * n3[2] + bf_hi(q1.w) * n3[3]); }
        qn += shx(qn, 16, lane); qn += shx(qn, 32, lane); rs += shx(rs, 16, lane); rs += shx(rs, 32, lane);
        const float inv = 1.0f / fmaxf(fabsf(wi * qn + rs), sc[192 + j]);
        float ss = 0.f;
#pragma unroll
        for (int vt = 0; vt < 4; ++vt) { hh[vt] = hh[vt] * inv; ss += (hh[vt][0] * hh[vt][0] + hh[vt][1] * hh[vt][1]) + (hh[vt][2] * hh[vt][2] + hh[vt][3] * hh[vt][3]); }
        ss += shx(ss, 16, lane); ss += shx(ss, 32, lane);
        if (g == 0) sc[320 + 64 * vh + j] = ss;
        __syncthreads();
        const float rn = __builtin_amdgcn_rsqf((sc[320 + j] + sc[384 + j]) * (1.0f / ML_DV) + EPS);
#pragma unroll
        for (int vt = 0; vt < 4; ++vt) { const int v0 = 64 * vh + 16 * vt + 4 * g; const v2u ow = *(const LAS v2u*)(Os + j * VST + v0 * 2); const f32x4 gn = *(const f32x4*)(mh_gain + v0);
            st8(Vs + j * VST + v0 * 2, hh[vt][0] * rn * gn[0] * sigmoidf_(bf_lo(ow.x)), hh[vt][1] * rn * gn[1] * sigmoidf_(bf_hi(ow.x)), hh[vt][2] * rn * gn[2] * sigmoidf_(bf_lo(ow.y)), hh[vt][3] * rn * gn[3] * sigmoidf_(bf_hi(ow.y))); }
        __syncthreads();
        { const v4u o0 = *(const LAS v4u*)(Vs + srow * VST + pc * 32), o1 = *(const LAS v4u*)(Vs + srow * VST + pc * 32 + 16); bf16* op = HC + (size_t)(row0 + srow) * 1024 + h * 128 + pc * 16;
          *(v4u*)op = o0; *(v4u*)(op + 8) = o1; }
        __syncthreads();
    }
#undef MLC_LOAD
}
}

namespace mattn {
using bf16=__hip_bfloat16;
using bf16x8=__attribute__((ext_vector_type(8)))short;
using s16x4=__attribute__((ext_vector_type(4)))short;
using f32x16=__attribute__((ext_vector_type(16)))float;
using u32x4=__attribute__((ext_vector_type(4)))unsigned;
constexpr int BATCH=8,NHEAD=16,SEQ=4096,D=64,DM=NHEAD*D,KP=256;
constexpr int NW=8,QBLK=32,QB=QBLK*NW,KVBLK=64,NQB=SEQ/QB;
constexpr int ATTN_PITCH=DM, ATTN_UNIT_ROWS=QB;
__device__ __forceinline__ int crow(int r,int hi){return (r&3)+8*(r>>2)+4*hi;}
#define SBAR() __builtin_amdgcn_sched_barrier(0)
__device__ __forceinline__ void cmask(f32x16&p0,f32x16&p1,int jb,int qrel,int hi){
  asm volatile("":"+v"(hi),"+v"(qrel));
  const float NEG=-INFINITY; int kb=64*jb+4*hi;
  #pragma unroll
  for(int r=0;r<16;++r){int kv=kb+(r&3)+8*(r>>2); if(kv>qrel)p0[r]=NEG; if(kv+32>qrel)p1[r]=NEG;}
}

constexpr int NSLOT=3, SLOTB=8192;
constexpr int LDS_K=0, LDS_V=NSLOT*SLOTB, LDS_WS=2*NSLOT*SLOTB, LDS_OST=LDS_WS+NW*64*4, LDS_KM=LDS_OST+NW*4096, LDS_BYTES=LDS_KM+4096;
constexpr float C2=0.125f*1.4426950408889634f;
__device__ __forceinline__ void glds16(const void*sbase,unsigned voff,unsigned lds_dst){unsigned keep;
  asm volatile("s_nop 4\n\ts_mov_b32 %0, m0\n\ts_mov_b32 m0, %3\n\ts_nop 0\n\tglobal_load_lds_dwordx4 %1, %2\n\ts_mov_b32 m0, %0":"=&s"(keep):"v"(voff),"s"(sbase),"s"(lds_dst):"memory");}
__device__ __forceinline__ float max3f(float a,float b,float c){float r;asm("v_max3_f32 %0, %1, %2, %3":"=v"(r):"v"(a),"v"(b),"v"(c));return r;}
__device__ __forceinline__ float max2f(float a,float b){float r;asm("v_max_f32_e32 %0, %1, %2":"=v"(r):"v"(a),"v"(b));return r;}
__device__ __forceinline__ float fadd_s(float a,float b){float r;asm("v_add_f32_e32 %0, %1, %2":"=v"(r):"v"(a),"v"(b));return r;}
__device__ __forceinline__ float fsub_s(float a,float b){float r;asm("v_sub_f32_e32 %0, %1, %2":"=v"(r):"v"(a),"v"(b));return r;}
typedef float f32x2_t __attribute__((ext_vector_type(2))); typedef __bf16 bf16x2_t __attribute__((ext_vector_type(2)));
__device__ __forceinline__ unsigned cvtpk_s(float lo,float hi){f32x2_t v={lo,hi};bf16x2_t b=__builtin_convertvector(v,bf16x2_t);return __builtin_bit_cast(unsigned,b);}
#define WAIT_BAR(N) asm volatile("s_waitcnt vmcnt(" #N ") lgkmcnt(0)\n\ts_barrier":::"memory")

__device__ __forceinline__ void qkt(f32x16&p0,f32x16&p1,const char*Kslot,const bf16x8*qr,const f32x16&negm,int r32,int hi){
  const char*kb=Kslot+hi*1024+r32*16;
  #pragma unroll
  for(int d0=0;d0<4;++d0){
    const bf16x8 b0=*reinterpret_cast<const bf16x8*>(kb+d0*2048);
    const bf16x8 b1=*reinterpret_cast<const bf16x8*>(kb+d0*2048+512);
    if(d0==0){p0=__builtin_amdgcn_mfma_f32_32x32x16_bf16(b0,qr[0],negm,0,0,0);p1=__builtin_amdgcn_mfma_f32_32x32x16_bf16(b1,qr[0],negm,0,0,0);}
    else{p0=__builtin_amdgcn_mfma_f32_32x32x16_bf16(b0,qr[d0],p0,0,0,0);p1=__builtin_amdgcn_mfma_f32_32x32x16_bf16(b1,qr[d0],p1,0,0,0);}}
}
typedef __attribute__((address_space(3))) const char* lds_cptr;
typedef short v4i16_t __attribute__((ext_vector_type(4)));
__device__ __forceinline__ void kload8(bf16x8*kf,lds_cptr kp){
  kf[0]=*(const __attribute__((address_space(3))) bf16x8*)(kp);      kf[1]=*(const __attribute__((address_space(3))) bf16x8*)(kp+512);
  kf[2]=*(const __attribute__((address_space(3))) bf16x8*)(kp+2048); kf[3]=*(const __attribute__((address_space(3))) bf16x8*)(kp+2560);
  kf[4]=*(const __attribute__((address_space(3))) bf16x8*)(kp+4096); kf[5]=*(const __attribute__((address_space(3))) bf16x8*)(kp+4608);
  kf[6]=*(const __attribute__((address_space(3))) bf16x8*)(kp+6144); kf[7]=*(const __attribute__((address_space(3))) bf16x8*)(kp+6656);
}
__device__ __forceinline__ void kload2(bf16x8*kf,lds_cptr kp,int j){ kf[2*j]=*(const __attribute__((address_space(3))) bf16x8*)(kp+j*2048); kf[2*j+1]=*(const __attribute__((address_space(3))) bf16x8*)(kp+j*2048+512); }
__device__ __forceinline__ s16x4 vtr(lds_cptr p){ return __builtin_bit_cast(s16x4,__builtin_amdgcn_ds_read_tr16_b64_v4i16((__attribute__((address_space(3))) v4i16_t*)p)); }
__device__ __forceinline__ float rowmax(const f32x16&p0,const f32x16&p1){
  float a=max3f(p0[0],p0[1],p1[0]),b=max3f(p0[2],p0[3],p1[1]);a=max3f(a,p1[2],p1[3]);
  #pragma unroll
  for(int r=4;r<16;r+=4){a=max3f(a,p0[r],p0[r+1]);b=max3f(b,p0[r+2],p0[r+3]);a=max3f(a,p1[r],p1[r+1]);b=max3f(b,p1[r+2],p1[r+3]);}
  const float m=max2f(a,b);
  auto rr=__builtin_amdgcn_permlane32_swap(__float_as_uint(m),__float_as_uint(m),false,false);
  return max2f(__uint_as_float(rr[0]),__uint_as_float(rr[1]));
}
__device__ __forceinline__ void pv(f32x16*o,int vb,bf16x8 pa0,bf16x8 pa1,bf16x8 pa2,bf16x8 pa3){
  #pragma unroll
  for(int d0=0;d0<2;++d0){s16x4 lo[4],hi[4];
    #pragma unroll
    for(int ks=0;ks<4;++ks){
      asm volatile("ds_read_b64_tr_b16 %0,%1 offset:%c2":"=&v"(lo[ks]):"v"(vb),"i"(d0*4096+ks*1024):"memory");
      asm volatile("ds_read_b64_tr_b16 %0,%1 offset:%c2":"=&v"(hi[ks]):"v"(vb),"i"(d0*4096+ks*1024+512):"memory");}
    asm volatile("s_waitcnt lgkmcnt(0)":::"memory");SBAR();
    #define PK(k) (bf16x8){lo[k][0],lo[k][1],lo[k][2],lo[k][3],hi[k][0],hi[k][1],hi[k][2],hi[k][3]}
    o[d0]=__builtin_amdgcn_mfma_f32_32x32x16_bf16(pa0,PK(0),o[d0],0,0,0);
    o[d0]=__builtin_amdgcn_mfma_f32_32x32x16_bf16(pa1,PK(1),o[d0],0,0,0);
    o[d0]=__builtin_amdgcn_mfma_f32_32x32x16_bf16(pa2,PK(2),o[d0],0,0,0);
    o[d0]=__builtin_amdgcn_mfma_f32_32x32x16_bf16(pa3,PK(3),o[d0],0,0,0);
    #undef PK
  }
}

#ifndef ATTN_STORE16
#define ATTN_STORE16(p,v) (*(u32x4*)(p)=(v))
#endif
__device__ __forceinline__ void attn_unit(int b,int h,int qb,const bf16*Q,const bf16*__restrict__ K,const bf16*__restrict__ V,bf16*O,char*shm,const float*kmsum,const float mref,const bool fill_km,const int tid){
  const int lane=tid&63,r32=lane&31,hi=lane>>5; const int wid=__builtin_amdgcn_readfirstlane(tid>>6);
  const long rowbase=(long)b*SEQ; const int q0=qb*QB;
  const bf16*Qw=Q+(rowbase+q0+wid*QBLK)*DM+h*D;
  const bf16*Kh=K+rowbase*KP+(h>>2)*D,*Vh=V+rowbase*KP+(h>>2)*D;
  const lds_cptr shm3=(lds_cptr)shm;
  const unsigned lds0=(unsigned)(uintptr_t)shm;
  float*wsf=(float*)(shm+LDS_WS)+wid*64;
  const unsigned kvoff=(unsigned)(lane*KP+wid*8)*2u;
  const unsigned vvoff=(unsigned)((16*(wid&3)+(lane>>2))*KP+(wid>>2)*32+(lane&3)*8)*2u;
  const unsigned kdst=lds0+LDS_K+wid*1024, vdst=lds0+LDS_V+wid*1024;
  #define DMA_K(t,slot) glds16(Kh+(long)(t)*KVBLK*KP,kvoff,(unsigned)__builtin_amdgcn_readfirstlane(kdst+(slot)))
  #define DMA_V(t,slot) glds16(Vh+(long)(t)*KVBLK*KP,vvoff,(unsigned)__builtin_amdgcn_readfirstlane(vdst+(slot)))
  const int vb0=(int)(lds0+LDS_V)+((lane>>4)&1)*32+(lane&3)*8+(4*hi+((lane&15)>>2))*64;
  const char*Kbase=shm+LDS_K; bf16x8 kf[8];
  const lds_cptr kp0=shm3+LDS_K+hi*1024+r32*16; const lds_cptr vp0=shm3+LDS_V+((lane>>4)&1)*32+(lane&3)*8+(4*hi+((lane&15)>>2))*64;
  const int NT=(q0+QB)/KVBLK;
  typedef __attribute__((address_space(3))) float ldsf;
  if(fill_km){ const float*ks0=kmsum+((size_t)b*16*4+(h>>2))*64;
    typedef __attribute__((address_space(3))) unsigned short ldsh;
    #pragma unroll
    for(int i=0;i<2;++i){const int idx=tid+512*i,n=idx>>6,d=idx&63; const float v=ks0[(size_t)n*256+d];
      const unsigned hb=cvtpk_s(v,0.f)&0xffffu; const unsigned lb=cvtpk_s(v-__uint_as_float(hb<<16),0.f)&0xffffu;
      ldsh*kp_=(ldsh*)(shm3+LDS_KM+(d>>3)*512+(d&7)*2); kp_[n*8]=(unsigned short)hb; kp_[(16+n)*8]=(unsigned short)lb;}
    asm volatile("s_waitcnt vmcnt(0) lgkmcnt(0)\n\ts_barrier":::"memory"); }
  DMA_K(0,0);DMA_V(0,0);DMA_K(1,SLOTB);
  bf16x8 qr[4];
  #pragma unroll
  for(int d0=0;d0<4;++d0)qr[d0]=*reinterpret_cast<const bf16x8*>(&Qw[(long)r32*DM+d0*16+hi*8]);
  unsigned selm=1u<<qb;
  if(qb>0){
    f32x16 gp;
    const lds_cptr kmp=shm3+LDS_KM+hi*512+r32*16;
    #pragma unroll
    for(int d0=0;d0<4;++d0){ const bf16x8 a=*(const __attribute__((address_space(3))) bf16x8*)(kmp+d0*1024);
      if(d0==0)gp=__builtin_amdgcn_mfma_f32_32x32x16_bf16(a,qr[0],f32x16{},0,0,0); else gp=__builtin_amdgcn_mfma_f32_32x32x16_bf16(a,qr[d0],gp,0,0,0); }
    float g[16];
    #pragma unroll
    for(int j=0;j<8;++j){ const float sg=gp[j]+gp[j+8]; const int n0=(j&3)+8*(j>>2);
      auto rr=__builtin_amdgcn_permlane32_swap(__float_as_uint(sg),__float_as_uint(sg),false,false);
      g[n0]=(n0<qb)?__uint_as_float(rr[0]):-INFINITY; g[n0+4]=(n0+4<qb)?__uint_as_float(rr[1]):-INFINITY; }
    #pragma unroll
    for(int r=0;r<3;++r){ float best=-INFINITY; int bi=0;
      #pragma unroll
      for(int n=0;n<15;++n)if(g[n]>best){best=g[n];bi=n;}
      if(best>-INFINITY)selm|=1u<<bi;
      #pragma unroll
      for(int n=0;n<15;++n)g[n]=(n==bi)?-INFINITY:g[n]; }
  }
  float l_reg=0.f;f32x16 o[2];o[0]=f32x16{};o[1]=f32x16{};f32x16 negm;
  #define SETNEG(t) do{ const float v_=((selm>>((t)>>2))&1u)?-mref:-INFINITY; _Pragma("unroll") for(int r=0;r<16;++r)negm[r]=v_; asm volatile("":"+v"(negm)); }while(0)
  SETNEG(0);
  const int qrel=wid*QBLK+r32;
  #define CMASK(P0,P1,t) do{int jb_=(t)-(NT-4); if(jb_>=0)cmask(P0,P1,jb_,qrel,hi);}while(0)
  #define START(P0,P1) do{ _Pragma("unroll") for(int r=0;r<16;++r)P0[r]=__builtin_amdgcn_exp2f(P0[r]); }while(0)
  #define RESC() do{}while(0)
  f32x16 pA0,pA1,pB0,pB1;
  int sl_prev=0,sl_cur=0,sl_next=SLOTB;
  #define ROT() do{sl_prev=sl_cur;sl_cur=sl_next;sl_next=(sl_next==(NSLOT-1)*SLOTB)?0:sl_next+SLOTB;}while(0)
  DMA_K(2,2*SLOTB);
  WAIT_BAR(3);
  qkt(pA0,pA1,Kbase,qr,negm,r32,hi);asm volatile("s_nop 15\n\ts_nop 7":"+v"(pA0),"+v"(pA1));CMASK(pA0,pA1,0);
  START(pA0,pA1);
  _Pragma("unroll") for(int r=0;r<16;++r)pA1[r]=__builtin_amdgcn_exp2f(pA1[r]);
  WAIT_BAR(0);
  DMA_K(3,0);DMA_V(1,SLOTB);
  ROT();
  kload8(kf,kp0+sl_cur);
  WAIT_BAR(2);
  s16x4 vlo[8],vhi[8]; u32x4 pw0,pw1,pw2,pw3;
  #define PKW(P,B) cvtpk_s(P[B],P[B+1])
  #define PAF(k) __builtin_bit_cast(bf16x8,pw##k)
  #define VFR(i) (bf16x8){vlo[i][0],vlo[i][1],vlo[i][2],vlo[i][3],vhi[i][0],vhi[i][1],vhi[i][2],vhi[i][3]}
  #define PIN(x) asm volatile("":"+v"(x))
  #define MX3(a,b,c) __builtin_fmaxf(__builtin_fmaxf((a),(b)),(c))
  #define GAPA(MF,A0,A1,A2,A3,W0,W1,PW) do{ MF; sacc+=A0; sacc+=A1; sacc+=A2; sacc+=A3; PIN(sacc); W0; W1; PIN(PW); SBAR(); }while(0)
  #define EX(v) __builtin_amdgcn_exp2f(v)
  #define GAPB(MF,X,B) do{ MF; X[B]=EX(X[B]); X[B+1]=EX(X[B+1]); X[B+2]=EX(X[B+2]); X[B+3]=EX(X[B+3]); PIN(X); SBAR(); }while(0)
  #define VRD(i) do{ vlo[i]=vtr(vp_+(((i)>>2)*4096+((i)&3)*1024)); vhi[i]=vtr(vp_+(((i)>>2)*4096+((i)&3)*1024+512)); }while(0)
  #define KRD(G,j) do{ if(G){ kload2(kf,kp0+sl_next,j); SBAR(); } }while(0)
  #define STEP(C0,C1,P0,P1,t,GK,GV,GL) do{ if((((t))&3)==0){SETNEG(t);} SBAR(); \
    const lds_cptr vp_=vp0+sl_prev; \
    VRD(0); SBAR(); float sacc=(P0[0]+P0[1]); \
    GAPA(C0=__builtin_amdgcn_mfma_f32_32x32x16_bf16(kf[0],qr[0],negm,0,0,0), P0[2],P0[3],P0[4],P0[5],     pw0[0]=PKW(P0,0), pw0[1]=PKW(P0,2), pw0); \
    VRD(4); SBAR(); GAPA(C1=__builtin_amdgcn_mfma_f32_32x32x16_bf16(kf[1],qr[0],negm,0,0,0), P0[6],P0[7],P0[8],P0[9],     pw0[2]=PKW(P0,4), pw0[3]=PKW(P0,6), pw0); \
    VRD(1); SBAR(); GAPA(C0=__builtin_amdgcn_mfma_f32_32x32x16_bf16(kf[2],qr[1],C0,0,0,0),   P0[10],P0[11],P0[12],P0[13], pw1[0]=PKW(P0,8), pw1[1]=PKW(P0,10), pw1); \
    VRD(5); SBAR(); GAPA(C1=__builtin_amdgcn_mfma_f32_32x32x16_bf16(kf[3],qr[1],C1,0,0,0),   P0[14],P0[15],P1[0],P1[1],   pw1[2]=PKW(P0,12),pw1[3]=PKW(P0,14), pw1); \
    VRD(2); SBAR(); GAPA(C0=__builtin_amdgcn_mfma_f32_32x32x16_bf16(kf[4],qr[2],C0,0,0,0),   P1[2],P1[3],P1[4],P1[5],     pw2[0]=PKW(P1,0), pw2[1]=PKW(P1,2), pw2); \
    VRD(6); SBAR(); GAPA(C1=__builtin_amdgcn_mfma_f32_32x32x16_bf16(kf[5],qr[2],C1,0,0,0),   P1[6],P1[7],P1[8],P1[9],     pw2[2]=PKW(P1,4), pw2[3]=PKW(P1,6), pw2); \
    VRD(3); SBAR(); GAPA(C0=__builtin_amdgcn_mfma_f32_32x32x16_bf16(kf[6],qr[3],C0,0,0,0),   P1[10],P1[11],P1[12],P1[13], pw3[0]=PKW(P1,8), pw3[1]=PKW(P1,10), pw3); \
    VRD(7); SBAR(); GAPA(C1=__builtin_amdgcn_mfma_f32_32x32x16_bf16(kf[7],qr[3],C1,0,0,0),   P1[14],P1[15],0.f,0.f,       pw3[2]=PKW(P1,12),pw3[3]=PKW(P1,14), pw3); \
    l_reg+=sacc; \
    if(GK){DMA_K((t)+3,sl_cur);} if(GV){DMA_V((t)+1,sl_next);} \
    CMASK(C0,C1,t); \
    SBAR(); \
    GAPB(o[0]=__builtin_amdgcn_mfma_f32_32x32x16_bf16(PAF(0),VFR(0),o[0],0,0,0), C0,0); \
    GAPB(o[1]=__builtin_amdgcn_mfma_f32_32x32x16_bf16(PAF(0),VFR(4),o[1],0,0,0), C0,4); \
    KRD(GL,0); GAPB(o[0]=__builtin_amdgcn_mfma_f32_32x32x16_bf16(PAF(1),VFR(1),o[0],0,0,0), C0,8); \
    KRD(GL,1); GAPB(o[1]=__builtin_amdgcn_mfma_f32_32x32x16_bf16(PAF(1),VFR(5),o[1],0,0,0), C0,12); \
    KRD(GL,2); GAPB(o[0]=__builtin_amdgcn_mfma_f32_32x32x16_bf16(PAF(2),VFR(2),o[0],0,0,0), C1,0); \
    KRD(GL,3); GAPB(o[1]=__builtin_amdgcn_mfma_f32_32x32x16_bf16(PAF(2),VFR(6),o[1],0,0,0), C1,4); \
    GAPB(o[0]=__builtin_amdgcn_mfma_f32_32x32x16_bf16(PAF(3),VFR(3),o[0],0,0,0), C1,8); \
    GAPB(o[1]=__builtin_amdgcn_mfma_f32_32x32x16_bf16(PAF(3),VFR(7),o[1],0,0,0), C1,12); \
    }while(0)
  int t=1;
  #undef CMASK
  #define CMASK(P0,P1,t) do{}while(0)
  for(;t+5<NT;t+=2){
    STEP(pB0,pB1,pA0,pA1,t,true,true,true);     WAIT_BAR(2); RESC(); ROT();
    STEP(pA0,pA1,pB0,pB1,t+1,true,true,true);   WAIT_BAR(2); RESC(); ROT();
  }
  #undef CMASK
  #define CMASK(P0,P1,t) do{int jb_=(t)-(NT-4); if(jb_>=0)cmask(P0,P1,jb_,qrel,hi);}while(0)
  #define ENDW(tt) do{ if((tt)+3<NT){WAIT_BAR(2);} else if((tt)+2<NT){WAIT_BAR(1);} else {WAIT_BAR(0);} }while(0)
  for(;t+1<NT;t+=2){
    STEP(pB0,pB1,pA0,pA1,t,(t+3<NT),(t+1<NT),(t+1<NT));       ENDW(t);   RESC(); ROT();
    STEP(pA0,pA1,pB0,pB1,t+1,(t+4<NT),(t+2<NT),(t+2<NT));     ENDW(t+1); RESC(); ROT();
  }
  STEP(pB0,pB1,pA0,pA1,NT-1,false,false,false); RESC();
  { float sacc=pB0[0]+pB0[1]; _Pragma("unroll") for(int r=2;r<16;++r)sacc+=pB0[r]; _Pragma("unroll") for(int r=0;r<16;++r)sacc+=pB1[r]; l_reg+=sacc;
    pw0=(u32x4){PKW(pB0,0),PKW(pB0,2),PKW(pB0,4),PKW(pB0,6)};pw1=(u32x4){PKW(pB0,8),PKW(pB0,10),PKW(pB0,12),PKW(pB0,14)};pw2=(u32x4){PKW(pB1,0),PKW(pB1,2),PKW(pB1,4),PKW(pB1,6)};pw3=(u32x4){PKW(pB1,8),PKW(pB1,10),PKW(pB1,12),PKW(pB1,14)};
    SBAR(); pv(o,vb0+sl_cur,PAF(0),PAF(1),PAF(2),PAF(3)); }
  #undef PKW
  #undef PAF
  #undef VFR
  #undef PIN
  #undef MX3
  #undef GAPA
  #undef GAPB
  #undef EX
  #undef VRD
  #undef KRD
  #undef STEP
  #undef ENDW
  {auto rr=__builtin_amdgcn_permlane32_swap(__float_as_uint(l_reg),__float_as_uint(l_reg),false,false);l_reg=__uint_as_float(rr[0])+__uint_as_float(rr[1]);}
  if(hi==0)wsf[32+r32]=l_reg;asm volatile("s_waitcnt lgkmcnt(0)":::"memory");
  float rli[16];
  #pragma unroll
  for(int r=0;r<16;++r)rli[r]=__builtin_amdgcn_rcpf(wsf[32+crow(r,hi)]);
  bf16*Ow=O+(rowbase+q0+wid*QBLK)*DM+h*D;
  { bf16*stg=(bf16*)(shm+LDS_OST)+wid*2048;
    #pragma unroll
    for(int r=0;r<16;++r){const int orow=crow(r,hi);
      #pragma unroll
      for(int d0=0;d0<2;++d0)stg[orow*64+d0*32+r32]=__float2bfloat16(o[d0][r]*rli[r]);}
    asm volatile("s_waitcnt lgkmcnt(0)":::"memory");
    #pragma unroll
    for(int i=0;i<4;++i){const int row=i*8+(lane>>3),ch=lane&7; const u32x4 v=*(const u32x4*)(stg+row*64+ch*8); ATTN_STORE16(Ow+(long)row*DM+ch*8,v);} }
  asm volatile("s_waitcnt lgkmcnt(0)\n\ts_barrier":::"memory");
  #undef DMA_K
  #undef DMA_V
  #undef CMASK
  #undef START
  #undef SETNEG
  #undef RESC
  #undef ROT
}
constexpr int ATTN_LDS_BYTES=LDS_BYTES;
struct AttnTensors { const bf16* Q; const bf16* K; const bf16* V; bf16* O; const float* kmsum; };
struct AttnUnit { int bh; int qb; };
struct StaticOrder {
  int vcu, G;
  __device__ __forceinline__ StaticOrder(int grid,int vc):vcu(vc),G(grid){}
  __device__ __forceinline__ bool next(int i,AttnUnit&u)const{ const int uu=vcu+i*G; if(uu>=2048)return false; const int v=uu&255,ii=uu>>8,hf=v&1,j=ii>>1; u.bh=v>>1; u.qb=(ii&1)?15-2*j-hf:2*j+hf; return true; }
};
__device__ __forceinline__ void attn_phase(char*lds,const AttnTensors&T,const StaticOrder&S,const float mref,const int tid){
  AttnUnit u;
  int last=-1;
  for(int i=0;S.next(i,u);++i){ const int key=(u.bh/NHEAD)*4+((u.bh%NHEAD)>>2); attn_unit(u.bh/NHEAD,u.bh%NHEAD,u.qb,T.Q,T.K,T.V,T.O,lds,T.kmsum,mref,key!=last,tid); last=key; }
}
#undef SBAR
#undef WAIT_BAR
}

constexpr int N_PHASES = 18;
#define PHASE_TID() unsigned ones_ = ones; asm volatile("" : "+s"(ones_)); const int tid = (wave_s << 6) | (int)__builtin_amdgcn_mbcnt_hi(ones_, __builtin_amdgcn_mbcnt_lo(ones_, 0u));
__device__ __forceinline__ void run_phase(const int ph, CArgs* ap, LAS unsigned char* lds, const int G, const int bx, const int wave_s, const unsigned ones) {
    const int vcu = (G % 8 == 0) ? (bx % 8) * (G / 8) + bx / 8 : bx;
    CArgs* A = ap;
    unsigned char* ws = A->ws;
    const int l = ph >= 10 ? 1 : 0;
    bf16* HB0 = (bf16*)(ws + WS_HB); bf16* HB1 = (bf16*)(ws + WS_HB2);
    bf16* HBl = l ? HB1 : HB0; bf16* HBo = l ? HB0 : HB1;
    float* SSQ0 = (float*)(ws + WS_SSQ0); float* SSQ1 = (float*)(ws + WS_SSQ1); LAS float* XQ = (LAS float*)(lds + LDSCTL_OFF + 12288);
    switch (ph) {
    case 0: { PHASE_TID() p0_prologue(A, lds, G, vcu, wave_s, tid & 63); } break;
    case 1: { PHASE_TID() pg8::Gemm g{HB0, (const bf16*)(ws + WS_WIN), M, ML_INP, D, SSQ0}; pg8::StaticOrder S; S.init(M, ML_INP, G, bx);
        EpiMl E{ws};
        pg8::gemm_phase<EpiMl, pg8::StaticOrder, true, true, true>(lds, g, S, E, tid); } break;
    case 2: { PHASE_TID() ml::phase_a(A, lds, G, bx, tid); } break;
    case 3: { PHASE_TID() ml::phase_scan(A, G, bx, tid); } break;
    case 4: { PHASE_TID() ml::phase_c(A, lds, G, bx, tid); } break;
    case 10: { PHASE_TID() pg8::Gemm g{HB1, (const bf16*)(ws + WS_WQKV1), M, 1536, D, SSQ1}; pg8::StaticOrder S; S.init(M, 1536, G, bx);
        EpiQkv1 E{ws, lds + LDSCTL_OFF + 1024, A->in[11], A->in[9]};
        pg8::gemm_phase<EpiQkv1, pg8::StaticOrder, true, true, true>(lds, g, S, E, tid); } break;
    case 11: break;
    case 12: { PHASE_TID()
        const mattn::AttnTensors AT{(const mattn::bf16*)(ws + WS_Q1), (const mattn::bf16*)(ws + WS_K1), (const mattn::bf16*)(ws + WS_V1), (mattn::bf16*)(ws + WS_AO), (const float*)(ws + WS_KMP)};
        const mattn::StaticOrder S(G, vcu);
        float mref; { const int lane = tid & 63; const float gq = wave_max(fabsf(A->in[11][lane]), lane), gk = wave_max(fabsf(A->in[9][lane]), lane);
            mref = __builtin_bit_cast(float, __builtin_amdgcn_readfirstlane(__builtin_bit_cast(int, 64.0f * 0.125f * 1.4426950408889634f * gq * gk))); }
        mattn::attn_phase((char*)lds, AT, S, mref, tid);
        } break;
    case 5: case 13: case 7: case 15: {
        PHASE_TID() const bool dn = (ph == 7 || ph == 15);
        const size_t aoff = dn ? WS_ACT : (ph == 5 ? WS_V0 : WS_AO), boff = dn ? WS_WDN + l * 6 * MiB : (ph == 5 ? WS_WOUT : WS_WO1);
        pg8::Gemm g{(const bf16*)(ws + aoff), (const bf16*)(ws + boff), M, D, dn ? FF : D, nullptr}; pg8::StaticOrder S; S.init(M, D, G, bx);
        EpiRes E{HBl, l ? SSQ1 : SSQ0, XQ};
        pg8::gemm_phase<EpiRes, pg8::StaticOrder, true, true, false>(lds, g, S, E, tid); } break;
    case 6: case 14: { PHASE_TID() pg8::Gemm g{HBl, (const bf16*)(ws + WS_WGU + l * 11 * MiB), M, 2 * FF, D, l ? SSQ1 : SSQ0}; pg8::StaticOrder S; S.init(M, 2 * FF, G, bx);
        EpiSwiglu E{(bf16*)(ws + WS_ACT)};
        pg8::gemm_phase<EpiSwiglu, pg8::StaticOrder, true, true, true>(lds, g, S, E, tid); } break;
    case 8: case 16: { PHASE_TID() pg8::Gemm g{(const bf16*)(ws + WS_PB) + (size_t)l * M * PLE, (const bf16*)(ws + WS_WPU + l * (MiB / 2)), M, D, PLE, nullptr}; pg8::StaticOrder S; S.init(M, D, G, bx);
        EpiPlain E{(bf16*)(ws + WS_UP), D};
        pg8::gemm_phase<EpiPlain, pg8::StaticOrder, true, true, false>(lds, g, S, E, tid); } break;
    case 9: { PHASE_TID() pg8::Gemm g{HB0, (const bf16*)(ws + WS_WPG), M, D, D, SSQ0}; pg8::StaticOrder S; S.init(M, D, G, bx);
        EpiPle<false> E{HB0, HB1, nullptr, (const bf16*)(ws + WS_UP), SSQ1, XQ};
        pg8::gemm_phase<EpiPle<false>, pg8::StaticOrder, true, true, true>(lds, g, S, E, tid); } break;
    case 17: { PHASE_TID() pg8::Gemm g{HB1, (const bf16*)(ws + WS_WPG + 2 * MiB), M, D, D, SSQ1}; pg8::StaticOrder S; S.init(M, D, G, bx);
        EpiPle<true> E{HB1, nullptr, A->out, (const bf16*)(ws + WS_UP), nullptr, XQ};
        pg8::gemm_phase<EpiPle<true>, pg8::StaticOrder, true, true, true>(lds, g, S, E, tid); } break;
    default: break;
    }
}
#ifndef PHASE_MASK
#define PHASE_MASK 0xFFFFFFFFu
#endif
#ifndef LOCAL_MODE
#define LOCAL_MODE 1
#endif

__global__ void __launch_bounds__(NTHREADS, 2) yoco_fwd(Args args) {
    extern __shared__ __attribute__((aligned(16))) unsigned char lds_raw[];
    LAS unsigned char* lds = (LAS unsigned char*)lds_raw;
    volatile LAS unsigned* MISC = (volatile LAS unsigned*)(lds + LDSCTL_OFF);
    for (int u = threadIdx.x; u < (LDS_BYTES - LDSCTL_OFF) / 4; u += NTHREADS) ((LAS unsigned*)(lds + LDSCTL_OFF))[u] = 0u;
    __syncthreads();
    XcdBarrier bar; bar.bar = (unsigned*)(args.ws + WS_CTL) + 4096; bar.x = 0; bar.st = nullptr;
    if (MK_N_LAUNCHES == 1) bar = xcd_barrier_post((unsigned*)(args.ws + WS_CTL) + 4096, MISC + 8);
    const int lo = args.ph_lo, hi = args.ph_hi;
    const int wave_s = __builtin_amdgcn_readfirstlane(threadIdx.x >> 6);
#pragma unroll 1
    for (int ph = lo; ph < hi; ++ph) {
        CArgs* ap = (CArgs*)__builtin_amdgcn_kernarg_segment_ptr(); unsigned ones = ~0u; int G = gridDim.x, bx = blockIdx.x;
        bool local = false;
        if (LOCAL_MODE && MK_N_LAUNCHES == 1 && ph > 0) { const unsigned ev = (unsigned)__builtin_amdgcn_readfirstlane((int)MISC[11]), rk = (unsigned)__builtin_amdgcn_readfirstlane((int)MISC[10]);
            if (ev != 0u && rk < 32u && bar.x < 8u) { local = true; bx = (int)(rk * 8u + bar.x); } }
        asm volatile("" : "+s"(ap), "+s"(ones), "+s"(G), "+s"(bx));
#if defined(TS_MASK)
        if (wave_s == 0) MISC[17] = (unsigned)__builtin_amdgcn_s_memrealtime();
#endif
        if ((PHASE_MASK >> ph) & 1u) run_phase(ph, ap, lds, G, bx, wave_s, ones);
#if defined(TS_MASK)
        { XcdBarrier b2 = bar; asm volatile("" : "+s"(b2.bar)); xcd_barrier(b2); }
        if (((TS_MASK >> ph) & 1u) && wave_s == 0) MISC[16] = MISC[16] + ((unsigned)__builtin_amdgcn_s_memrealtime() - MISC[17]);
#else
        if (ph + 1 < hi && ph != 7 && ph != 15 && ph != 10) { XcdBarrier b2 = bar; asm volatile("" : "+s"(b2.bar));
            const int job = (SIDE_JOBS && G == 256) ? ((ph >= 1 && ph <= 4) ? ph - 1 : (ph == 5 ? 4 : (ph == 6 ? 5 : (ph == 8 ? 6 : -1)))) : -1;
            xcd_barrier(b2, ap, lds, job, G, bx, wave_s, ones, local && !(ph == 5 || ph == 9 || ph == 13)); }
#endif
    }
#if defined(TS_MASK)
    if (blockIdx.x == 0 && wave_s == 0) args.out[0] += (float)MISC[16] * 0.001f;
#endif
}

extern "C" void kernel_launch(void* const* d_in, const int* in_sizes, int n_in, void* d_out, int out_size, void* d_ws, size_t ws_size, hipStream_t stream) {
    static int grid = 0;
    if (grid == 0) {
        if (n_in != 19 || in_sizes[0] != M * D || out_size != M * D || ws_size < WS_END) { fprintf(stderr, "kernel_launch: unexpected shapes (n_in %d, in0 %d, out %d, ws %zu); nothing launched\n", n_in, n_in > 0 ? in_sizes[0] : -1, out_size, ws_size); grid = -1; return; }
        int dev = 0, cus = 0, per_cu = 0;
        if (hipGetDevice(&dev) != hipSuccess || hipDeviceGetAttribute(&cus, hipDeviceAttributeMultiprocessorCount, dev) != hipSuccess) { grid = -1; return; }
        if (hipFuncSetAttribute((const void*)yoco_fwd, hipFuncAttributeMaxDynamicSharedMemorySize, LDS_BYTES) != hipSuccess) { fprintf(stderr, "kernel_launch: hipFuncSetAttribute failed\n"); grid = -1; return; }
        if (hipOccupancyMaxActiveBlocksPerMultiprocessor(&per_cu, (const void*)yoco_fwd, NTHREADS, LDS_BYTES) != hipSuccess || per_cu < 1) { fprintf(stderr, "kernel_launch: occupancy query says %d blocks per CU\n", per_cu); per_cu = 1; }
        (void)hipGetLastError();
        grid = cus;
    }
    if (grid < 0) return;
    (void)hipMemsetAsync((char*)d_ws + WS_CTL, 0, CTL_ZERO_BYTES, stream);
    Args a{};
    for (int i = 0; i < 19; ++i) a.in[i] = (const float*)d_in[i];
    a.out = (float*)d_out; a.ws = (unsigned char*)d_ws;
    if (MK_N_LAUNCHES == 1) {
        a.ph_lo = 0; a.ph_hi = N_PHASES;
        hipLaunchKernelGGL(yoco_fwd, dim3(grid), dim3(NTHREADS), LDS_BYTES, stream, a);
    } else {
        for (int p = 0; p < N_PHASES; ++p) { a.ph_lo = p; a.ph_hi = p + 1; hipLaunchKernelGGL(yoco_fwd, dim3(grid), dim3(NTHREADS), LDS_BYTES, stream, a); }
    }
}
```
